# Optimizing an MI355X kernel written in HIP

```python
import jax, jax.numpy as jnp
from jax import lax
import numpy as np

D_MODEL = 2048
BATCH = 16
SEQ = 2048
DEPTH = 1

CHUNK = 64
LEFT_CHUNKS = 8
BAND = (LEFT_CHUNKS + 1) * CHUNK

D_MIX = D_MODEL
D_ATTN = D_MIX // 2
ATTN_HEADS = 16
ATTN_HEAD_DIM = D_ATTN // ATTN_HEADS
REL_CLIP = 128
D_POOL = D_MIX - D_ATTN
POOL_WINDOWS = (2, 4, 8, 16)
N_POOL_GROUPS = len(POOL_WINDOWS)
POOL_GROUP_DIM = D_POOL // N_POOL_GROUPS
D_IN = 3 * D_ATTN + D_POOL

N_MEM = 256
CROSS_HEADS = 4
CROSS_HEAD_DIM = 128
D_CROSS = CROSS_HEADS * CROSS_HEAD_DIM

D_FF = ((8 * D_MODEL // 3) + 255) // 256 * 256
FFN_RES_WEIGHT = 0.5
EPS = 1e-6
NEG_INF = -1e30

kernel_name = "hybrid_chunk_attn_pool_macaron"


def rmsnorm(x, g):
    xf = x.astype(jnp.float32)
    y = xf * lax.rsqrt(jnp.mean(xf * xf, axis=-1, keepdims=True) + EPS)
    return (y * g.astype(jnp.float32)).astype(x.dtype)


def swiglu(x, w_gate, w_up, w_down):
    return (jax.nn.silu(x @ w_gate) * (x @ w_up)) @ w_down


def chunk_rel_attention(q, k, v, rel_table):
    B, S, H, Dh = q.shape
    nc = S // CHUNK
    pad = LEFT_CHUNKS * CHUNK
    kp = jnp.pad(k, ((0, 0), (pad, 0), (0, 0), (0, 0)))
    vp = jnp.pad(v, ((0, 0), (pad, 0), (0, 0), (0, 0)))
    q_band = pad + jnp.arange(CHUNK)
    rel = q_band[:, None] - jnp.arange(BAND)[None, :]
    rel_idx = jnp.clip(rel, -REL_CLIP, REL_CLIP) + REL_CLIP
    bias = rel_table[:, rel_idx].astype(jnp.float32)
    scale = Dh ** -0.5
    qc = q.reshape(B, nc, CHUNK, H, Dh).transpose(1, 0, 2, 3, 4)

    def one_chunk(args):
        c, qb = args
        start = c * CHUNK
        kb = lax.dynamic_slice_in_dim(kp, start, BAND, axis=1)
        vb = lax.dynamic_slice_in_dim(vp, start, BAND, axis=1)
        s = jnp.einsum('bqhd,bkhd->bhqk', qb, kb).astype(jnp.float32) * scale + bias[None]
        valid = (start + jnp.arange(BAND)) >= pad
        s = jnp.where(valid[None, None, None, :], s, NEG_INF)
        p = jax.nn.softmax(s, axis=-1).astype(vb.dtype)
        return jnp.einsum('bhqk,bkhd->bqhd', p, vb)

    out = lax.map(one_chunk, (jnp.arange(nc), qc))
    return out.transpose(1, 0, 2, 3, 4).reshape(B, S, H * Dh)


def multiscale_pool(u, w_pool, pool_scale):
    B, S, _ = u.shape
    uf = u.astype(jnp.float32)
    cs = jnp.concatenate([jnp.zeros((B, 1, D_POOL), jnp.float32), jnp.cumsum(uf, axis=1)], axis=1)
    t = jnp.arange(S)
    diffs = []
    for g, w in enumerate(POOL_WINDOWS):
        lo = jnp.maximum(t + 1 - w, 0)
        count = (t + 1 - lo).astype(jnp.float32)
        csg = cs[..., g * POOL_GROUP_DIM:(g + 1) * POOL_GROUP_DIM]
        mean = (csg[:, 1:] - csg[:, lo]) / count[None, :, None]
        diffs.append(mean - uf[..., g * POOL_GROUP_DIM:(g + 1) * POOL_GROUP_DIM])
    d = jnp.stack(diffs, axis=2).astype(u.dtype)
    y = jnp.einsum('bsgc,gcd->bsgd', d, w_pool).reshape(B, S, D_POOL)
    return y * pool_scale


def memory_cross_attention(h, mem, w_cq, w_ckv, w_co):
    B, S, _ = h.shape
    q = (h @ w_cq).reshape(B, S, CROSS_HEADS, CROSS_HEAD_DIM)
    kv = mem @ w_ckv
    k = kv[..., :D_CROSS].reshape(B, N_MEM, CROSS_HEADS, CROSS_HEAD_DIM)
    v = kv[..., D_CROSS:].reshape(B, N_MEM, CROSS_HEADS, CROSS_HEAD_DIM)
    s = jnp.einsum('bshd,bmhd->bhsm', q, k).astype(jnp.float32) * (CROSS_HEAD_DIM ** -0.5)
    p = jax.nn.softmax(s, axis=-1).astype(v.dtype)
    o = jnp.einsum('bhsm,bmhd->bshd', p, v).reshape(B, S, D_CROSS)
    return o @ w_co


def setup_inputs(seed: int = 0) -> dict:
    key = jax.random.key(seed)
    ks = jax.random.split(key, 24)
    f32 = jnp.float32

    def w(k, shape, fan_in):
        return jax.random.normal(k, shape, f32) * (fan_in ** -0.5)

    def gain(k, shape):
        return 1.0 + 0.05 * jax.random.normal(k, shape, f32)

    L = DEPTH
    return {
        "x": jax.random.normal(ks[0], (BATCH, SEQ, D_MODEL), f32),
        "mem": jax.random.normal(ks[1], (BATCH, N_MEM, D_MODEL), f32),
        "ffn1_norm": gain(ks[2], (L, D_MODEL)),
        "ffn1_w_gate": w(ks[3], (L, D_MODEL, D_FF), D_MODEL),
        "ffn1_w_up": w(ks[4], (L, D_MODEL, D_FF), D_MODEL),
        "ffn1_w_down": w(ks[5], (L, D_FF, D_MODEL), D_FF),
        "mix_norm": gain(ks[6], (L, D_MODEL)),
        "w_in": w(ks[7], (L, D_MODEL, D_IN), D_MODEL),
        "rel_bias": 0.5 * jax.random.normal(ks[8], (L, ATTN_HEADS, 2 * REL_CLIP + 1), f32),
        "w_pool": w(ks[9], (L, N_POOL_GROUPS, POOL_GROUP_DIM, POOL_GROUP_DIM), POOL_GROUP_DIM),
        "pool_scale": gain(ks[10], (L, D_POOL)),
        "w_out": w(ks[11], (L, D_MIX, D_MODEL), D_MIX),
        "cross_norm": gain(ks[12], (L, D_MODEL)),
        "mem_norm": gain(ks[13], (L, D_MODEL)),
        "w_cq": w(ks[14], (L, D_MODEL, D_CROSS), D_MODEL),
        "w_ckv": w(ks[15], (L, D_MODEL, 2 * D_CROSS), D_MODEL),
        "w_co": w(ks[16], (L, D_CROSS, D_MODEL), D_CROSS),
        "ffn2_norm": gain(ks[17], (L, D_MODEL)),
        "ffn2_w_gate": w(ks[18], (L, D_MODEL, D_FF), D_MODEL),
        "ffn2_w_up": w(ks[19], (L, D_MODEL, D_FF), D_MODEL),
        "ffn2_w_down": w(ks[20], (L, D_FF, D_MODEL), D_FF),
        "final_norm": gain(ks[21], (D_MODEL,)),
    }


def reference(x, mem, ffn1_norm, ffn1_w_gate, ffn1_w_up, ffn1_w_down, mix_norm, w_in,
              rel_bias, w_pool, pool_scale, w_out, cross_norm, mem_norm, w_cq, w_ckv, w_co,
              ffn2_norm, ffn2_w_gate, ffn2_w_up, ffn2_w_down, final_norm):
    B, S, _ = x.shape
    h = x
    for l in range(DEPTH):
        h = h + FFN_RES_WEIGHT * swiglu(rmsnorm(h, ffn1_norm[l]), ffn1_w_gate[l], ffn1_w_up[l], ffn1_w_down[l])
        z = rmsnorm(h, mix_norm[l]) @ w_in[l]
        q = z[..., 0 * D_ATTN:1 * D_ATTN].reshape(B, S, ATTN_HEADS, ATTN_HEAD_DIM)
        k = z[..., 1 * D_ATTN:2 * D_ATTN].reshape(B, S, ATTN_HEADS, ATTN_HEAD_DIM)
        v = z[..., 2 * D_ATTN:3 * D_ATTN].reshape(B, S, ATTN_HEADS, ATTN_HEAD_DIM)
        u = z[..., 3 * D_ATTN:]
        y_attn = chunk_rel_attention(q, k, v, rel_bias[l])
        y_pool = multiscale_pool(u, w_pool[l], pool_scale[l])
        h = h + jnp.concatenate([y_attn, y_pool], axis=-1) @ w_out[l]
        h = h + memory_cross_attention(rmsnorm(h, cross_norm[l]), rmsnorm(mem, mem_norm[l]),
                                       w_cq[l], w_ckv[l], w_co[l])
        h = h + FFN_RES_WEIGHT * swiglu(rmsnorm(h, ffn2_norm[l]), ffn2_w_gate[l], ffn2_w_up[l], ffn2_w_down[l])
    return rmsnorm(h, final_norm)
```

```cpp
#include <hip/hip_runtime.h>
#include <hip/hip_cooperative_groups.h>
#include <cstdio>
#include <cstdint>
namespace cg = cooperative_groups;

#define LAS __attribute__((address_space(3)))
typedef unsigned short bf16_t;
typedef short bf16x8 __attribute__((ext_vector_type(8)));
typedef float f32x4 __attribute__((ext_vector_type(4)));
typedef float f32x2 __attribute__((ext_vector_type(2)));
typedef unsigned u32x4 __attribute__((ext_vector_type(4)));
typedef unsigned u32x2 __attribute__((ext_vector_type(2)));

constexpr int BATCH = 16, SEQ = 2048, DM = 2048, MTOK = BATCH * SEQ;
constexpr int DFF = 5632, DIN = 4096, DATT = 1024, DPOOL = 1024, NMEM = 256, DCROSS = 512;
constexpr int NREL = 257;
constexpr float EPS = 1e-6f;
constexpr float LOG2E = 1.4426950408889634f;

constexpr size_t MiB = 1u << 20;
constexpr size_t WS_ROWSS = 0;
constexpr size_t WS_WGU1 = 1 * MiB, WS_WD1 = 45 * MiB, WS_WIN = 67 * MiB, WS_WP = 83 * MiB, WS_WOUT = 84 * MiB, WS_WCQ = 92 * MiB,
                 WS_WCKV = 94 * MiB, WS_WCO = 98 * MiB, WS_WGU2 = 100 * MiB, WS_WD2 = 144 * MiB;
constexpr size_t WS_HB = 166 * MiB;
constexpr size_t WS_ACT = 294 * MiB;
constexpr size_t WS_Z = 294 * MiB;
constexpr size_t WS_VT = 550 * MiB;
constexpr size_t WS_Y = 646 * MiB;
constexpr size_t WS_CQ = 646 * MiB, WS_CO = 678 * MiB;
constexpr size_t WS_DP = 774 * MiB;
constexpr size_t WS_MEMN = 838 * MiB;
constexpr size_t WS_KC = 854 * MiB;
constexpr size_t WS_VCT = 858 * MiB;
constexpr size_t WS_END = 862 * MiB;

constexpr int LDS_BYTES = 147456;

__device__ __forceinline__ unsigned cvt_pk_bf16(float lo, float hi) { unsigned r; asm volatile("v_cvt_pk_bf16_f32 %0, %1, %2" : "=v"(r) : "v"(lo), "v"(hi)); return r; }
__device__ __forceinline__ float bf_lo(unsigned w) { return __uint_as_float(w << 16); }
__device__ __forceinline__ float bf_hi(unsigned w) { return __uint_as_float(w & 0xffff0000u); }
__device__ __forceinline__ float wave_sum(float v) {
#pragma unroll
    for (int o = 1; o < 64; o <<= 1) v += __shfl_xor(v, o);
    return v;
}

namespace pg8 {
constexpr int BM = 256, BK = 64, HALF = 128, HTB = HALF * BK * 2, STAGE_BYTES = 8 * HTB, NXCD = 8, WGM = 8;
__host__ __device__ __forceinline__ int lds_byte(int r, int c) { const int st = (r >> 4) * 2 + (c >> 5), rr = r & 15, cc = c & 31, ob = rr * 64 + cc * 2; return st * 1024 + (ob ^ (((ob >> 9) & 1) << 5)); }
__host__ __device__ __forceinline__ void stage_rc(int b, int& R, int& C) { const int st = b / 1024, sb = b % 1024, swz = sb ^ (((sb >> 9) & 1) << 5); R = (st >> 1) * 16 + swz / 64; C = (st & 1) * 32 + (swz % 64) / 2; }
__host__ __device__ __forceinline__ int perm32(int rho) { const int n = rho >> 4, i = rho & 15; return 8 * (i >> 2) + 4 * n + (i & 3); }

struct Unit { int pm, pn; };
struct Gemm { const bf16_t* A; const bf16_t* Bt; int lda, ldb, K, a_pn_step; };

struct StaticOrder {
    int nM, nN, nwg, G, c;
    __device__ void init(int M, int N, int G_, int c_) { nM = M / BM; nN = N / BM; nwg = nM * nN; G = G_; c = c_; }
    __device__ bool next(int i, Unit& u) const {
        const long L = (long)i * G + c; if (L >= nwg) return false;
        int wgid = (int)L; { const int q = nwg / NXCD, r = nwg % NXCD, xcd = wgid % NXCD, off = wgid / NXCD; wgid = (xcd < r ? xcd * (q + 1) : r * (q + 1) + (xcd - r) * q) + off; }
        const int nig = WGM * nN, gid = wgid / nig, fm = gid * WGM, gsz = (nM - fm) < WGM ? (nM - fm) : WGM;
        u.pm = fm + ((wgid % nig) % gsz); u.pn = (wgid % nig) / gsz; return true;
    }
};

struct EpiBf {
    bf16_t* O; int ldc; int col_off; const float* rowss; const float* colscale; int t_lo, t_hi, t_rows, t_cols; bf16_t* VT;
    __device__ __forceinline__ void operator()(const f32x4 (&acc)[2][2][4][2], const Unit& u, int wr, int wc, int fr, int fq) const {
        const int row0 = u.pm * BM + wr * 64 + fr, cl = wc * 32 + 8 * fq;
        const bool tr = (u.pn >= t_lo) && (u.pn < t_hi);
        f32x4 cs[2][2];
#pragma unroll
        for (int bj = 0; bj < 2; ++bj)
#pragma unroll
            for (int n = 0; n < 2; ++n) cs[bj][n] = colscale ? *(const f32x4*)(colscale + u.pn * BM + bj * HALF + cl + 4 * n) : (f32x4){1.f, 1.f, 1.f, 1.f};
#pragma unroll
        for (int ai = 0; ai < 2; ++ai)
#pragma unroll
            for (int m = 0; m < 4; ++m) {
                const int row = row0 + ai * HALF + m * 16;
                const float rsc = rowss ? __builtin_amdgcn_rsqf(rowss[row] * (1.0f / DM) + EPS) : 1.0f;
#pragma unroll
                for (int bj = 0; bj < 2; ++bj) {
                    const f32x4 v0 = acc[ai][bj][m][0] * rsc * cs[bj][0], v1 = acc[ai][bj][m][1] * rsc * cs[bj][1];
                    u32x4 w; w.x = cvt_pk_bf16(v0[0], v0[1]); w.y = cvt_pk_bf16(v0[2], v0[3]); w.z = cvt_pk_bf16(v1[0], v1[1]); w.w = cvt_pk_bf16(v1[2], v1[3]);
                    if (!tr) { *(u32x4*)(O + (size_t)row * ldc + col_off + u.pn * BM + bj * HALF + cl) = w; }
                    else {
                        const int cv = (u.pn - t_lo) * BM + bj * HALF + cl, b = row / t_rows, s = row - b * t_rows;
                        bf16_t* p = VT + ((size_t)b * t_cols + cv) * t_rows + s;
                        p[0] = (bf16_t)(w.x & 0xffffu); p[(size_t)t_rows] = (bf16_t)(w.x >> 16); p[(size_t)2 * t_rows] = (bf16_t)(w.y & 0xffffu); p[(size_t)3 * t_rows] = (bf16_t)(w.y >> 16);
                        p[(size_t)4 * t_rows] = (bf16_t)(w.z & 0xffffu); p[(size_t)5 * t_rows] = (bf16_t)(w.z >> 16); p[(size_t)6 * t_rows] = (bf16_t)(w.w & 0xffffu); p[(size_t)7 * t_rows] = (bf16_t)(w.w >> 16);
                    }
                }
            }
    }
};
__device__ __forceinline__ float silu_mul(float g, float u) { return g * __builtin_amdgcn_rcpf(1.0f + __expf(-g)) * u; }
struct EpiSwiglu {
    bf16_t* O; int ldc; const float* rowss;
    __device__ __forceinline__ void operator()(const f32x4 (&acc)[2][2][4][2], const Unit& u, int wr, int wc, int fr, int fq) const {
        const int row0 = u.pm * BM + wr * 64 + fr, cl = wc * 32 + 8 * fq;
#pragma unroll
        for (int ai = 0; ai < 2; ++ai)
#pragma unroll
            for (int m = 0; m < 4; ++m) {
                const int row = row0 + ai * HALF + m * 16;
                const float rsc = __builtin_amdgcn_rsqf(rowss[row] * (1.0f / DM) + EPS);
                const f32x4 g0 = acc[ai][0][m][0] * rsc, g1 = acc[ai][0][m][1] * rsc, u0 = acc[ai][1][m][0] * rsc, u1 = acc[ai][1][m][1] * rsc;
                u32x4 w;
                w.x = cvt_pk_bf16(silu_mul(g0[0], u0[0]), silu_mul(g0[1], u0[1])); w.y = cvt_pk_bf16(silu_mul(g0[2], u0[2]), silu_mul(g0[3], u0[3]));
                w.z = cvt_pk_bf16(silu_mul(g1[0], u1[0]), silu_mul(g1[1], u1[1])); w.w = cvt_pk_bf16(silu_mul(g1[2], u1[2]), silu_mul(g1[3], u1[3]));
                *(u32x4*)(O + (size_t)row * ldc + u.pn * HALF + cl) = w;
            }
    }
};
struct EpiRes {
    const float* hin; float* hout; bf16_t* hb; float* rowss_out; float alpha;
    __device__ __forceinline__ void operator()(const f32x4 (&acc)[2][2][4][2], const Unit& u, int wr, int wc, int fr, int fq) const {
        const int row0 = u.pm * BM + wr * 64 + fr, cl = u.pn * BM + wc * 32 + 8 * fq;
#pragma unroll
        for (int ai = 0; ai < 2; ++ai)
#pragma unroll
            for (int m = 0; m < 4; ++m) {
                const int row = row0 + ai * HALF + m * 16; const size_t off = (size_t)row * DM + cl;
                float ss = 0.f;
#pragma unroll
                for (int bj = 0; bj < 2; ++bj) {
                    f32x4 h0 = *(const f32x4*)(hin + off + bj * HALF), h1 = *(const f32x4*)(hin + off + bj * HALF + 4);
                    h0 = h0 + acc[ai][bj][m][0] * alpha; h1 = h1 + acc[ai][bj][m][1] * alpha;
                    *(f32x4*)(hout + off + bj * HALF) = h0; *(f32x4*)(hout + off + bj * HALF + 4) = h1;
                    ss += (h0[0] * h0[0] + h0[1] * h0[1]) + (h0[2] * h0[2] + h0[3] * h0[3]) + (h1[0] * h1[0] + h1[1] * h1[1]) + (h1[2] * h1[2] + h1[3] * h1[3]);
                    if (hb) { u32x4 w; w.x = cvt_pk_bf16(h0[0], h0[1]); w.y = cvt_pk_bf16(h0[2], h0[3]); w.z = cvt_pk_bf16(h1[0], h1[1]); w.w = cvt_pk_bf16(h1[2], h1[3]); *(u32x4*)(hb + off + bj * HALF) = w; }
                }
                ss += __shfl_xor(ss, 16); ss += __shfl_xor(ss, 32);
                if (fq == 0) unsafeAtomicAdd(rowss_out + row, ss);
                asm volatile("" ::: "memory");
            }
    }
};

template <class Epi, bool ALIGN_EPI = true>
__device__ __forceinline__ void gemm_phase(LAS unsigned char* lds, const Gemm g, const StaticOrder& S, const Epi& E) {
    const int tid = threadIdx.x, wid = __builtin_amdgcn_readfirstlane(tid >> 6), lane = tid & 63, wr = wid >> 2, wc = wid & 3, fr = lane & 15, fq = lane >> 4;
    const int K = g.K, nt = K / BK;
    unsigned voffA[2], voffB[2];
#pragma unroll
    for (int i = 0; i < 2; ++i) { int R, C; stage_rc(tid * 16 + i * 8192, R, C); const int Rb = (R & ~31) + perm32(R & 31);
        voffA[i] = (unsigned)(R * g.lda + C) * 2u; voffB[i] = (unsigned)(Rb * g.ldb + C) * 2u; }
    const size_t kstep = (size_t)(BK * 2);
    const size_t hstepA = (size_t)HALF * g.lda * 2, hstepB = (size_t)HALF * g.ldb * 2;
    const size_t tstepA = 2 * hstepA, tstepB = 2 * hstepB;
    const unsigned ldsw = (unsigned)wid * 1024u;
    const int aoff = lds_byte(wr * 64 + fr, fq * 8), boff = lds_byte(wc * 32 + fr, fq * 8);
#define PG8_SA(b, h) (((b) * 2 + (h)) * HTB)
#define PG8_SB(b, h) ((4 + (b) * 2 + (h)) * HTB)
#define PG8_STAGE(bufoff, gbase, voff) do { _Pragma("unroll") for (int _i = 0; _i < 2; ++_i) \
        __builtin_amdgcn_global_load_lds((const unsigned*)((const char*)(gbase) + (voff)[_i]), (LAS unsigned*)(lds + (bufoff) + ldsw + _i * 8192), 16, 0, 0); } while (0)
#define PG8_LDA(dst, b, h) do { _Pragma("unroll") for (int m = 0; m < 4; ++m) _Pragma("unroll") for (int k = 0; k < 2; ++k) dst[m][k] = *(const LAS bf16x8*)(lds + PG8_SA(b, h) + aoff + m * 2048 + k * 1024); } while (0)
#define PG8_LDB(dst, b, h) do { _Pragma("unroll") for (int n = 0; n < 2; ++n) _Pragma("unroll") for (int k = 0; k < 2; ++k) dst[n][k] = *(const LAS bf16x8*)(lds + PG8_SB(b, h) + boff + n * 2048 + k * 1024); } while (0)
#define PG8_MMA(ai, bj, At, Bt) do { __builtin_amdgcn_s_setprio(1); _Pragma("unroll") for (int m = 0; m < 4; ++m) _Pragma("unroll") for (int n = 0; n < 2; ++n) _Pragma("unroll") for (int k = 0; k < 2; ++k) \
        acc[ai][bj][m][n] = __builtin_amdgcn_mfma_f32_16x16x32_bf16(Bt[n][k], At[m][k], acc[ai][bj][m][n], 0, 0, 0); __builtin_amdgcn_s_setprio(0); } while (0)
#define PG8_WAIT_V(n) asm volatile("s_waitcnt vmcnt(" #n ")" ::: "memory")
#define PG8_WAIT_L(n) asm volatile("s_waitcnt lgkmcnt(" #n ")" ::: "memory")
#define PG8_BAR __builtin_amdgcn_s_barrier()
#define PG8_SCHED __builtin_amdgcn_sched_barrier(0)
    Unit cur, nxt; int ui = 0;
    if (!S.next(0, cur)) return;
    f32x4 acc[2][2][4][2];
#pragma unroll
    for (int a = 0; a < 2; ++a)
#pragma unroll
        for (int b = 0; b < 2; ++b)
#pragma unroll
            for (int m = 0; m < 4; ++m)
#pragma unroll
                for (int n = 0; n < 2; ++n) acc[a][b][m][n] = (f32x4){0.f, 0.f, 0.f, 0.f};
    bf16x8 At[4][2], B0[2][2], B1[2][2];
    const char* cA = (const char*)g.A + (size_t)cur.pm * tstepA + (size_t)cur.pn * g.a_pn_step; const char* cB = (const char*)g.Bt + (size_t)cur.pn * tstepB;
    PG8_STAGE(PG8_SB(0, 0), cB, voffB); PG8_STAGE(PG8_SB(0, 1), cB + hstepB, voffB); PG8_STAGE(PG8_SA(0, 0), cA, voffA); PG8_STAGE(PG8_SA(0, 1), cA + hstepA, voffA);
    if (wr == 1) PG8_BAR;
    PG8_WAIT_V(2); PG8_BAR;
    PG8_STAGE(PG8_SB(1, 0), cB + kstep, voffB); PG8_STAGE(PG8_SA(1, 0), cA + kstep, voffA); PG8_STAGE(PG8_SB(1, 1), cB + hstepB + kstep, voffB);
    PG8_WAIT_V(6); PG8_BAR;
    for (;;) {
        const bool has_next = S.next(ui + 1, nxt);
        const char* nA = has_next ? (const char*)g.A + (size_t)nxt.pm * tstepA + (size_t)nxt.pn * g.a_pn_step : cA; const char* nB = has_next ? (const char*)g.Bt + (size_t)nxt.pn * tstepB : cB;
        for (int t = 0; t < nt; t += 2) {
            const bool last = (t == nt - 2);
            const char* a1 = cA + (size_t)(t + 1) * kstep;
            const char* a2 = last ? nA : cA + (size_t)(t + 2) * kstep; const char* b2 = last ? nB : cB + (size_t)(t + 2) * kstep;
            const char* a3 = a2 + kstep; const char* b3 = b2 + kstep;
            PG8_LDB(B0, 0, 0); PG8_LDB(B1, 0, 1); PG8_SCHED; PG8_LDA(At, 0, 0); PG8_STAGE(PG8_SA(1, 1), a1 + hstepA, voffA);
            PG8_WAIT_V(8); PG8_WAIT_L(0); PG8_BAR; PG8_MMA(0, 0, At, B0); PG8_MMA(0, 1, At, B1); PG8_BAR; PG8_SCHED;
            PG8_LDA(At, 0, 1); PG8_STAGE(PG8_SB(0, 0), b2, voffB); PG8_STAGE(PG8_SB(0, 1), b2 + hstepB, voffB); PG8_STAGE(PG8_SA(0, 0), a2, voffA);
            PG8_WAIT_V(8); PG8_WAIT_L(0); PG8_BAR; PG8_MMA(1, 0, At, B0); PG8_MMA(1, 1, At, B1); PG8_BAR; PG8_SCHED;
            PG8_LDB(B0, 1, 0); PG8_LDB(B1, 1, 1); PG8_SCHED; PG8_LDA(At, 1, 0); PG8_STAGE(PG8_SA(0, 1), a2 + hstepA, voffA);
            PG8_WAIT_V(8); PG8_WAIT_L(0); PG8_BAR; PG8_MMA(0, 0, At, B0); PG8_MMA(0, 1, At, B1); PG8_BAR; PG8_SCHED;
            PG8_LDA(At, 1, 1); PG8_STAGE(PG8_SB(1, 0), b3, voffB); PG8_STAGE(PG8_SB(1, 1), b3 + hstepB, voffB); PG8_STAGE(PG8_SA(1, 0), a3, voffA);
            PG8_WAIT_V(8); PG8_WAIT_L(0); PG8_BAR; PG8_MMA(1, 0, At, B0); PG8_MMA(1, 1, At, B1); PG8_BAR; PG8_SCHED;
        }
        if constexpr (ALIGN_EPI) { if (wr == 0) PG8_BAR; }
        E(acc, cur, wr, wc, fr, fq);
        if (!has_next) break;
#pragma unroll
        for (int a = 0; a < 2; ++a)
#pragma unroll
            for (int b = 0; b < 2; ++b)
#pragma unroll
                for (int m = 0; m < 4; ++m)
#pragma unroll
                    for (int n = 0; n < 2; ++n) acc[a][b][m][n] = (f32x4){0.f, 0.f, 0.f, 0.f};
        cur = nxt; cA = nA; cB = nB; ++ui;
        if constexpr (ALIGN_EPI) { if (wr == 1) PG8_BAR; }
    }
    PG8_WAIT_V(0);
    if constexpr (!ALIGN_EPI) { if (wr == 0) PG8_BAR; }
    PG8_BAR;
#undef PG8_SA
#undef PG8_SB
#undef PG8_STAGE
#undef PG8_LDA
#undef PG8_LDB
#undef PG8_MMA
#undef PG8_WAIT_V
#undef PG8_WAIT_L
#undef PG8_BAR
#undef PG8_SCHED
}
}

template <int DH, bool BIAS, int NT, bool PF>
__device__ __forceinline__ void attn_wave32(const bf16_t* __restrict__ Qp, int ldq, const bf16_t* __restrict__ Kp, int ldk, const bf16_t* __restrict__ Vp, int ldv,
                                            bf16_t* __restrict__ Op, int ldo, int ntiles, float sc, const LAS float* tab, int rel_base, int lane) {
    constexpr int KS = DH / 32, DT = DH / 16;
    const int fr = lane & 15, fq = lane >> 4;
    bf16x8 qf[NT][KS];
#pragma unroll
    for (int nt = 0; nt < NT; ++nt)
#pragma unroll
        for (int ks = 0; ks < KS; ++ks) qf[nt][ks] = *(const bf16x8*)(Qp + (size_t)(nt * 16 + fr) * ldq + ks * 32 + fq * 8);
    f32x4 o[DT][NT];
#pragma unroll
    for (int dt = 0; dt < DT; ++dt)
#pragma unroll
        for (int nt = 0; nt < NT; ++nt) o[dt][nt] = (f32x4){0.f, 0.f, 0.f, 0.f};
    float mrun[NT], lrun[NT];
#pragma unroll
    for (int nt = 0; nt < NT; ++nt) { mrun[nt] = -1e30f; lrun[nt] = 0.f; }
    const bf16_t* kbase = Kp + (size_t)(8 * (fr >> 2) + (fr & 3)) * ldk + fq * 8;
    const bf16_t* vbase = Vp + (size_t)fr * ldv + fq * 8;
    bf16x8 kf[4][KS];
    if (PF) {
#pragma unroll
        for (int mt = 0; mt < 4; ++mt)
#pragma unroll
            for (int ks = 0; ks < KS; ++ks) kf[mt][ks] = *(const bf16x8*)(kbase + (size_t)((mt >> 1) * 32 + 4 * (mt & 1)) * ldk + ks * 32);
    }
#pragma nounroll
    for (int t = 0; t < ntiles; ++t) {
        bf16x8 vf[DT][2];
        if (PF) {
#pragma unroll
            for (int dt = 0; dt < DT; ++dt)
#pragma unroll
                for (int kb = 0; kb < 2; ++kb) vf[dt][kb] = *(const bf16x8*)(vbase + (size_t)(dt * 16) * ldv + t * 64 + kb * 32);
        } else {
#pragma unroll
            for (int mt = 0; mt < 4; ++mt)
#pragma unroll
                for (int ks = 0; ks < KS; ++ks) kf[mt][ks] = *(const bf16x8*)(kbase + (size_t)(t * 64 + (mt >> 1) * 32 + 4 * (mt & 1)) * ldk + ks * 32);
        }
        f32x4 s[4][NT];
#pragma unroll
        for (int mt = 0; mt < 4; ++mt)
#pragma unroll
            for (int nt = 0; nt < NT; ++nt) {
                s[mt][nt] = (f32x4){0.f, 0.f, 0.f, 0.f};
#pragma unroll
                for (int ks = 0; ks < KS; ++ks) s[mt][nt] = __builtin_amdgcn_mfma_f32_16x16x32_bf16(kf[mt][ks], qf[nt][ks], s[mt][nt], 0, 0, 0);
            }
        if (PF) {
            const int tn = (t + 1 < ntiles) ? t + 1 : t;
#pragma unroll
            for (int mt = 0; mt < 4; ++mt)
#pragma unroll
                for (int ks = 0; ks < KS; ++ks) kf[mt][ks] = *(const bf16x8*)(kbase + (size_t)(tn * 64 + (mt >> 1) * 32 + 4 * (mt & 1)) * ldk + ks * 32);
        }
        bf16x8 pf[NT][2];
        const int relt = rel_base - 64 * t;
        const bool cbias = BIAS && (relt - 63 >= 128);
#pragma unroll
        for (int nt = 0; nt < NT; ++nt) {
            float mloc = -1e30f;
#pragma unroll
            for (int mt = 0; mt < 4; ++mt)
#pragma unroll
                for (int j = 0; j < 4; ++j) {
                    float v = s[mt][nt][j] * sc;
                    if (BIAS) {
                        if (cbias) v += tab[256];
                        else { int rel = relt + (nt * 16 + fr) - ((mt >> 1) * 32 + 8 * fq + 4 * (mt & 1) + j); rel = rel < -128 ? -128 : (rel > 128 ? 128 : rel); v += tab[rel + 128]; }
                    }
                    s[mt][nt][j] = v; mloc = fmaxf(mloc, v);
                }
            mloc = fmaxf(mloc, __shfl_xor(mloc, 16)); mloc = fmaxf(mloc, __shfl_xor(mloc, 32));
            const float mnew = fmaxf(mrun[nt], mloc), alpha = __builtin_amdgcn_exp2f(mrun[nt] - mnew);
            mrun[nt] = mnew;
            float ls = 0.f;
#pragma unroll
            for (int mt = 0; mt < 4; ++mt)
#pragma unroll
                for (int j = 0; j < 4; ++j) { const float p = __builtin_amdgcn_exp2f(s[mt][nt][j] - mnew); s[mt][nt][j] = p; ls += p; }
            lrun[nt] = lrun[nt] * alpha + ls;
#pragma unroll
            for (int dt = 0; dt < DT; ++dt) o[dt][nt] = o[dt][nt] * alpha;
#pragma unroll
            for (int kb = 0; kb < 2; ++kb) {
                u32x4 w; w.x = cvt_pk_bf16(s[2 * kb][nt][0], s[2 * kb][nt][1]); w.y = cvt_pk_bf16(s[2 * kb][nt][2], s[2 * kb][nt][3]);
                w.z = cvt_pk_bf16(s[2 * kb + 1][nt][0], s[2 * kb + 1][nt][1]); w.w = cvt_pk_bf16(s[2 * kb + 1][nt][2], s[2 * kb + 1][nt][3]);
                pf[nt][kb] = __builtin_bit_cast(bf16x8, w);
            }
        }
        if (!PF) {
            asm volatile("" ::: "memory");
#pragma unroll
            for (int dt = 0; dt < DT; ++dt)
#pragma unroll
                for (int kb = 0; kb < 2; ++kb) vf[dt][kb] = *(const bf16x8*)(vbase + (size_t)(dt * 16) * ldv + t * 64 + kb * 32);
        }
#pragma unroll
        for (int dt = 0; dt < DT; ++dt)
#pragma unroll
            for (int nt = 0; nt < NT; ++nt)
#pragma unroll
                for (int kb = 0; kb < 2; ++kb) o[dt][nt] = __builtin_amdgcn_mfma_f32_16x16x32_bf16(vf[dt][kb], pf[nt][kb], o[dt][nt], 0, 0, 0);
    }
#pragma unroll
    for (int nt = 0; nt < NT; ++nt) {
        float l = lrun[nt]; l += __shfl_xor(l, 16); l += __shfl_xor(l, 32);
        const float inv = 1.0f / l;
#pragma unroll
        for (int dt = 0; dt < DT; ++dt) {
            const f32x4 v = o[dt][nt] * inv; u32x2 w; w.x = cvt_pk_bf16(v[0], v[1]); w.y = cvt_pk_bf16(v[2], v[3]);
            *(u32x2*)(Op + (size_t)(nt * 16 + fr) * ldo + dt * 16 + 4 * fq) = w;
        }
    }
}

struct Params {
    const float* x; const float* mem;
    const float* ffn1_norm; const float* ffn1_wg; const float* ffn1_wu; const float* ffn1_wd;
    const float* mix_norm; const float* w_in; const float* rel_bias; const float* w_pool; const float* pool_scale; const float* w_out;
    const float* cross_norm; const float* mem_norm; const float* w_cq; const float* w_ckv; const float* w_co;
    const float* ffn2_norm; const float* ffn2_wg; const float* ffn2_wu; const float* ffn2_wd; const float* final_norm;
    float* out; unsigned char* ws;
};

__device__ __forceinline__ void p0_transpose_item(const float* __restrict__ W, int K, int N, bf16_t* __restrict__ WT, int mode, int row_off, const float* __restrict__ gain, LAS float* scr, int item, int lane) {
    const int nblk = N / 32, kb = item / nblk, nb = item - kb * nblk, k0 = 64 * kb, n0 = 32 * nb;
#pragma unroll 8
    for (int i = 0; i < 32; ++i) { const int kk = 2 * i + (lane >> 5); const float gk = gain ? gain[k0 + kk] : 1.0f; scr[kk * 33 + (lane & 31)] = W[(size_t)(k0 + kk) * N + n0 + (lane & 31)] * gk; }
    asm volatile("s_waitcnt lgkmcnt(0)" ::: "memory");
    const int c = lane & 7;
    const int d0 = (mode == 0) ? (row_off + n0) : ((n0 >> 7) * 256 + (n0 & 127) + (mode == 2 ? 128 : 0));
#pragma unroll
    for (int j = 0; j < 4; ++j) { const int n = (lane >> 3) + 8 * j; const LAS float* s = scr + (8 * c) * 33 + n;
        u32x4 o; o.x = cvt_pk_bf16(s[0 * 33], s[1 * 33]); o.y = cvt_pk_bf16(s[2 * 33], s[3 * 33]); o.z = cvt_pk_bf16(s[4 * 33], s[5 * 33]); o.w = cvt_pk_bf16(s[6 * 33], s[7 * 33]);
        *(u32x4*)(WT + (size_t)(d0 + n) * K + k0 + 8 * c) = o; }
    asm volatile("s_waitcnt lgkmcnt(0)" ::: "memory");
}

__global__ void __launch_bounds__(512, 2) fwd_megakernel(Params P) {
    extern __shared__ __attribute__((aligned(16))) unsigned char lds_raw[];
    cg::grid_group grid = cg::this_grid();
    LAS unsigned char* lds = (LAS unsigned char*)lds_raw;
    const int tid = threadIdx.x, lane = tid & 63, wave = __builtin_amdgcn_readfirstlane(tid >> 6);
    const int G = gridDim.x, bx = blockIdx.x;
    const int gw = bx * 8 + wave, NGW = G * 8;
    unsigned char* ws = P.ws;
    float* rowss = (float*)(ws + WS_ROWSS);
    bf16_t* Wgu1 = (bf16_t*)(ws + WS_WGU1); bf16_t* Wd1 = (bf16_t*)(ws + WS_WD1); bf16_t* Win = (bf16_t*)(ws + WS_WIN); bf16_t* Wp = (bf16_t*)(ws + WS_WP);
    bf16_t* Wout = (bf16_t*)(ws + WS_WOUT); bf16_t* Wcq = (bf16_t*)(ws + WS_WCQ); bf16_t* Wckv = (bf16_t*)(ws + WS_WCKV); bf16_t* Wco = (bf16_t*)(ws + WS_WCO);
    bf16_t* Wgu2 = (bf16_t*)(ws + WS_WGU2); bf16_t* Wd2 = (bf16_t*)(ws + WS_WD2);
    bf16_t* HB = (bf16_t*)(ws + WS_HB); bf16_t* ACT = (bf16_t*)(ws + WS_ACT); bf16_t* Z = (bf16_t*)(ws + WS_Z); bf16_t* VT = (bf16_t*)(ws + WS_VT);
    bf16_t* Y = (bf16_t*)(ws + WS_Y); bf16_t* CQ = (bf16_t*)(ws + WS_CQ); bf16_t* CO = (bf16_t*)(ws + WS_CO); bf16_t* DP = (bf16_t*)(ws + WS_DP);
    bf16_t* MEMN = (bf16_t*)(ws + WS_MEMN); bf16_t* KC = (bf16_t*)(ws + WS_KC); bf16_t* VCT = (bf16_t*)(ws + WS_VCT);

#define RUN_GEMM(EPI, gM, gN, gdesc, edesc) do { pg8::StaticOrder S_; S_.init((gM), (gN), G, bx); pg8::gemm_phase<EPI>(lds, (gdesc), S_, (edesc)); } while (0)

    {
        LAS float* scr = (LAS float*)(lds + wave * 16384);
        constexpr int I_G = (DM / 64) * (DFF / 32), I_D = (DFF / 64) * (DM / 32), I_IN = (DM / 64) * (DIN / 32), I_P = (256 / 64) * (256 / 32), I_O = (DM / 64) * (DM / 32),
                      I_CQ = (DM / 64) * (DCROSS / 32), I_CKV = (DM / 64) * (2 * DCROSS / 32), I_CO = (DCROSS / 64) * (DM / 32);
        constexpr int NITEMS = 4 * I_G + 2 * I_D + I_IN + 4 * I_P + I_O + I_CQ + I_CKV + I_CO;
        for (int it = gw; it < NITEMS; it += NGW) {
            int r = it;
            if (r < I_G) { p0_transpose_item(P.ffn1_wg, DM, DFF, Wgu1, 1, 0, P.ffn1_norm, scr, r, lane); continue; } r -= I_G;
            if (r < I_G) { p0_transpose_item(P.ffn1_wu, DM, DFF, Wgu1, 2, 0, P.ffn1_norm, scr, r, lane); continue; } r -= I_G;
            if (r < I_D) { p0_transpose_item(P.ffn1_wd, DFF, DM, Wd1, 0, 0, nullptr, scr, r, lane); continue; } r -= I_D;
            if (r < I_G) { p0_transpose_item(P.ffn2_wg, DM, DFF, Wgu2, 1, 0, P.ffn2_norm, scr, r, lane); continue; } r -= I_G;
            if (r < I_G) { p0_transpose_item(P.ffn2_wu, DM, DFF, Wgu2, 2, 0, P.ffn2_norm, scr, r, lane); continue; } r -= I_G;
            if (r < I_D) { p0_transpose_item(P.ffn2_wd, DFF, DM, Wd2, 0, 0, nullptr, scr, r, lane); continue; } r -= I_D;
            if (r < I_IN) { p0_transpose_item(P.w_in, DM, DIN, Win, 0, 0, P.mix_norm, scr, r, lane); continue; } r -= I_IN;
            if (r < 4 * I_P) { const int gi = r / I_P; p0_transpose_item(P.w_pool + (size_t)gi * 65536, 256, 256, Wp, 0, gi * 256, nullptr, scr, r - gi * I_P, lane); continue; } r -= 4 * I_P;
            if (r < I_O) { p0_transpose_item(P.w_out, DM, DM, Wout, 0, 0, nullptr, scr, r, lane); continue; } r -= I_O;
            if (r < I_CQ) { p0_transpose_item(P.w_cq, DM, DCROSS, Wcq, 0, 0, P.cross_norm, scr, r, lane); continue; } r -= I_CQ;
            if (r < I_CKV) { p0_transpose_item(P.w_ckv, DM, 2 * DCROSS, Wckv, 0, 0, nullptr, scr, r, lane); continue; } r -= I_CKV;
            p0_transpose_item(P.w_co, DCROSS, DM, Wco, 0, 0, nullptr, scr, r, lane);
        }
        for (int i = bx * 512 + tid; i < 4 * MTOK; i += G * 512) rowss[MTOK + i] = 0.f;
        for (int m = gw; m < MTOK; m += NGW) {
            const f32x4* xr = (const f32x4*)(P.x + (size_t)m * DM) + lane; u32x2* o8 = (u32x2*)(HB + (size_t)m * DM) + lane; float s = 0.f;
#pragma unroll
            for (int j = 0; j < 8; ++j) { const f32x4 v = xr[64 * j]; s += (v[0] * v[0] + v[1] * v[1]) + (v[2] * v[2] + v[3] * v[3]); u32x2 w; w.x = cvt_pk_bf16(v[0], v[1]); w.y = cvt_pk_bf16(v[2], v[3]); o8[64 * j] = w; }
            s = wave_sum(s); if (lane == 0) rowss[m] = s;
        }
        for (int m = gw; m < BATCH * NMEM; m += NGW) {
            const f32x4* xr = (const f32x4*)(P.mem + (size_t)m * DM) + lane; const f32x4* gr = (const f32x4*)P.mem_norm + lane; u32x2* o8 = (u32x2*)(MEMN + (size_t)m * DM) + lane;
            f32x4 v[8]; float s = 0.f;
#pragma unroll
            for (int j = 0; j < 8; ++j) { v[j] = xr[64 * j]; s += (v[j][0] * v[j][0] + v[j][1] * v[j][1]) + (v[j][2] * v[j][2] + v[j][3] * v[j][3]); }
            const float rs = __builtin_amdgcn_rsqf(wave_sum(s) * (1.0f / DM) + EPS);
#pragma unroll
            for (int j = 0; j < 8; ++j) { const f32x4 gg = gr[64 * j]; const f32x4 y = v[j] * rs * gg; u32x2 w; w.x = cvt_pk_bf16(y[0], y[1]); w.y = cvt_pk_bf16(y[2], y[3]); o8[64 * j] = w; }
        }
    }
    grid.sync();
    RUN_GEMM(pg8::EpiSwiglu, MTOK, 2 * DFF, (pg8::Gemm{HB, Wgu1, DM, DM, DM, 0}), (pg8::EpiSwiglu{ACT, DFF, rowss}));
    RUN_GEMM(pg8::EpiBf, BATCH * NMEM, 2 * DCROSS, (pg8::Gemm{MEMN, Wckv, DM, DM, DM, 0}), (pg8::EpiBf{KC, DCROSS, 0, nullptr, nullptr, 2, 4, NMEM, DCROSS, VCT}));
    grid.sync();
    RUN_GEMM(pg8::EpiRes, MTOK, DM, (pg8::Gemm{ACT, Wd1, DFF, DFF, DFF, 0}), (pg8::EpiRes{P.x, P.out, HB, rowss + 1 * MTOK, 0.5f}));
    grid.sync();
    RUN_GEMM(pg8::EpiBf, MTOK, DIN, (pg8::Gemm{HB, Win, DM, DM, DM, 0}), (pg8::EpiBf{Z, DIN, 0, rowss + 1 * MTOK, nullptr, 8, 12, SEQ, DATT, VT}));
    grid.sync();
    {
        for (int task = gw; task < (MTOK / 64) * 4; task += NGW) {
            const int gi = task & 3, rt = task >> 2, sub = lane >> 5, cgi = lane & 31, w = 2 << gi;
            const int t0 = rt * 64 + sub * 32, tpos = t0 & (SEQ - 1);
            const bf16_t* up = Z + (size_t)t0 * DIN + 3 * DATT + gi * 256 + cgi * 8;
            bf16_t* dp = DP + (size_t)t0 * DPOOL + gi * 256 + cgi * 8;
            float sum[8];
#pragma unroll
            for (int e = 0; e < 8; ++e) sum[e] = 0.f;
            for (int i = 1; i < w; ++i) if (tpos - i >= 0) { const u32x4 v = *(const u32x4*)(up - (size_t)i * DIN);
                sum[0] += bf_lo(v.x); sum[1] += bf_hi(v.x); sum[2] += bf_lo(v.y); sum[3] += bf_hi(v.y); sum[4] += bf_lo(v.z); sum[5] += bf_hi(v.z); sum[6] += bf_lo(v.w); sum[7] += bf_hi(v.w); }
            for (int r = 0; r < 32; ++r) {
                const u32x4 v = *(const u32x4*)(up + (size_t)r * DIN);
                float cur[8] = {bf_lo(v.x), bf_hi(v.x), bf_lo(v.y), bf_hi(v.y), bf_lo(v.z), bf_hi(v.z), bf_lo(v.w), bf_hi(v.w)};
                const int have = tpos + r + 1; const float inv = 1.0f / (float)(have < w ? have : w);
                float d[8];
#pragma unroll
                for (int e = 0; e < 8; ++e) { sum[e] += cur[e]; d[e] = sum[e] * inv - cur[e]; }
                u32x4 o; o.x = cvt_pk_bf16(d[0], d[1]); o.y = cvt_pk_bf16(d[2], d[3]); o.z = cvt_pk_bf16(d[4], d[5]); o.w = cvt_pk_bf16(d[6], d[7]);
                *(u32x4*)(dp + (size_t)r * DPOOL) = o;
                if (have >= w) { const u32x4 q = *(const u32x4*)(up + (ptrdiff_t)(r - w + 1) * DIN);
                    sum[0] -= bf_lo(q.x); sum[1] -= bf_hi(q.x); sum[2] -= bf_lo(q.y); sum[3] -= bf_hi(q.y); sum[4] -= bf_lo(q.z); sum[5] -= bf_hi(q.z); sum[6] -= bf_lo(q.w); sum[7] -= bf_hi(q.w); }
            }
        }
        LAS float* tab = (LAS float*)lds;
        for (int bh = bx; bh < BATCH * 16; bh += G) {
            const int b = bh >> 4, h = bh & 15;
            __syncthreads();
            for (int i = tid; i < NREL; i += 512) tab[i] = P.rel_bias[h * NREL + i] * LOG2E;
            __syncthreads();
#pragma nounroll
            for (int i = 0; i < 8; ++i) {
                const int c = i * 4 + (wave >> 1), half = wave & 1, j0 = c < 8 ? 8 - c : 0, kstart = (c - 8 + j0) * 64;
                const size_t qrow = (size_t)b * SEQ + c * 64 + half * 32;
#ifndef NO_ATT5
                attn_wave32<64, true, 2, true>(Z + qrow * DIN + h * 64, DIN, Z + ((size_t)b * SEQ + kstart) * DIN + DATT + h * 64, DIN,
                                      VT + ((size_t)b * DATT + h * 64) * SEQ + kstart, SEQ, Y + qrow * DM + h * 64, DM, 9 - j0, 0.125f * LOG2E, tab, half * 32 + (8 - j0) * 64, lane);
#endif
            }
        }
        __syncthreads();
    }
    grid.sync();
    RUN_GEMM(pg8::EpiBf, MTOK, DPOOL, (pg8::Gemm{DP, Wp, DPOOL, 256, 256, 512}), (pg8::EpiBf{Y, DM, DATT, nullptr, P.pool_scale, 0, 0, 1, 1, nullptr}));
    grid.sync();
    RUN_GEMM(pg8::EpiRes, MTOK, DM, (pg8::Gemm{Y, Wout, DM, DM, DM, 0}), (pg8::EpiRes{P.out, P.out, HB, rowss + 2 * MTOK, 1.0f}));
    grid.sync();
    RUN_GEMM(pg8::EpiBf, MTOK, DCROSS, (pg8::Gemm{HB, Wcq, DM, DM, DM, 0}), (pg8::EpiBf{CQ, DCROSS, 0, rowss + 2 * MTOK, nullptr, 0, 0, 1, 1, nullptr}));
    grid.sync();
    {
        for (int it = bx; it < BATCH * 16; it += G) {
            const int b = it >> 4, sub = it & 15;
#pragma nounroll
            for (int r = 0; r < 4; ++r) {
                const int wu = r * 8 + wave, head = wu & 3, qblk = wu >> 2;
                const size_t qrow = (size_t)b * SEQ + sub * 128 + qblk * 16;
#ifndef NO_ATT9
                attn_wave32<128, false, 1, false>(CQ + qrow * DCROSS + head * 128, DCROSS, KC + (size_t)b * NMEM * DCROSS + head * 128, DCROSS,
                                        VCT + ((size_t)b * DCROSS + head * 128) * NMEM, NMEM, CO + qrow * DCROSS + head * 128, DCROSS, 4, 0.08838834764831845f * LOG2E, nullptr, 0, lane);
#endif
            }
        }
    }
    grid.sync();
    RUN_GEMM(pg8::EpiRes, MTOK, DM, (pg8::Gemm{CO, Wco, DCROSS, DCROSS, DCROSS, 0}), (pg8::EpiRes{P.out, P.out, HB, rowss + 3 * MTOK, 1.0f}));
    grid.sync();
    RUN_GEMM(pg8::EpiSwiglu, MTOK, 2 * DFF, (pg8::Gemm{HB, Wgu2, DM, DM, DM, 0}), (pg8::EpiSwiglu{ACT, DFF, rowss + 3 * MTOK}));
    grid.sync();
    RUN_GEMM(pg8::EpiRes, MTOK, DM, (pg8::Gemm{ACT, Wd2, DFF, DFF, DFF, 0}), (pg8::EpiRes{P.out, P.out, nullptr, rowss + 4 * MTOK, 0.5f}));
    grid.sync();
    {
        const float* rs4 = rowss + 4 * MTOK;
        for (int m = gw; m < MTOK; m += NGW) {
            f32x4* xr = (f32x4*)(P.out + (size_t)m * DM) + lane; const f32x4* gr = (const f32x4*)P.final_norm + lane;
            const float rs = __builtin_amdgcn_rsqf(rs4[m] * (1.0f / DM) + EPS);
#pragma unroll
            for (int j = 0; j < 8; ++j) { const f32x4 v = xr[64 * j]; xr[64 * j] = v * rs * gr[64 * j]; }
        }
    }
#undef RUN_GEMM
}

extern "C" void kernel_launch(void* const* d_in, const int* in_sizes, int n_in, void* d_out, int out_size, void* d_ws, size_t ws_size, hipStream_t stream) {
    static int grid_blocks = 0;
    if (grid_blocks == 0) {
        if (n_in != 22 || in_sizes[0] != MTOK * DM || out_size != MTOK * DM || ws_size < WS_END) {
            fprintf(stderr, "kernel_launch: unexpected shapes (n_in %d, in0 %d, out %d, ws %zu)\n", n_in, n_in > 0 ? in_sizes[0] : -1, out_size, ws_size); grid_blocks = -1; return; }
        int dev = 0, cus = 0, per_cu = 0;
        hipGetDevice(&dev);
        hipDeviceGetAttribute(&cus, hipDeviceAttributeMultiprocessorCount, dev);
        if (hipFuncSetAttribute((const void*)fwd_megakernel, hipFuncAttributeMaxDynamicSharedMemorySize, LDS_BYTES) != hipSuccess) { fprintf(stderr, "kernel_launch: hipFuncSetAttribute failed\n"); grid_blocks = -1; return; }
        if (hipOccupancyMaxActiveBlocksPerMultiprocessor(&per_cu, (const void*)fwd_megakernel, 512, LDS_BYTES) != hipSuccess || per_cu < 1) { fprintf(stderr, "kernel_launch: occupancy query gave %d\n", per_cu); per_cu = 1; }
        (void)hipGetLastError();
        grid_blocks = cus * per_cu;
    }
    if (grid_blocks < 0) return;
    Params p{};
    const float* const* in = (const float* const*)d_in;
    p.x = in[0]; p.mem = in[1]; p.ffn1_norm = in[2]; p.ffn1_wg = in[3]; p.ffn1_wu = in[4]; p.ffn1_wd = in[5]; p.mix_norm = in[6]; p.w_in = in[7]; p.rel_bias = in[8];
    p.w_pool = in[9]; p.pool_scale = in[10]; p.w_out = in[11]; p.cross_norm = in[12]; p.mem_norm = in[13]; p.w_cq = in[14]; p.w_ckv = in[15]; p.w_co = in[16];
    p.ffn2_norm = in[17]; p.ffn2_wg = in[18]; p.ffn2_wu = in[19]; p.ffn2_wd = in[20]; p.final_norm = in[21];
    p.out = (float*)d_out; p.ws = (unsigned char*)d_ws;
    void* args[] = {&p};
    hipError_t e = hipLaunchCooperativeKernel((const void*)fwd_megakernel, dim3(grid_blocks), dim3(512), args, LDS_BYTES, stream);
    if (e != hipSuccess) fprintf(stderr, "cooperative launch failed: %s (grid %d)\n", hipGetErrorString(e), grid_blocks);
}
```

```cpp
#include <hip/hip_runtime.h>
#include <hip/hip_cooperative_groups.h>
#include <cstdio>
#include <cstdint>
namespace cg = cooperative_groups;

#define LAS __attribute__((address_space(3)))
typedef unsigned short bf16_t;
typedef short bf16x8 __attribute__((ext_vector_type(8)));
typedef float f32x4 __attribute__((ext_vector_type(4)));
typedef float f32x2 __attribute__((ext_vector_type(2)));
typedef unsigned u32x4 __attribute__((ext_vector_type(4)));
typedef unsigned u32x2 __attribute__((ext_vector_type(2)));

constexpr int BATCH = 16, SEQ = 2048, DM = 2048, MTOK = BATCH * SEQ;
constexpr int DFF = 5632, DIN = 4096, DATT = 1024, DPOOL = 1024, NMEM = 256, DCROSS = 512;
constexpr int NREL = 257;
constexpr float EPS = 1e-6f;
constexpr float LOG2E = 1.4426950408889634f;

constexpr size_t MiB = 1u << 20;
constexpr size_t WS_ROWSS = 0;
constexpr size_t WS_WGU1 = 1 * MiB, WS_WD1 = 45 * MiB, WS_WIN = 67 * MiB, WS_WP = 83 * MiB, WS_WOUT = 84 * MiB, WS_WCQ = 92 * MiB,
                 WS_WCKV = 94 * MiB, WS_WCO = 98 * MiB, WS_WGU2 = 100 * MiB, WS_WD2 = 144 * MiB;
constexpr size_t WS_HB = 166 * MiB;
constexpr size_t WS_ACT = 294 * MiB;
constexpr size_t WS_Z = 294 * MiB;
constexpr size_t WS_VT = 550 * MiB;
constexpr size_t WS_Y = 646 * MiB;
constexpr size_t WS_CQ = 646 * MiB, WS_CO = 678 * MiB;
constexpr size_t WS_DP = 774 * MiB;
constexpr size_t WS_MEMN = 838 * MiB;
constexpr size_t WS_KC = 854 * MiB;
constexpr size_t WS_VCT = 858 * MiB;
constexpr size_t WS_END = 862 * MiB;

#ifndef REP_G1NULL
#define REP_G1NULL 0
#endif
#ifndef REP_SYNC
#define REP_SYNC 0
#endif
#ifndef REP_G2
#define REP_G2 0
#endif
#ifndef REP_P0
#define REP_P0 1
#endif
#ifndef REP_G1
#define REP_G1 1
#endif
#ifndef REP_ATT
#define REP_ATT 1
#endif
#ifndef REP_G3
#define REP_G3 1
#endif
constexpr int LDS_BYTES = 147456;

__device__ __forceinline__ unsigned cvt_pk_bf16(float lo, float hi) { unsigned r; asm volatile("v_cvt_pk_bf16_f32 %0, %1, %2" : "=v"(r) : "v"(lo), "v"(hi)); return r; }
__device__ __forceinline__ float bf_lo(unsigned w) { return __uint_as_float(w << 16); }
__device__ __forceinline__ float bf_hi(unsigned w) { return __uint_as_float(w & 0xffff0000u); }
__device__ __forceinline__ float wave_sum(float v) {
#pragma unroll
    for (int o = 1; o < 64; o <<= 1) v += __shfl_xor(v, o);
    return v;
}

namespace pg8 {
constexpr int BM = 256, BK = 64, HALF = 128, HTB = HALF * BK * 2, STAGE_BYTES = 8 * HTB, NXCD = 8, WGM = 8;
__host__ __device__ __forceinline__ int lds_byte(int r, int c) { const int st = (r >> 4) * 2 + (c >> 5), rr = r & 15, cc = c & 31, ob = rr * 64 + cc * 2; return st * 1024 + (ob ^ (((ob >> 9) & 1) << 5)); }
__host__ __device__ __forceinline__ void stage_rc(int b, int& R, int& C) { const int st = b / 1024, sb = b % 1024, swz = sb ^ (((sb >> 9) & 1) << 5); R = (st >> 1) * 16 + swz / 64; C = (st & 1) * 32 + (swz % 64) / 2; }
__host__ __device__ __forceinline__ int perm32(int rho) { const int n = rho >> 4, i = rho & 15; return 8 * (i >> 2) + 4 * n + (i & 3); }

struct Unit { int pm, pn; };
struct Gemm { const bf16_t* A; const bf16_t* Bt; int lda, ldb, K, a_pn_step; };

struct StaticOrder {
    int nM, nN, nwg, G, c;
    __device__ void init(int M, int N, int G_, int c_) { nM = M / BM; nN = N / BM; nwg = nM * nN; G = G_; c = c_; }
    __device__ bool next(int i, Unit& u) const {
        const long L = (long)i * G + c; if (L >= nwg) return false;
        int wgid = (int)L; { const int q = nwg / NXCD, r = nwg % NXCD, xcd = wgid % NXCD, off = wgid / NXCD; wgid = (xcd < r ? xcd * (q + 1) : r * (q + 1) + (xcd - r) * q) + off; }
        const int nig = WGM * nN, gid = wgid / nig, fm = gid * WGM, gsz = (nM - fm) < WGM ? (nM - fm) : WGM;
        u.pm = fm + ((wgid % nig) % gsz); u.pn = (wgid % nig) / gsz; return true;
    }
};

struct EpiBf {
    bf16_t* O; int ldc; int col_off; const float* rowss; const float* colscale; int t_lo, t_hi, t_rows, t_cols; bf16_t* VT;
    __device__ __forceinline__ void operator()(const f32x4 (&acc)[2][2][4][2], const Unit& u, int wr, int wc, int fr, int fq) const {
        const int row0 = u.pm * BM + wr * 64 + fr, cl = wc * 32 + 8 * fq;
        const bool tr = (u.pn >= t_lo) && (u.pn < t_hi);
        f32x4 cs[2][2]; float rsv[8];
#pragma unroll
        for (int bj = 0; bj < 2; ++bj)
#pragma unroll
            for (int n = 0; n < 2; ++n) cs[bj][n] = colscale ? *(const f32x4*)(colscale + u.pn * BM + bj * HALF + cl + 4 * n) : (f32x4){1.f, 1.f, 1.f, 1.f};
#pragma unroll
        for (int i = 0; i < 8; ++i) rsv[i] = rowss ? rowss[row0 + (i >> 2) * HALF + (i & 3) * 16] : 0.f;
        asm volatile("" ::: "memory");
#pragma unroll
        for (int ai = 0; ai < 2; ++ai)
#pragma unroll
            for (int m = 0; m < 4; ++m) {
                const int row = row0 + ai * HALF + m * 16;
                const float rsc = rowss ? __builtin_amdgcn_rsqf(rsv[ai * 4 + m] * (1.0f / DM) + EPS) : 1.0f;
#pragma unroll
                for (int bj = 0; bj < 2; ++bj) {
                    const f32x4 v0 = acc[ai][bj][m][0] * rsc * cs[bj][0], v1 = acc[ai][bj][m][1] * rsc * cs[bj][1];
                    u32x4 w; w.x = cvt_pk_bf16(v0[0], v0[1]); w.y = cvt_pk_bf16(v0[2], v0[3]); w.z = cvt_pk_bf16(v1[0], v1[1]); w.w = cvt_pk_bf16(v1[2], v1[3]);
                    if (!tr) { *(u32x4*)(O + (size_t)row * ldc + col_off + u.pn * BM + bj * HALF + cl) = w; }
                    else {
                        const int cv = (u.pn - t_lo) * BM + bj * HALF + cl, b = row / t_rows, s = row - b * t_rows;
                        bf16_t* p = VT + ((size_t)b * t_cols + cv) * t_rows + s;
                        p[0] = (bf16_t)(w.x & 0xffffu); p[(size_t)t_rows] = (bf16_t)(w.x >> 16); p[(size_t)2 * t_rows] = (bf16_t)(w.y & 0xffffu); p[(size_t)3 * t_rows] = (bf16_t)(w.y >> 16);
                        p[(size_t)4 * t_rows] = (bf16_t)(w.z & 0xffffu); p[(size_t)5 * t_rows] = (bf16_t)(w.z >> 16); p[(size_t)6 * t_rows] = (bf16_t)(w.w & 0xffffu); p[(size_t)7 * t_rows] = (bf16_t)(w.w >> 16);
                    }
                }
            }
    }
};
__device__ __forceinline__ float silu_mul(float g, float u) { return g * __builtin_amdgcn_rcpf(1.0f + __expf(-g)) * u; }
struct EpiSwiglu {
    bf16_t* O; int ldc; const float* rowss;
    __device__ __forceinline__ void operator()(const f32x4 (&acc)[2][2][4][2], const Unit& u, int wr, int wc, int fr, int fq) const {
        const int row0 = u.pm * BM + wr * 64 + fr, cl = wc * 32 + 8 * fq;
        float rsv[8];
#pragma unroll
        for (int i = 0; i < 8; ++i) rsv[i] = rowss[row0 + (i >> 2) * HALF + (i & 3) * 16];
        asm volatile("" ::: "memory");
#pragma unroll
        for (int ai = 0; ai < 2; ++ai)
#pragma unroll
            for (int m = 0; m < 4; ++m) {
                const int row = row0 + ai * HALF + m * 16;
                const float rsc = __builtin_amdgcn_rsqf(rsv[ai * 4 + m] * (1.0f / DM) + EPS);
                const f32x4 g0 = acc[ai][0][m][0] * rsc, g1 = acc[ai][0][m][1] * rsc, u0 = acc[ai][1][m][0] * rsc, u1 = acc[ai][1][m][1] * rsc;
                u32x4 w;
                w.x = cvt_pk_bf16(silu_mul(g0[0], u0[0]), silu_mul(g0[1], u0[1])); w.y = cvt_pk_bf16(silu_mul(g0[2], u0[2]), silu_mul(g0[3], u0[3]));
                w.z = cvt_pk_bf16(silu_mul(g1[0], u1[0]), silu_mul(g1[1], u1[1])); w.w = cvt_pk_bf16(silu_mul(g1[2], u1[2]), silu_mul(g1[3], u1[3]));
                *(u32x4*)(O + (size_t)row * ldc + u.pn * HALF + cl) = w;
            }
    }
};
template <bool F32IN> struct EpiRes {
    const float* hin_f; bf16_t* hb; float* rowss_out; float alpha;
    static constexpr int DEPTH = F32IN ? 2 : 4, NV = F32IN ? 4 : 2;
    __device__ __forceinline__ void ld(f32x4 (&hv)[4], size_t off) const {
        if (F32IN) { hv[0] = *(const f32x4*)(hin_f + off); hv[1] = *(const f32x4*)(hin_f + off + 4); hv[2] = *(const f32x4*)(hin_f + off + HALF); hv[3] = *(const f32x4*)(hin_f + off + HALF + 4); }
        else { hv[0] = __builtin_bit_cast(f32x4, *(const u32x4*)(hb + off)); hv[1] = __builtin_bit_cast(f32x4, *(const u32x4*)(hb + off + HALF)); }
    }
    __device__ __forceinline__ void operator()(const f32x4 (&acc)[2][2][4][2], const Unit& u, int wr, int wc, int fr, int fq) const {
        const int row0 = u.pm * BM + wr * 64 + fr, cl = u.pn * BM + wc * 32 + 8 * fq;
        f32x4 hv[DEPTH][4];
#pragma unroll
        for (int gi = 0; gi < DEPTH; ++gi) ld(hv[gi], (size_t)(row0 + (gi >> 2) * HALF + (gi & 3) * 16) * DM + cl);
#pragma unroll
        for (int gi = 0; gi < 8; ++gi) {
            const int ai = gi >> 2, m = gi & 3, cb = gi % DEPTH;
            asm volatile("" ::: "memory");
            const int row = row0 + ai * HALF + m * 16; const size_t off = (size_t)row * DM + cl;
            float ss = 0.f;
            u32x4 wv[2];
#pragma unroll
            for (int bj = 0; bj < 2; ++bj) {
                f32x4 o0, o1;
                if (F32IN) { o0 = hv[cb][2 * bj]; o1 = hv[cb][2 * bj + 1]; }
                else { const u32x4 q = __builtin_bit_cast(u32x4, hv[cb][bj]); o0 = (f32x4){bf_lo(q.x), bf_hi(q.x), bf_lo(q.y), bf_hi(q.y)}; o1 = (f32x4){bf_lo(q.z), bf_hi(q.z), bf_lo(q.w), bf_hi(q.w)}; }
                const f32x4 h0 = o0 + acc[ai][bj][m][0] * alpha, h1 = o1 + acc[ai][bj][m][1] * alpha;
                ss += (h0[0] * h0[0] + h0[1] * h0[1]) + (h0[2] * h0[2] + h0[3] * h0[3]) + (h1[0] * h1[0] + h1[1] * h1[1]) + (h1[2] * h1[2] + h1[3] * h1[3]);
                wv[bj].x = cvt_pk_bf16(h0[0], h0[1]); wv[bj].y = cvt_pk_bf16(h0[2], h0[3]); wv[bj].z = cvt_pk_bf16(h1[0], h1[1]); wv[bj].w = cvt_pk_bf16(h1[2], h1[3]);
            }
            if (gi + DEPTH < 8) ld(hv[cb], (size_t)(row0 + ((gi + DEPTH) >> 2) * HALF + ((gi + DEPTH) & 3) * 16) * DM + cl);
            *(u32x4*)(hb + off) = wv[0]; *(u32x4*)(hb + off + HALF) = wv[1];
            ss += __shfl_xor(ss, 16); ss += __shfl_xor(ss, 32);
            if (rowss_out && fq == 0) unsafeAtomicAdd(rowss_out + row, ss);
        }
    }
};

struct EpiNull {
    __device__ __forceinline__ void operator()(const f32x4 (&acc)[2][2][4][2], const Unit& u, int wr, int wc, int fr, int fq) const {
#pragma unroll
        for (int ai = 0; ai < 2; ++ai)
#pragma unroll
            for (int bj = 0; bj < 2; ++bj)
#pragma unroll
                for (int m = 0; m < 4; ++m) asm volatile("" :: "v"(acc[ai][bj][m][0]), "v"(acc[ai][bj][m][1]));
    }
};

template <class Epi, bool ALIGN_EPI = true>
__device__ __forceinline__ void gemm_phase(LAS unsigned char* lds, const Gemm g, const StaticOrder& S, const Epi& E) {
    int tid_l = threadIdx.x; asm volatile("" : "+v"(tid_l));
    const int tid = tid_l, wid = __builtin_amdgcn_readfirstlane(tid >> 6), lane = tid & 63, wr = wid >> 2, wc = wid & 3, fr = lane & 15, fq = lane >> 4;
    const int K = g.K, nt = K / BK;
    unsigned voffA[2], voffB[2];
#pragma unroll
    for (int i = 0; i < 2; ++i) { int R, C; stage_rc(tid * 16 + i * 8192, R, C); const int Rb = (R & ~31) + perm32(R & 31);
        voffA[i] = (unsigned)(R * g.lda + C) * 2u; voffB[i] = (unsigned)(Rb * g.ldb + C) * 2u; }
    const size_t kstep = (size_t)(BK * 2);
    const size_t hstepA = (size_t)HALF * g.lda * 2, hstepB = (size_t)HALF * g.ldb * 2;
    const size_t tstepA = 2 * hstepA, tstepB = 2 * hstepB;
    const unsigned ldsw = (unsigned)wid * 1024u;
    const int aoff = lds_byte(wr * 64 + fr, fq * 8), boff = lds_byte(wc * 32 + fr, fq * 8);
#define PG8_SA(b, h) (((b) * 2 + (h)) * HTB)
#define PG8_SB(b, h) ((4 + (b) * 2 + (h)) * HTB)
#define PG8_STAGE(bufoff, gbase, voff) do { _Pragma("unroll") for (int _i = 0; _i < 2; ++_i) \
        __builtin_amdgcn_global_load_lds((const unsigned*)((const char*)(gbase) + (voff)[_i]), (LAS unsigned*)(lds + (bufoff) + ldsw + _i * 8192), 16, 0, 0); } while (0)
#define PG8_LDA(dst, b, h) do { _Pragma("unroll") for (int m = 0; m < 4; ++m) _Pragma("unroll") for (int k = 0; k < 2; ++k) dst[m][k] = *(const LAS bf16x8*)(lds + PG8_SA(b, h) + aoff + m * 2048 + k * 1024); } while (0)
#define PG8_LDB(dst, b, h) do { _Pragma("unroll") for (int n = 0; n < 2; ++n) _Pragma("unroll") for (int k = 0; k < 2; ++k) dst[n][k] = *(const LAS bf16x8*)(lds + PG8_SB(b, h) + boff + n * 2048 + k * 1024); } while (0)
#define PG8_MMA(ai, bj, At, Bt) do { __builtin_amdgcn_s_setprio(1); _Pragma("unroll") for (int m = 0; m < 4; ++m) _Pragma("unroll") for (int n = 0; n < 2; ++n) _Pragma("unroll") for (int k = 0; k < 2; ++k) \
        acc[ai][bj][m][n] = __builtin_amdgcn_mfma_f32_16x16x32_bf16(Bt[n][k], At[m][k], acc[ai][bj][m][n], 0, 0, 0); __builtin_amdgcn_s_setprio(0); } while (0)
#define PG8_WAIT_V(n) asm volatile("s_waitcnt vmcnt(" #n ")" ::: "memory")
#define PG8_WAIT_L(n) asm volatile("s_waitcnt lgkmcnt(" #n ")" ::: "memory")
#define PG8_BAR __builtin_amdgcn_s_barrier()
#define PG8_SCHED __builtin_amdgcn_sched_barrier(0)
    Unit cur, nxt; int ui = 0;
    if (!S.next(0, cur)) return;
    f32x4 acc[2][2][4][2];
#pragma unroll
    for (int a = 0; a < 2; ++a)
#pragma unroll
        for (int b = 0; b < 2; ++b)
#pragma unroll
            for (int m = 0; m < 4; ++m)
#pragma unroll
                for (int n = 0; n < 2; ++n) acc[a][b][m][n] = (f32x4){0.f, 0.f, 0.f, 0.f};
    bf16x8 At[4][2], B0[2][2], B1[2][2];
    const char* cA = (const char*)g.A + (size_t)cur.pm * tstepA + (size_t)cur.pn * g.a_pn_step; const char* cB = (const char*)g.Bt + (size_t)cur.pn * tstepB;
    PG8_STAGE(PG8_SB(0, 0), cB, voffB); PG8_STAGE(PG8_SB(0, 1), cB + hstepB, voffB); PG8_STAGE(PG8_SA(0, 0), cA, voffA); PG8_STAGE(PG8_SA(0, 1), cA + hstepA, voffA);
    if (wr == 1) PG8_BAR;
    PG8_WAIT_V(2); PG8_BAR;
    PG8_STAGE(PG8_SB(1, 0), cB + kstep, voffB); PG8_STAGE(PG8_SA(1, 0), cA + kstep, voffA); PG8_STAGE(PG8_SB(1, 1), cB + hstepB + kstep, voffB);
    PG8_WAIT_V(6); PG8_BAR;
    for (;;) {
        const bool has_next = S.next(ui + 1, nxt);
        const char* nA = has_next ? (const char*)g.A + (size_t)nxt.pm * tstepA + (size_t)nxt.pn * g.a_pn_step : cA; const char* nB = has_next ? (const char*)g.Bt + (size_t)nxt.pn * tstepB : cB;
        for (int t = 0; t < nt; t += 2) {
            const bool last = (t == nt - 2);
            const char* a1 = cA + (size_t)(t + 1) * kstep;
            const char* a2 = last ? nA : cA + (size_t)(t + 2) * kstep; const char* b2 = last ? nB : cB + (size_t)(t + 2) * kstep;
            const char* a3 = a2 + kstep; const char* b3 = b2 + kstep;
            PG8_LDB(B0, 0, 0); PG8_LDB(B1, 0, 1); PG8_SCHED; PG8_LDA(At, 0, 0); PG8_STAGE(PG8_SA(1, 1), a1 + hstepA, voffA);
            PG8_WAIT_V(8); PG8_WAIT_L(0); PG8_BAR; PG8_MMA(0, 0, At, B0); PG8_MMA(0, 1, At, B1); PG8_BAR; PG8_SCHED;
            PG8_LDA(At, 0, 1); PG8_STAGE(PG8_SB(0, 0), b2, voffB); PG8_STAGE(PG8_SB(0, 1), b2 + hstepB, voffB); PG8_STAGE(PG8_SA(0, 0), a2, voffA);
            PG8_WAIT_V(8); PG8_WAIT_L(0); PG8_BAR; PG8_MMA(1, 0, At, B0); PG8_MMA(1, 1, At, B1); PG8_BAR; PG8_SCHED;
            PG8_LDB(B0, 1, 0); PG8_LDB(B1, 1, 1); PG8_SCHED; PG8_LDA(At, 1, 0); PG8_STAGE(PG8_SA(0, 1), a2 + hstepA, voffA);
            PG8_WAIT_V(8); PG8_WAIT_L(0); PG8_BAR; PG8_MMA(0, 0, At, B0); PG8_MMA(0, 1, At, B1); PG8_BAR; PG8_SCHED;
            PG8_LDA(At, 1, 1); PG8_STAGE(PG8_SB(1, 0), b3, voffB); PG8_STAGE(PG8_SB(1, 1), b3 + hstepB, voffB); PG8_STAGE(PG8_SA(1, 0), a3, voffA);
            PG8_WAIT_V(8); PG8_WAIT_L(0); PG8_BAR; PG8_MMA(1, 0, At, B0); PG8_MMA(1, 1, At, B1); PG8_BAR; PG8_SCHED;
        }
        if constexpr (ALIGN_EPI) { if (wr == 0) PG8_BAR; }
        E(acc, cur, wr, wc, fr, fq);
        if (!has_next) break;
#pragma unroll
        for (int a = 0; a < 2; ++a)
#pragma unroll
            for (int b = 0; b < 2; ++b)
#pragma unroll
                for (int m = 0; m < 4; ++m)
#pragma unroll
                    for (int n = 0; n < 2; ++n) acc[a][b][m][n] = (f32x4){0.f, 0.f, 0.f, 0.f};
        cur = nxt; cA = nA; cB = nB; ++ui;
        if constexpr (ALIGN_EPI) { if (wr == 1) PG8_BAR; }
    }
    PG8_WAIT_V(0);
    if constexpr (!ALIGN_EPI) { if (wr == 0) PG8_BAR; }
    PG8_BAR;
#undef PG8_SA
#undef PG8_SB
#undef PG8_STAGE
#undef PG8_LDA
#undef PG8_LDB
#undef PG8_MMA
#undef PG8_WAIT_V
#undef PG8_WAIT_L
#undef PG8_BAR
#undef PG8_SCHED
}
}

template <int DH, bool BIAS, int NT, bool PF>
__device__ __forceinline__ void attn_wave32(const bf16_t* __restrict__ Qp, int ldq, const bf16_t* __restrict__ Kp, int ldk, const bf16_t* __restrict__ Vp, int ldv,
                                            bf16_t* __restrict__ Op, int ldo, int ntiles, float sc, const LAS float* tab, int rel_base, int lane) {
    constexpr int KS = DH / 32, DT = DH / 16;
    asm volatile("" : "+v"(lane));
    const int fr = lane & 15, fq = lane >> 4;
    bf16x8 qf[NT][KS];
#pragma unroll
    for (int nt = 0; nt < NT; ++nt)
#pragma unroll
        for (int ks = 0; ks < KS; ++ks) qf[nt][ks] = *(const bf16x8*)(Qp + (size_t)(nt * 16 + fr) * ldq + ks * 32 + fq * 8);
    f32x4 o[DT][NT];
#pragma unroll
    for (int dt = 0; dt < DT; ++dt)
#pragma unroll
        for (int nt = 0; nt < NT; ++nt) o[dt][nt] = (f32x4){0.f, 0.f, 0.f, 0.f};
    float mrun[NT], lrun[NT];
#pragma unroll
    for (int nt = 0; nt < NT; ++nt) { mrun[nt] = -1e30f; lrun[nt] = 0.f; }
    const bf16_t* kbase = Kp + (size_t)(8 * (fr >> 2) + (fr & 3)) * ldk + fq * 8;
    const bf16_t* vbase = Vp + (size_t)fr * ldv + fq * 8;
    bf16x8 kf[4][KS], vfA[DT][2], vfB[DT][2];
#define ATT_LOADK(tt) do { _Pragma("unroll") for (int mt = 0; mt < 4; ++mt) _Pragma("unroll") for (int ks = 0; ks < KS; ++ks) \
        kf[mt][ks] = *(const bf16x8*)(kbase + (size_t)((tt) * 64 + (mt >> 1) * 32 + 4 * (mt & 1)) * ldk + ks * 32); } while (0)
#define ATT_LOADV(dst, tt) do { _Pragma("unroll") for (int dt = 0; dt < DT; ++dt) _Pragma("unroll") for (int kb = 0; kb < 2; ++kb) \
        dst[dt][kb] = *(const bf16x8*)(vbase + (size_t)(dt * 16) * ldv + (tt) * 64 + kb * 32); } while (0)
#define ATT_BODY(t, vcur, vnext) do { \
        const int tn_ = ((t) + 1 < ntiles) ? (t) + 1 : (t); \
        if (PF) ATT_LOADV(vnext, tn_); else ATT_LOADK(t); \
        f32x4 s[4][NT]; \
        _Pragma("unroll") for (int mt = 0; mt < 4; ++mt) _Pragma("unroll") for (int nt = 0; nt < NT; ++nt) { s[mt][nt] = (f32x4){0.f, 0.f, 0.f, 0.f}; \
            _Pragma("unroll") for (int ks = 0; ks < KS; ++ks) s[mt][nt] = __builtin_amdgcn_mfma_f32_16x16x32_bf16(kf[mt][ks], qf[nt][ks], s[mt][nt], 0, 0, 0); } \
        if (PF) ATT_LOADK(tn_); \
        bf16x8 pf[NT][2]; \
        const int relt = rel_base - 64 * (t); \
        const bool cbias = BIAS && (relt - 63 >= 128); \
        _Pragma("unroll") for (int nt = 0; nt < NT; ++nt) { \
            float mloc = -1e30f; \
            _Pragma("unroll") for (int mt = 0; mt < 4; ++mt) _Pragma("unroll") for (int j = 0; j < 4; ++j) { \
                float v = s[mt][nt][j] * sc; \
                if (BIAS) { if (cbias) v += tab[256]; \
                    else { int rel = relt + (nt * 16 + fr) - ((mt >> 1) * 32 + 8 * fq + 4 * (mt & 1) + j); rel = rel < -128 ? -128 : (rel > 128 ? 128 : rel); v += tab[rel + 128]; } } \
                s[mt][nt][j] = v; mloc = fmaxf(mloc, v); } \
            mloc = fmaxf(mloc, __shfl_xor(mloc, 16)); mloc = fmaxf(mloc, __shfl_xor(mloc, 32)); \
            const float mnew = fmaxf(mrun[nt], mloc), alpha = __builtin_amdgcn_exp2f(mrun[nt] - mnew); \
            mrun[nt] = mnew; \
            float ls = 0.f; \
            _Pragma("unroll") for (int mt = 0; mt < 4; ++mt) _Pragma("unroll") for (int j = 0; j < 4; ++j) { const float p = __builtin_amdgcn_exp2f(s[mt][nt][j] - mnew); s[mt][nt][j] = p; ls += p; } \
            lrun[nt] = lrun[nt] * alpha + ls; \
            _Pragma("unroll") for (int dt = 0; dt < DT; ++dt) o[dt][nt] = o[dt][nt] * alpha; \
            _Pragma("unroll") for (int kb = 0; kb < 2; ++kb) { \
                u32x4 w; w.x = cvt_pk_bf16(s[2 * kb][nt][0], s[2 * kb][nt][1]); w.y = cvt_pk_bf16(s[2 * kb][nt][2], s[2 * kb][nt][3]); \
                w.z = cvt_pk_bf16(s[2 * kb + 1][nt][0], s[2 * kb + 1][nt][1]); w.w = cvt_pk_bf16(s[2 * kb + 1][nt][2], s[2 * kb + 1][nt][3]); \
                pf[nt][kb] = __builtin_bit_cast(bf16x8, w); } } \
        if (!PF) { asm volatile("" ::: "memory"); ATT_LOADV(vcur, t); } \
        _Pragma("unroll") for (int dt = 0; dt < DT; ++dt) _Pragma("unroll") for (int nt = 0; nt < NT; ++nt) _Pragma("unroll") for (int kb = 0; kb < 2; ++kb) \
            o[dt][nt] = __builtin_amdgcn_mfma_f32_16x16x32_bf16(vcur[dt][kb], pf[nt][kb], o[dt][nt], 0, 0, 0); \
    } while (0)
    if (PF) { ATT_LOADK(0); ATT_LOADV(vfA, 0);
#pragma nounroll
        for (int t = 0; t < ntiles; t += 2) {
            ATT_BODY(t, vfA, vfB);
            if (t + 1 < ntiles) ATT_BODY(t + 1, vfB, vfA);
        }
    } else {
#pragma nounroll
        for (int t = 0; t < ntiles; ++t) ATT_BODY(t, vfA, vfB);
    }
#undef ATT_BODY
#undef ATT_LOADK
#undef ATT_LOADV
#pragma unroll
    for (int nt = 0; nt < NT; ++nt) {
        float l = lrun[nt]; l += __shfl_xor(l, 16); l += __shfl_xor(l, 32);
        const float inv = 1.0f / l;
#pragma unroll
        for (int dt = 0; dt < DT; ++dt) {
            const f32x4 v = o[dt][nt] * inv; u32x2 w; w.x = cvt_pk_bf16(v[0], v[1]); w.y = cvt_pk_bf16(v[2], v[3]);
            *(u32x2*)(Op + (size_t)(nt * 16 + fr) * ldo + dt * 16 + 4 * fq) = w;
        }
    }
}

struct Params {
    const float* x; const float* mem;
    const float* ffn1_norm; const float* ffn1_wg; const float* ffn1_wu; const float* ffn1_wd;
    const float* mix_norm; const float* w_in; const float* rel_bias; const float* w_pool; const float* pool_scale; const float* w_out;
    const float* cross_norm; const float* mem_norm; const float* w_cq; const float* w_ckv; const float* w_co;
    const float* ffn2_norm; const float* ffn2_wg; const float* ffn2_wu; const float* ffn2_wd; const float* final_norm;
    float* out; unsigned char* ws;
};

__device__ __forceinline__ void p0_transpose_item(const float* __restrict__ W, int K, int N, bf16_t* __restrict__ WT, int mode, int row_off, const float* __restrict__ gain, LAS float* scr, int item, int lane) {
    const int nblk = N / 32, kb = item / nblk, nb = item - kb * nblk, k0 = 64 * kb, n0 = 32 * nb;
#pragma unroll 8
    for (int i = 0; i < 32; ++i) { const int kk = 2 * i + (lane >> 5); const float gk = gain ? gain[k0 + kk] : 1.0f; scr[kk * 33 + (lane & 31)] = W[(size_t)(k0 + kk) * N + n0 + (lane & 31)] * gk; }
    asm volatile("s_waitcnt lgkmcnt(0)" ::: "memory");
    const int c = lane & 7;
    const int d0 = (mode == 0) ? (row_off + n0) : ((n0 >> 7) * 256 + (n0 & 127) + (mode == 2 ? 128 : 0));
#pragma unroll
    for (int j = 0; j < 4; ++j) { const int n = (lane >> 3) + 8 * j; const LAS float* s = scr + (8 * c) * 33 + n;
        u32x4 o; o.x = cvt_pk_bf16(s[0 * 33], s[1 * 33]); o.y = cvt_pk_bf16(s[2 * 33], s[3 * 33]); o.z = cvt_pk_bf16(s[4 * 33], s[5 * 33]); o.w = cvt_pk_bf16(s[6 * 33], s[7 * 33]);
        *(u32x4*)(WT + (size_t)(d0 + n) * K + k0 + 8 * c) = o; }
    asm volatile("s_waitcnt lgkmcnt(0)" ::: "memory");
}

#define rowss ((float*)(P.ws + WS_ROWSS))
#define Wgu1 ((bf16_t*)(P.ws + WS_WGU1))
#define Wd1 ((bf16_t*)(P.ws + WS_WD1))
#define Win ((bf16_t*)(P.ws + WS_WIN))
#define Wp ((bf16_t*)(P.ws + WS_WP))
#define Wout ((bf16_t*)(P.ws + WS_WOUT))
#define Wcq ((bf16_t*)(P.ws + WS_WCQ))
#define Wckv ((bf16_t*)(P.ws + WS_WCKV))
#define Wco ((bf16_t*)(P.ws + WS_WCO))
#define Wgu2 ((bf16_t*)(P.ws + WS_WGU2))
#define Wd2 ((bf16_t*)(P.ws + WS_WD2))
#define HB ((bf16_t*)(P.ws + WS_HB))
#define ACT ((bf16_t*)(P.ws + WS_ACT))
#define Z ((bf16_t*)(P.ws + WS_Z))
#define VT ((bf16_t*)(P.ws + WS_VT))
#define Y ((bf16_t*)(P.ws + WS_Y))
#define CQ ((bf16_t*)(P.ws + WS_CQ))
#define CO ((bf16_t*)(P.ws + WS_CO))
#define DP ((bf16_t*)(P.ws + WS_DP))
#define MEMN ((bf16_t*)(P.ws + WS_MEMN))
#define KC ((bf16_t*)(P.ws + WS_KC))
#define VCT ((bf16_t*)(P.ws + WS_VCT))
__global__ void __launch_bounds__(512, 2) fwd_megakernel(Params P) {
    extern __shared__ __attribute__((aligned(16))) unsigned char lds_raw[];
    cg::grid_group grid = cg::this_grid();
    LAS unsigned char* lds = (LAS unsigned char*)lds_raw;
    const int tid = threadIdx.x, lane = tid & 63, wave = __builtin_amdgcn_readfirstlane(tid >> 6);
    const int G = gridDim.x, bx = blockIdx.x;
    const int gw = bx * 8 + wave, NGW = G * 8;
#define RUN_GEMM(EPI, gM, gN, gdesc, edesc) do { pg8::StaticOrder S_; S_.init((gM), (gN), G, bx); pg8::gemm_phase<EPI>(lds, (gdesc), S_, (edesc)); } while (0)

    for (int rep_ = 0; rep_ < REP_P0; ++rep_) {
        LAS float* scr = (LAS float*)(lds + wave * 16384);
        constexpr int I_G = (DM / 64) * (DFF / 32), I_D = (DFF / 64) * (DM / 32), I_IN = (DM / 64) * (DIN / 32), I_P = (256 / 64) * (256 / 32), I_O = (DM / 64) * (DM / 32),
                      I_CQ = (DM / 64) * (DCROSS / 32), I_CKV = (DM / 64) * (2 * DCROSS / 32), I_CO = (DCROSS / 64) * (DM / 32);
        constexpr int NITEMS = 4 * I_G + 2 * I_D + I_IN + 4 * I_P + I_O + I_CQ + I_CKV + I_CO;
        for (int it = gw; it < NITEMS; it += NGW) {
            int r = it;
            if (r < I_G) { p0_transpose_item(P.ffn1_wg, DM, DFF, Wgu1, 1, 0, P.ffn1_norm, scr, r, lane); continue; } r -= I_G;
            if (r < I_G) { p0_transpose_item(P.ffn1_wu, DM, DFF, Wgu1, 2, 0, P.ffn1_norm, scr, r, lane); continue; } r -= I_G;
            if (r < I_D) { p0_transpose_item(P.ffn1_wd, DFF, DM, Wd1, 0, 0, nullptr, scr, r, lane); continue; } r -= I_D;
            if (r < I_G) { p0_transpose_item(P.ffn2_wg, DM, DFF, Wgu2, 1, 0, P.ffn2_norm, scr, r, lane); continue; } r -= I_G;
            if (r < I_G) { p0_transpose_item(P.ffn2_wu, DM, DFF, Wgu2, 2, 0, P.ffn2_norm, scr, r, lane); continue; } r -= I_G;
            if (r < I_D) { p0_transpose_item(P.ffn2_wd, DFF, DM, Wd2, 0, 0, nullptr, scr, r, lane); continue; } r -= I_D;
            if (r < I_IN) { p0_transpose_item(P.w_in, DM, DIN, Win, 0, 0, P.mix_norm, scr, r, lane); continue; } r -= I_IN;
            if (r < 4 * I_P) { const int gi = r / I_P; p0_transpose_item(P.w_pool + (size_t)gi * 65536, 256, 256, Wp, 0, gi * 256, nullptr, scr, r - gi * I_P, lane); continue; } r -= 4 * I_P;
            if (r < I_O) { p0_transpose_item(P.w_out, DM, DM, Wout, 0, 0, nullptr, scr, r, lane); continue; } r -= I_O;
            if (r < I_CQ) { p0_transpose_item(P.w_cq, DM, DCROSS, Wcq, 0, 0, P.cross_norm, scr, r, lane); continue; } r -= I_CQ;
            if (r < I_CKV) { p0_transpose_item(P.w_ckv, DM, 2 * DCROSS, Wckv, 0, 0, nullptr, scr, r, lane); continue; } r -= I_CKV;
            p0_transpose_item(P.w_co, DCROSS, DM, Wco, 0, 0, nullptr, scr, r, lane);
        }
        for (int i = bx * 512 + tid; i < 4 * MTOK; i += G * 512) rowss[MTOK + i] = 0.f;
        for (int m = gw; m < MTOK; m += NGW) {
            const f32x4* xr = (const f32x4*)(P.x + (size_t)m * DM) + lane; u32x2* o8 = (u32x2*)(HB + (size_t)m * DM) + lane; float s = 0.f;
#pragma unroll
            for (int j = 0; j < 8; ++j) { const f32x4 v = xr[64 * j]; s += (v[0] * v[0] + v[1] * v[1]) + (v[2] * v[2] + v[3] * v[3]); u32x2 w; w.x = cvt_pk_bf16(v[0], v[1]); w.y = cvt_pk_bf16(v[2], v[3]); o8[64 * j] = w; }
            s = wave_sum(s); if (lane == 0) rowss[m] = s;
        }
        for (int m = gw; m < BATCH * NMEM; m += NGW) {
            const f32x4* xr = (const f32x4*)(P.mem + (size_t)m * DM) + lane; const f32x4* gr = (const f32x4*)P.mem_norm + lane; u32x2* o8 = (u32x2*)(MEMN + (size_t)m * DM) + lane;
            f32x4 v[8]; float s = 0.f;
#pragma unroll
            for (int j = 0; j < 8; ++j) { v[j] = xr[64 * j]; s += (v[j][0] * v[j][0] + v[j][1] * v[j][1]) + (v[j][2] * v[j][2] + v[j][3] * v[j][3]); }
            const float rs = __builtin_amdgcn_rsqf(wave_sum(s) * (1.0f / DM) + EPS);
#pragma unroll
            for (int j = 0; j < 8; ++j) { const f32x4 gg = gr[64 * j]; const f32x4 y = v[j] * rs * gg; u32x2 w; w.x = cvt_pk_bf16(y[0], y[1]); w.y = cvt_pk_bf16(y[2], y[3]); o8[64 * j] = w; }
        }
    }
    grid.sync();
    for (int rep_ = 0; rep_ < REP_G1; ++rep_)
    RUN_GEMM(pg8::EpiSwiglu, MTOK, 2 * DFF, (pg8::Gemm{HB, Wgu1, DM, DM, DM, 0}), (pg8::EpiSwiglu{ACT, DFF, rowss}));
    for (int rep_ = 0; rep_ < REP_G1NULL; ++rep_)
    RUN_GEMM(pg8::EpiNull, MTOK, 2 * DFF, (pg8::Gemm{HB, Wgu1, DM, DM, DM, 0}), (pg8::EpiNull{}));
    for (int rep_ = 0; rep_ < REP_SYNC; ++rep_) grid.sync();
    RUN_GEMM(pg8::EpiBf, BATCH * NMEM, 2 * DCROSS, (pg8::Gemm{MEMN, Wckv, DM, DM, DM, 0}), (pg8::EpiBf{KC, DCROSS, 0, nullptr, nullptr, 2, 4, NMEM, DCROSS, VCT}));
    grid.sync();
    for (int rep_ = 0; rep_ < REP_G2; ++rep_)
    RUN_GEMM(pg8::EpiRes<true>, MTOK, DM, (pg8::Gemm{ACT, Wd1, DFF, DFF, DFF, 0}), (pg8::EpiRes<true>{P.x, HB, nullptr, 0.5f}));
    RUN_GEMM(pg8::EpiRes<true>, MTOK, DM, (pg8::Gemm{ACT, Wd1, DFF, DFF, DFF, 0}), (pg8::EpiRes<true>{P.x, HB, rowss + 1 * MTOK, 0.5f}));
    grid.sync();
    for (int rep_ = 0; rep_ < REP_G3; ++rep_)
    RUN_GEMM(pg8::EpiBf, MTOK, DIN, (pg8::Gemm{HB, Win, DM, DM, DM, 0}), (pg8::EpiBf{Z, DIN, 0, rowss + 1 * MTOK, nullptr, 8, 12, SEQ, DATT, VT}));
    grid.sync();
    for (int rep_ = 0; rep_ < REP_ATT; ++rep_) {
        for (int task = gw; task < (MTOK / 64) * 4; task += NGW) {
            const int gi = task & 3, rt = task >> 2, sub = lane >> 5, cgi = lane & 31, w = 2 << gi;
            const int t0 = rt * 64 + sub * 32, tpos = t0 & (SEQ - 1);
            const bf16_t* up = Z + (size_t)t0 * DIN + 3 * DATT + gi * 256 + cgi * 8;
            bf16_t* dp = DP + (size_t)t0 * DPOOL + gi * 256 + cgi * 8;
            float sum[8];
#pragma unroll
            for (int e = 0; e < 8; ++e) sum[e] = 0.f;
            for (int i = 1; i < w; ++i) if (tpos - i >= 0) { const u32x4 v = *(const u32x4*)(up - (size_t)i * DIN);
                sum[0] += bf_lo(v.x); sum[1] += bf_hi(v.x); sum[2] += bf_lo(v.y); sum[3] += bf_hi(v.y); sum[4] += bf_lo(v.z); sum[5] += bf_hi(v.z); sum[6] += bf_lo(v.w); sum[7] += bf_hi(v.w); }
#pragma nounroll
            for (int r0 = 0; r0 < 32; r0 += 8) {
                u32x4 cv[8], ov[8];
#pragma unroll
                for (int j = 0; j < 8; ++j) cv[j] = *(const u32x4*)(up + (size_t)(r0 + j) * DIN);
#pragma unroll
                for (int j = 0; j < 8; ++j) { const int rr = r0 + j - w + 1; ov[j] = (tpos + rr >= 0) ? *(const u32x4*)(up + (ptrdiff_t)rr * DIN) : (u32x4){0u, 0u, 0u, 0u}; }
#pragma unroll
                for (int j = 0; j < 8; ++j) {
                    const u32x4 v = cv[j], q = ov[j];
                    const float cur[8] = {bf_lo(v.x), bf_hi(v.x), bf_lo(v.y), bf_hi(v.y), bf_lo(v.z), bf_hi(v.z), bf_lo(v.w), bf_hi(v.w)};
                    const float old[8] = {bf_lo(q.x), bf_hi(q.x), bf_lo(q.y), bf_hi(q.y), bf_lo(q.z), bf_hi(q.z), bf_lo(q.w), bf_hi(q.w)};
                    const int have = tpos + r0 + j + 1; const float inv = 1.0f / (float)(have < w ? have : w);
                    float d[8];
#pragma unroll
                    for (int e = 0; e < 8; ++e) { sum[e] += cur[e]; d[e] = sum[e] * inv - cur[e]; sum[e] -= old[e]; }
                    u32x4 o; o.x = cvt_pk_bf16(d[0], d[1]); o.y = cvt_pk_bf16(d[2], d[3]); o.z = cvt_pk_bf16(d[4], d[5]); o.w = cvt_pk_bf16(d[6], d[7]);
                    *(u32x4*)(dp + (size_t)(r0 + j) * DPOOL) = o;
                }
            }
        }
        LAS float* tab = (LAS float*)lds;
        for (int bh = bx; bh < BATCH * 16; bh += G) {
            const int b = bh >> 4, h = bh & 15;
            __syncthreads();
            for (int i = tid; i < NREL; i += 512) tab[i] = P.rel_bias[h * NREL + i] * LOG2E;
            __syncthreads();
#pragma nounroll
            for (int i = 0; i < 8; ++i) {
                const int c = i * 4 + (wave >> 1), half = wave & 1, j0 = c < 8 ? 8 - c : 0, kstart = (c - 8 + j0) * 64;
                const size_t qrow = (size_t)b * SEQ + c * 64 + half * 32;
#ifndef NO_ATT5
                attn_wave32<64, true, 2, true>(Z + qrow * DIN + h * 64, DIN, Z + ((size_t)b * SEQ + kstart) * DIN + DATT + h * 64, DIN,
                                      VT + ((size_t)b * DATT + h * 64) * SEQ + kstart, SEQ, Y + qrow * DM + h * 64, DM, 9 - j0, 0.125f * LOG2E, tab, half * 32 + (8 - j0) * 64, lane);
#endif
            }
        }
        __syncthreads();
    }
    grid.sync();
    RUN_GEMM(pg8::EpiBf, MTOK, DPOOL, (pg8::Gemm{DP, Wp, DPOOL, 256, 256, 512}), (pg8::EpiBf{Y, DM, DATT, nullptr, P.pool_scale, 0, 0, 1, 1, nullptr}));
    grid.sync();
    RUN_GEMM(pg8::EpiRes<false>, MTOK, DM, (pg8::Gemm{Y, Wout, DM, DM, DM, 0}), (pg8::EpiRes<false>{nullptr, HB, rowss + 2 * MTOK, 1.0f}));
    grid.sync();
    RUN_GEMM(pg8::EpiBf, MTOK, DCROSS, (pg8::Gemm{HB, Wcq, DM, DM, DM, 0}), (pg8::EpiBf{CQ, DCROSS, 0, rowss + 2 * MTOK, nullptr, 0, 0, 1, 1, nullptr}));
    grid.sync();
    {
        for (int it = bx; it < BATCH * 16; it += G) {
            const int b = it >> 4, sub = it & 15;
#pragma nounroll
            for (int r = 0; r < 4; ++r) {
                const int wu = r * 8 + wave, head = wu & 3, qblk = wu >> 2;
                const size_t qrow = (size_t)b * SEQ + sub * 128 + qblk * 16;
#ifndef NO_ATT9
                attn_wave32<128, false, 1, false>(CQ + qrow * DCROSS + head * 128, DCROSS, KC + (size_t)b * NMEM * DCROSS + head * 128, DCROSS,
                                        VCT + ((size_t)b * DCROSS + head * 128) * NMEM, NMEM, CO + qrow * DCROSS + head * 128, DCROSS, 4, 0.08838834764831845f * LOG2E, nullptr, 0, lane);
#endif
            }
        }
    }
    grid.sync();
    RUN_GEMM(pg8::EpiRes<false>, MTOK, DM, (pg8::Gemm{CO, Wco, DCROSS, DCROSS, DCROSS, 0}), (pg8::EpiRes<false>{nullptr, HB, rowss + 3 * MTOK, 1.0f}));
    grid.sync();
    RUN_GEMM(pg8::EpiSwiglu, MTOK, 2 * DFF, (pg8::Gemm{HB, Wgu2, DM, DM, DM, 0}), (pg8::EpiSwiglu{ACT, DFF, rowss + 3 * MTOK}));
    grid.sync();
    RUN_GEMM(pg8::EpiRes<false>, MTOK, DM, (pg8::Gemm{ACT, Wd2, DFF, DFF, DFF, 0}), (pg8::EpiRes<false>{nullptr, HB, rowss + 4 * MTOK, 0.5f}));
    grid.sync();
    {
        const float* rs4 = rowss + 4 * MTOK;
        for (int m = gw; m < MTOK; m += NGW) {
            const u32x2* hr = (const u32x2*)(HB + (size_t)m * DM) + lane; f32x4* xr = (f32x4*)(P.out + (size_t)m * DM) + lane; const f32x4* gr = (const f32x4*)P.final_norm + lane;
            const float rs = __builtin_amdgcn_rsqf(rs4[m] * (1.0f / DM) + EPS);
#pragma unroll
            for (int j = 0; j < 8; ++j) { const u32x2 q = hr[64 * j]; const f32x4 v = (f32x4){bf_lo(q.x), bf_hi(q.x), bf_lo(q.y), bf_hi(q.y)}; xr[64 * j] = v * rs * gr[64 * j]; }
        }
    }
#undef RUN_GEMM
}

extern "C" void kernel_launch(void* const* d_in, const int* in_sizes, int n_in, void* d_out, int out_size, void* d_ws, size_t ws_size, hipStream_t stream) {
    static int grid_blocks = 0;
    if (grid_blocks == 0) {
        if (n_in != 22 || in_sizes[0] != MTOK * DM || out_size != MTOK * DM || ws_size < WS_END) {
            fprintf(stderr, "kernel_launch: unexpected shapes (n_in %d, in0 %d, out %d, ws %zu)\n", n_in, n_in > 0 ? in_sizes[0] : -1, out_size, ws_size); grid_blocks = -1; return; }
        int dev = 0, cus = 0, per_cu = 0;
        hipGetDevice(&dev);
        hipDeviceGetAttribute(&cus, hipDeviceAttributeMultiprocessorCount, dev);
        if (hipFuncSetAttribute((const void*)fwd_megakernel, hipFuncAttributeMaxDynamicSharedMemorySize, LDS_BYTES) != hipSuccess) { fprintf(stderr, "kernel_launch: hipFuncSetAttribute failed\n"); grid_blocks = -1; return; }
        if (hipOccupancyMaxActiveBlocksPerMultiprocessor(&per_cu, (const void*)fwd_megakernel, 512, LDS_BYTES) != hipSuccess || per_cu < 1) { fprintf(stderr, "kernel_launch: occupancy query gave %d\n", per_cu); per_cu = 1; }
        (void)hipGetLastError();
        grid_blocks = cus * per_cu;
    }
    if (grid_blocks < 0) return;
    Params p{};
    const float* const* in = (const float* const*)d_in;
    p.x = in[0]; p.mem = in[1]; p.ffn1_norm = in[2]; p.ffn1_wg = in[3]; p.ffn1_wu = in[4]; p.ffn1_wd = in[5]; p.mix_norm = in[6]; p.w_in = in[7]; p.rel_bias = in[8];
    p.w_pool = in[9]; p.pool_scale = in[10]; p.w_out = in[11]; p.cross_norm = in[12]; p.mem_norm = in[13]; p.w_cq = in[14]; p.w_ckv = in[15]; p.w_co = in[16];
    p.ffn2_norm = in[17]; p.ffn2_wg = in[18]; p.ffn2_wu = in[19]; p.ffn2_wd = in[20]; p.final_norm = in[21];
    p.out = (float*)d_out; p.ws = (unsigned char*)d_ws;
    void* args[] = {&p};
    hipError_t e = hipLaunchCooperativeKernel((const void*)fwd_megakernel, dim3(grid_blocks), dim3(512), args, LDS_BYTES, stream);
    if (e != hipSuccess) fprintf(stderr, "cooperative launch failed: %s (grid %d)\n", hipGetErrorString(e), grid_blocks);
}
```

```cpp
#include <hip/hip_runtime.h>
#include <hip/hip_cooperative_groups.h>
#include <cstdio>
#include <cstdint>
namespace cg = cooperative_groups;

#define LAS __attribute__((address_space(3)))
typedef unsigned short bf16_t;
typedef short bf16x8 __attribute__((ext_vector_type(8)));
typedef float f32x4 __attribute__((ext_vector_type(4)));
typedef float f32x2 __attribute__((ext_vector_type(2)));
typedef unsigned u32x4 __attribute__((ext_vector_type(4)));
typedef unsigned u32x2 __attribute__((ext_vector_type(2)));

constexpr int BATCH = 16, SEQ = 2048, DM = 2048, MTOK = BATCH * SEQ;
constexpr int DFF = 5632, DIN = 4096, DATT = 1024, DPOOL = 1024, NMEM = 256, DCROSS = 512;
constexpr int NREL = 257;
constexpr float EPS = 1e-6f;
constexpr float LOG2E = 1.4426950408889634f;

constexpr size_t MiB = 1u << 20;
constexpr size_t WS_ROWSS = 0;
constexpr size_t WS_BAR = 896 * 1024, WS_BAR_BYTES = 16384;
constexpr size_t WS_WGU1 = 1 * MiB, WS_WD1 = 45 * MiB, WS_WIN = 67 * MiB, WS_WP = 83 * MiB, WS_WOUT = 84 * MiB, WS_WCQ = 92 * MiB,
                 WS_WCKV = 94 * MiB, WS_WCO = 98 * MiB, WS_WGU2 = 100 * MiB, WS_WD2 = 144 * MiB;
constexpr size_t WS_HB = 166 * MiB;
constexpr size_t WS_ACT = 294 * MiB;
constexpr size_t WS_Z = 294 * MiB;
constexpr size_t WS_VT = 550 * MiB;
constexpr size_t WS_Y = 646 * MiB;
constexpr size_t WS_CQ = 646 * MiB, WS_CO = 678 * MiB;
constexpr size_t WS_DP = 774 * MiB;
constexpr size_t WS_MEMN = 838 * MiB;
constexpr size_t WS_KC = 854 * MiB;
constexpr size_t WS_VCT = 858 * MiB;
constexpr size_t WS_END = 862 * MiB;

#ifndef REP_G1NULL
#define REP_G1NULL 0
#endif
#ifndef REP_SYNC
#define REP_SYNC 0
#endif
#ifndef REP_G2
#define REP_G2 0
#endif
#ifndef REP_P0
#define REP_P0 1
#endif
#ifndef REP_G1
#define REP_G1 1
#endif
#ifndef REP_ATT
#define REP_ATT 1
#endif
#ifndef REP_G3
#define REP_G3 1
#endif
constexpr int LDS_BYTES = 147456;

__device__ __forceinline__ unsigned cvt_pk_bf16(float lo, float hi) { unsigned r; asm volatile("v_cvt_pk_bf16_f32 %0, %1, %2" : "=v"(r) : "v"(lo), "v"(hi)); return r; }
__device__ __forceinline__ float bf_lo(unsigned w) { return __uint_as_float(w << 16); }
__device__ __forceinline__ float bf_hi(unsigned w) { return __uint_as_float(w & 0xffff0000u); }
__device__ __forceinline__ float wave_sum(float v) {
#pragma unroll
    for (int o = 1; o < 64; o <<= 1) v += __shfl_xor(v, o);
    return v;
}

namespace pg8 {
constexpr int BM = 256, BK = 64, HALF = 128, HTB = HALF * BK * 2, STAGE_BYTES = 8 * HTB, NXCD = 8, WGM = 8;
__host__ __device__ __forceinline__ int lds_byte(int r, int c) { const int st = (r >> 4) * 2 + (c >> 5), rr = r & 15, cc = c & 31, ob = rr * 64 + cc * 2; return st * 1024 + (ob ^ (((ob >> 9) & 1) << 5)); }
__host__ __device__ __forceinline__ void stage_rc(int b, int& R, int& C) { const int st = b / 1024, sb = b % 1024, swz = sb ^ (((sb >> 9) & 1) << 5); R = (st >> 1) * 16 + swz / 64; C = (st & 1) * 32 + (swz % 64) / 2; }
__host__ __device__ __forceinline__ int perm32(int rho) { const int n = rho >> 4, i = rho & 15; return 8 * (i >> 2) + 4 * n + (i & 3); }

struct Unit { int pm, pn; };
struct Gemm { const bf16_t* A; const bf16_t* Bt; int lda, ldb, K, a_pn_step; };

struct StaticOrder {
    int nM, nN, nwg, G, c;
    __device__ void init(int M, int N, int G_, int c_) { nM = M / BM; nN = N / BM; nwg = nM * nN; G = G_; c = c_; }
    __device__ bool next(int i, Unit& u) const {
        const long L = (long)i * G + c; if (L >= nwg) return false;
        int wgid = (int)L; { const int q = nwg / NXCD, r = nwg % NXCD, xcd = wgid % NXCD, off = wgid / NXCD; wgid = (xcd < r ? xcd * (q + 1) : r * (q + 1) + (xcd - r) * q) + off; }
        const int nig = WGM * nN, gid = wgid / nig, fm = gid * WGM, gsz = (nM - fm) < WGM ? (nM - fm) : WGM;
        u.pm = fm + ((wgid % nig) % gsz); u.pn = (wgid % nig) / gsz; return true;
    }
};

struct EpiBf {
    bf16_t* O; int ldc; int col_off; const float* rowss; const float* colscale; int t_lo, t_hi, t_rows, t_cols; bf16_t* VT;
    __device__ __forceinline__ void operator()(const f32x4 (&acc)[2][2][4][2], const Unit& u, int wr, int wc, int fr, int fq) const {
        const int row0 = u.pm * BM + wr * 64 + fr, cl = wc * 32 + 8 * fq;
        const bool tr = (u.pn >= t_lo) && (u.pn < t_hi);
        f32x4 cs[2][2]; float rsv[8];
#pragma unroll
        for (int bj = 0; bj < 2; ++bj)
#pragma unroll
            for (int n = 0; n < 2; ++n) cs[bj][n] = colscale ? *(const f32x4*)(colscale + u.pn * BM + bj * HALF + cl + 4 * n) : (f32x4){1.f, 1.f, 1.f, 1.f};
#pragma unroll
        for (int i = 0; i < 8; ++i) rsv[i] = rowss ? rowss[row0 + (i >> 2) * HALF + (i & 3) * 16] : 0.f;
        asm volatile("" ::: "memory");
#pragma unroll
        for (int ai = 0; ai < 2; ++ai)
#pragma unroll
            for (int m = 0; m < 4; ++m) {
                const int row = row0 + ai * HALF + m * 16;
                const float rsc = rowss ? __builtin_amdgcn_rsqf(rsv[ai * 4 + m] * (1.0f / DM) + EPS) : 1.0f;
#pragma unroll
                for (int bj = 0; bj < 2; ++bj) {
                    const f32x4 v0 = acc[ai][bj][m][0] * rsc * cs[bj][0], v1 = acc[ai][bj][m][1] * rsc * cs[bj][1];
                    u32x4 w; w.x = cvt_pk_bf16(v0[0], v0[1]); w.y = cvt_pk_bf16(v0[2], v0[3]); w.z = cvt_pk_bf16(v1[0], v1[1]); w.w = cvt_pk_bf16(v1[2], v1[3]);
                    if (!tr) { *(u32x4*)(O + (size_t)row * ldc + col_off + u.pn * BM + bj * HALF + cl) = w; }
                    else {
                        const int cv = (u.pn - t_lo) * BM + bj * HALF + cl, b = row / t_rows, s = row - b * t_rows;
                        bf16_t* p = VT + ((size_t)b * t_cols + cv) * t_rows + s;
                        p[0] = (bf16_t)(w.x & 0xffffu); p[(size_t)t_rows] = (bf16_t)(w.x >> 16); p[(size_t)2 * t_rows] = (bf16_t)(w.y & 0xffffu); p[(size_t)3 * t_rows] = (bf16_t)(w.y >> 16);
                        p[(size_t)4 * t_rows] = (bf16_t)(w.z & 0xffffu); p[(size_t)5 * t_rows] = (bf16_t)(w.z >> 16); p[(size_t)6 * t_rows] = (bf16_t)(w.w & 0xffffu); p[(size_t)7 * t_rows] = (bf16_t)(w.w >> 16);
                    }
                }
            }
    }
};
__device__ __forceinline__ float silu_mul(float g, float u) { return g * __builtin_amdgcn_rcpf(1.0f + __expf(-g)) * u; }
struct EpiSwiglu {
    bf16_t* O; int ldc; const float* rowss;
    __device__ __forceinline__ void operator()(const f32x4 (&acc)[2][2][4][2], const Unit& u, int wr, int wc, int fr, int fq) const {
        const int row0 = u.pm * BM + wr * 64 + fr, cl = wc * 32 + 8 * fq;
        float rsv[8];
#pragma unroll
        for (int i = 0; i < 8; ++i) rsv[i] = rowss[row0 + (i >> 2) * HALF + (i & 3) * 16];
        asm volatile("" ::: "memory");
#pragma unroll
        for (int ai = 0; ai < 2; ++ai)
#pragma unroll
            for (int m = 0; m < 4; ++m) {
                const int row = row0 + ai * HALF + m * 16;
                const float rsc = __builtin_amdgcn_rsqf(rsv[ai * 4 + m] * (1.0f / DM) + EPS);
                const f32x4 g0 = acc[ai][0][m][0] * rsc, g1 = acc[ai][0][m][1] * rsc, u0 = acc[ai][1][m][0] * rsc, u1 = acc[ai][1][m][1] * rsc;
                u32x4 w;
                w.x = cvt_pk_bf16(silu_mul(g0[0], u0[0]), silu_mul(g0[1], u0[1])); w.y = cvt_pk_bf16(silu_mul(g0[2], u0[2]), silu_mul(g0[3], u0[3]));
                w.z = cvt_pk_bf16(silu_mul(g1[0], u1[0]), silu_mul(g1[1], u1[1])); w.w = cvt_pk_bf16(silu_mul(g1[2], u1[2]), silu_mul(g1[3], u1[3]));
                *(u32x4*)(O + (size_t)row * ldc + u.pn * HALF + cl) = w;
            }
    }
};
template <bool F32IN> struct EpiRes {
    const float* hin_f; bf16_t* hb; float* rowss_out; float alpha;
    static constexpr int DEPTH = F32IN ? 2 : 4, NV = F32IN ? 4 : 2;
    __device__ __forceinline__ void ld(f32x4 (&hv)[4], size_t off) const {
        if (F32IN) { hv[0] = *(const f32x4*)(hin_f + off); hv[1] = *(const f32x4*)(hin_f + off + 4); hv[2] = *(const f32x4*)(hin_f + off + HALF); hv[3] = *(const f32x4*)(hin_f + off + HALF + 4); }
        else { hv[0] = __builtin_bit_cast(f32x4, *(const u32x4*)(hb + off)); hv[1] = __builtin_bit_cast(f32x4, *(const u32x4*)(hb + off + HALF)); }
    }
    __device__ __forceinline__ void operator()(const f32x4 (&acc)[2][2][4][2], const Unit& u, int wr, int wc, int fr, int fq) const {
        const int row0 = u.pm * BM + wr * 64 + fr, cl = u.pn * BM + wc * 32 + 8 * fq;
        f32x4 hv[DEPTH][4];
#pragma unroll
        for (int gi = 0; gi < DEPTH; ++gi) ld(hv[gi], (size_t)(row0 + (gi >> 2) * HALF + (gi & 3) * 16) * DM + cl);
#pragma unroll
        for (int gi = 0; gi < 8; ++gi) {
            const int ai = gi >> 2, m = gi & 3, cb = gi % DEPTH;
            asm volatile("" ::: "memory");
            const int row = row0 + ai * HALF + m * 16; const size_t off = (size_t)row * DM + cl;
            float ss = 0.f;
            u32x4 wv[2];
#pragma unroll
            for (int bj = 0; bj < 2; ++bj) {
                f32x4 o0, o1;
                if (F32IN) { o0 = hv[cb][2 * bj]; o1 = hv[cb][2 * bj + 1]; }
                else { const u32x4 q = __builtin_bit_cast(u32x4, hv[cb][bj]); o0 = (f32x4){bf_lo(q.x), bf_hi(q.x), bf_lo(q.y), bf_hi(q.y)}; o1 = (f32x4){bf_lo(q.z), bf_hi(q.z), bf_lo(q.w), bf_hi(q.w)}; }
                const f32x4 h0 = o0 + acc[ai][bj][m][0] * alpha, h1 = o1 + acc[ai][bj][m][1] * alpha;
                ss += (h0[0] * h0[0] + h0[1] * h0[1]) + (h0[2] * h0[2] + h0[3] * h0[3]) + (h1[0] * h1[0] + h1[1] * h1[1]) + (h1[2] * h1[2] + h1[3] * h1[3]);
                wv[bj].x = cvt_pk_bf16(h0[0], h0[1]); wv[bj].y = cvt_pk_bf16(h0[2], h0[3]); wv[bj].z = cvt_pk_bf16(h1[0], h1[1]); wv[bj].w = cvt_pk_bf16(h1[2], h1[3]);
            }
            if (gi + DEPTH < 8) ld(hv[cb], (size_t)(row0 + ((gi + DEPTH) >> 2) * HALF + ((gi + DEPTH) & 3) * 16) * DM + cl);
            *(u32x4*)(hb + off) = wv[0]; *(u32x4*)(hb + off + HALF) = wv[1];
            ss += __shfl_xor(ss, 16); ss += __shfl_xor(ss, 32);
            if (rowss_out && fq == 0) unsafeAtomicAdd(rowss_out + row, ss);
        }
    }
};

struct EpiNull {
    __device__ __forceinline__ void operator()(const f32x4 (&acc)[2][2][4][2], const Unit& u, int wr, int wc, int fr, int fq) const {
#pragma unroll
        for (int ai = 0; ai < 2; ++ai)
#pragma unroll
            for (int bj = 0; bj < 2; ++bj)
#pragma unroll
                for (int m = 0; m < 4; ++m) asm volatile("" :: "v"(acc[ai][bj][m][0]), "v"(acc[ai][bj][m][1]));
    }
};

template <class Epi, bool ALIGN_EPI = true>
__device__ __forceinline__ void gemm_phase(LAS unsigned char* lds, const Gemm g, const StaticOrder& S, const Epi& E) {
    int tid_l = threadIdx.x; asm volatile("" : "+v"(tid_l));
    const int tid = tid_l, wid = __builtin_amdgcn_readfirstlane(tid >> 6), lane = tid & 63, wr = wid >> 2, wc = wid & 3, fr = lane & 15, fq = lane >> 4;
    const int K = g.K, nt = K / BK;
    unsigned voffA[2], voffB[2];
#pragma unroll
    for (int i = 0; i < 2; ++i) { int R, C; stage_rc(tid * 16 + i * 8192, R, C); const int Rb = (R & ~31) + perm32(R & 31);
        voffA[i] = (unsigned)(R * g.lda + C) * 2u; voffB[i] = (unsigned)(Rb * g.ldb + C) * 2u; }
    const size_t kstep = (size_t)(BK * 2);
    const size_t hstepA = (size_t)HALF * g.lda * 2, hstepB = (size_t)HALF * g.ldb * 2;
    const size_t tstepA = 2 * hstepA, tstepB = 2 * hstepB;
    const unsigned ldsw = (unsigned)wid * 1024u;
    const int aoff = lds_byte(wr * 64 + fr, fq * 8), boff = lds_byte(wc * 32 + fr, fq * 8);
#define PG8_SA(b, h) (((b) * 2 + (h)) * HTB)
#define PG8_SB(b, h) ((4 + (b) * 2 + (h)) * HTB)
#define PG8_STAGE(bufoff, gbase, voff) do { _Pragma("unroll") for (int _i = 0; _i < 2; ++_i) \
        __builtin_amdgcn_global_load_lds((const unsigned*)((const char*)(gbase) + (voff)[_i]), (LAS unsigned*)(lds + (bufoff) + ldsw + _i * 8192), 16, 0, 0); } while (0)
#define PG8_LDA(dst, b, h) do { _Pragma("unroll") for (int m = 0; m < 4; ++m) _Pragma("unroll") for (int k = 0; k < 2; ++k) dst[m][k] = *(const LAS bf16x8*)(lds + PG8_SA(b, h) + aoff + m * 2048 + k * 1024); } while (0)
#define PG8_LDB(dst, b, h) do { _Pragma("unroll") for (int n = 0; n < 2; ++n) _Pragma("unroll") for (int k = 0; k < 2; ++k) dst[n][k] = *(const LAS bf16x8*)(lds + PG8_SB(b, h) + boff + n * 2048 + k * 1024); } while (0)
#define PG8_MMA(ai, bj, At, Bt) do { __builtin_amdgcn_s_setprio(1); _Pragma("unroll") for (int m = 0; m < 4; ++m) _Pragma("unroll") for (int n = 0; n < 2; ++n) _Pragma("unroll") for (int k = 0; k < 2; ++k) \
        acc[ai][bj][m][n] = __builtin_amdgcn_mfma_f32_16x16x32_bf16(Bt[n][k], At[m][k], acc[ai][bj][m][n], 0, 0, 0); __builtin_amdgcn_s_setprio(0); } while (0)
#define PG8_WAIT_V(n) asm volatile("s_waitcnt vmcnt(" #n ")" ::: "memory")
#define PG8_WAIT_L(n) asm volatile("s_waitcnt lgkmcnt(" #n ")" ::: "memory")
#define PG8_BAR __builtin_amdgcn_s_barrier()
#define PG8_SCHED __builtin_amdgcn_sched_barrier(0)
    Unit cur, nxt; int ui = 0;
    if (!S.next(0, cur)) return;
    f32x4 acc[2][2][4][2];
#pragma unroll
    for (int a = 0; a < 2; ++a)
#pragma unroll
        for (int b = 0; b < 2; ++b)
#pragma unroll
            for (int m = 0; m < 4; ++m)
#pragma unroll
                for (int n = 0; n < 2; ++n) acc[a][b][m][n] = (f32x4){0.f, 0.f, 0.f, 0.f};
    bf16x8 At[4][2], B0[2][2], B1[2][2];
    const char* cA = (const char*)g.A + (size_t)cur.pm * tstepA + (size_t)cur.pn * g.a_pn_step; const char* cB = (const char*)g.Bt + (size_t)cur.pn * tstepB;
    PG8_STAGE(PG8_SB(0, 0), cB, voffB); PG8_STAGE(PG8_SB(0, 1), cB + hstepB, voffB); PG8_STAGE(PG8_SA(0, 0), cA, voffA); PG8_STAGE(PG8_SA(0, 1), cA + hstepA, voffA);
    if (wr == 1) PG8_BAR;
    PG8_WAIT_V(2); PG8_BAR;
    PG8_STAGE(PG8_SB(1, 0), cB + kstep, voffB); PG8_STAGE(PG8_SA(1, 0), cA + kstep, voffA); PG8_STAGE(PG8_SB(1, 1), cB + hstepB + kstep, voffB);
    PG8_WAIT_V(6); PG8_BAR;
    for (;;) {
        const bool has_next = S.next(ui + 1, nxt);
        const char* nA = has_next ? (const char*)g.A + (size_t)nxt.pm * tstepA + (size_t)nxt.pn * g.a_pn_step : cA; const char* nB = has_next ? (const char*)g.Bt + (size_t)nxt.pn * tstepB : cB;
        for (int t = 0; t < nt; t += 2) {
            const bool last = (t == nt - 2);
            const char* a1 = cA + (size_t)(t + 1) * kstep;
            const char* a2 = last ? nA : cA + (size_t)(t + 2) * kstep; const char* b2 = last ? nB : cB + (size_t)(t + 2) * kstep;
            const char* a3 = a2 + kstep; const char* b3 = b2 + kstep;
            PG8_LDB(B0, 0, 0); PG8_LDB(B1, 0, 1); PG8_SCHED; PG8_LDA(At, 0, 0); PG8_STAGE(PG8_SA(1, 1), a1 + hstepA, voffA);
            PG8_WAIT_V(8); PG8_WAIT_L(0); PG8_BAR; PG8_MMA(0, 0, At, B0); PG8_MMA(0, 1, At, B1); PG8_BAR; PG8_SCHED;
            PG8_LDA(At, 0, 1); PG8_STAGE(PG8_SB(0, 0), b2, voffB); PG8_STAGE(PG8_SB(0, 1), b2 + hstepB, voffB); PG8_STAGE(PG8_SA(0, 0), a2, voffA);
            PG8_WAIT_V(8); PG8_WAIT_L(0); PG8_BAR; PG8_MMA(1, 0, At, B0); PG8_MMA(1, 1, At, B1); PG8_BAR; PG8_SCHED;
            PG8_LDB(B0, 1, 0); PG8_LDB(B1, 1, 1); PG8_SCHED; PG8_LDA(At, 1, 0); PG8_STAGE(PG8_SA(0, 1), a2 + hstepA, voffA);
            PG8_WAIT_V(8); PG8_WAIT_L(0); PG8_BAR; PG8_MMA(0, 0, At, B0); PG8_MMA(0, 1, At, B1); PG8_BAR; PG8_SCHED;
            PG8_LDA(At, 1, 1); PG8_STAGE(PG8_SB(1, 0), b3, voffB); PG8_STAGE(PG8_SB(1, 1), b3 + hstepB, voffB); PG8_STAGE(PG8_SA(1, 0), a3, voffA);
            PG8_WAIT_V(8); PG8_WAIT_L(0); PG8_BAR; PG8_MMA(1, 0, At, B0); PG8_MMA(1, 1, At, B1); PG8_BAR; PG8_SCHED;
        }
        if constexpr (ALIGN_EPI) { if (wr == 0) PG8_BAR; }
        E(acc, cur, wr, wc, fr, fq);
        if (!has_next) break;
#pragma unroll
        for (int a = 0; a < 2; ++a)
#pragma unroll
            for (int b = 0; b < 2; ++b)
#pragma unroll
                for (int m = 0; m < 4; ++m)
#pragma unroll
                    for (int n = 0; n < 2; ++n) acc[a][b][m][n] = (f32x4){0.f, 0.f, 0.f, 0.f};
        cur = nxt; cA = nA; cB = nB; ++ui;
        if constexpr (ALIGN_EPI) { if (wr == 1) PG8_BAR; }
    }
    PG8_WAIT_V(0);
    if constexpr (!ALIGN_EPI) { if (wr == 0) PG8_BAR; }
    PG8_BAR;
#undef PG8_SA
#undef PG8_SB
#undef PG8_STAGE
#undef PG8_LDA
#undef PG8_LDB
#undef PG8_MMA
#undef PG8_WAIT_V
#undef PG8_WAIT_L
#undef PG8_BAR
#undef PG8_SCHED
}
}

template <int DH, bool BIAS, int NT, bool PF>
__device__ __forceinline__ void attn_wave32(const bf16_t* __restrict__ Qp, int ldq, const bf16_t* __restrict__ Kp, int ldk, const bf16_t* __restrict__ Vp, int ldv,
                                            bf16_t* __restrict__ Op, int ldo, int ntiles, float sc, const LAS float* tab, int rel_base, int lane) {
    constexpr int KS = DH / 32, DT = DH / 16;
    asm volatile("" : "+v"(lane));
    const int fr = lane & 15, fq = lane >> 4;
    bf16x8 qf[NT][KS];
#pragma unroll
    for (int nt = 0; nt < NT; ++nt)
#pragma unroll
        for (int ks = 0; ks < KS; ++ks) qf[nt][ks] = *(const bf16x8*)(Qp + (size_t)(nt * 16 + fr) * ldq + ks * 32 + fq * 8);
    f32x4 o[DT][NT];
#pragma unroll
    for (int dt = 0; dt < DT; ++dt)
#pragma unroll
        for (int nt = 0; nt < NT; ++nt) o[dt][nt] = (f32x4){0.f, 0.f, 0.f, 0.f};
    float mrun[NT], lrun[NT];
#pragma unroll
    for (int nt = 0; nt < NT; ++nt) { mrun[nt] = -1e30f; lrun[nt] = 0.f; }
    const bf16_t* kbase = Kp + (size_t)(8 * (fr >> 2) + (fr & 3)) * ldk + fq * 8;
    const bf16_t* vbase = Vp + (size_t)fr * ldv + fq * 8;
    bf16x8 kf[4][KS], vfA[DT][2], vfB[DT][2];
#define ATT_LOADK(tt) do { _Pragma("unroll") for (int mt = 0; mt < 4; ++mt) _Pragma("unroll") for (int ks = 0; ks < KS; ++ks) \
        kf[mt][ks] = *(const bf16x8*)(kbase + (size_t)((tt) * 64 + (mt >> 1) * 32 + 4 * (mt & 1)) * ldk + ks * 32); } while (0)
#define ATT_LOADV(dst, tt) do { _Pragma("unroll") for (int dt = 0; dt < DT; ++dt) _Pragma("unroll") for (int kb = 0; kb < 2; ++kb) \
        dst[dt][kb] = *(const bf16x8*)(vbase + (size_t)(dt * 16) * ldv + (tt) * 64 + kb * 32); } while (0)
#define ATT_BODY(t, vcur, vnext) do { \
        const int tn_ = ((t) + 1 < ntiles) ? (t) + 1 : (t); \
        if (PF) ATT_LOADV(vnext, tn_); else ATT_LOADK(t); \
        f32x4 s[4][NT]; \
        _Pragma("unroll") for (int mt = 0; mt < 4; ++mt) _Pragma("unroll") for (int nt = 0; nt < NT; ++nt) { s[mt][nt] = (f32x4){0.f, 0.f, 0.f, 0.f}; \
            _Pragma("unroll") for (int ks = 0; ks < KS; ++ks) s[mt][nt] = __builtin_amdgcn_mfma_f32_16x16x32_bf16(kf[mt][ks], qf[nt][ks], s[mt][nt], 0, 0, 0); } \
        if (PF) ATT_LOADK(tn_); \
        bf16x8 pf[NT][2]; \
        const int relt = rel_base - 64 * (t); \
        const bool cbias = BIAS && (relt - 63 >= 128); \
        _Pragma("unroll") for (int nt = 0; nt < NT; ++nt) { \
            float mloc = -1e30f; \
            _Pragma("unroll") for (int mt = 0; mt < 4; ++mt) _Pragma("unroll") for (int j = 0; j < 4; ++j) { \
                float v = s[mt][nt][j] * sc; \
                if (BIAS) { if (cbias) v += tab[256]; \
                    else { int rel = relt + (nt * 16 + fr) - ((mt >> 1) * 32 + 8 * fq + 4 * (mt & 1) + j); rel = rel < -128 ? -128 : (rel > 128 ? 128 : rel); v += tab[rel + 128]; } } \
                s[mt][nt][j] = v; mloc = fmaxf(mloc, v); } \
            mloc = fmaxf(mloc, __shfl_xor(mloc, 16)); mloc = fmaxf(mloc, __shfl_xor(mloc, 32)); \
            const float mnew = fmaxf(mrun[nt], mloc), alpha = __builtin_amdgcn_exp2f(mrun[nt] - mnew); \
            mrun[nt] = mnew; \
            float ls = 0.f; \
            _Pragma("unroll") for (int mt = 0; mt < 4; ++mt) _Pragma("unroll") for (int j = 0; j < 4; ++j) { const float p = __builtin_amdgcn_exp2f(s[mt][nt][j] - mnew); s[mt][nt][j] = p; ls += p; } \
            lrun[nt] = lrun[nt] * alpha + ls; \
            _Pragma("unroll") for (int dt = 0; dt < DT; ++dt) o[dt][nt] = o[dt][nt] * alpha; \
            _Pragma("unroll") for (int kb = 0; kb < 2; ++kb) { \
                u32x4 w; w.x = cvt_pk_bf16(s[2 * kb][nt][0], s[2 * kb][nt][1]); w.y = cvt_pk_bf16(s[2 * kb][nt][2], s[2 * kb][nt][3]); \
                w.z = cvt_pk_bf16(s[2 * kb + 1][nt][0], s[2 * kb + 1][nt][1]); w.w = cvt_pk_bf16(s[2 * kb + 1][nt][2], s[2 * kb + 1][nt][3]); \
                pf[nt][kb] = __builtin_bit_cast(bf16x8, w); } } \
        if (!PF) { asm volatile("" ::: "memory"); ATT_LOADV(vcur, t); } \
        _Pragma("unroll") for (int dt = 0; dt < DT; ++dt) _Pragma("unroll") for (int nt = 0; nt < NT; ++nt) _Pragma("unroll") for (int kb = 0; kb < 2; ++kb) \
            o[dt][nt] = __builtin_amdgcn_mfma_f32_16x16x32_bf16(vcur[dt][kb], pf[nt][kb], o[dt][nt], 0, 0, 0); \
    } while (0)
    if (PF) { ATT_LOADK(0); ATT_LOADV(vfA, 0);
#pragma nounroll
        for (int t = 0; t < ntiles; t += 2) {
            ATT_BODY(t, vfA, vfB);
            if (t + 1 < ntiles) ATT_BODY(t + 1, vfB, vfA);
        }
    } else {
#pragma nounroll
        for (int t = 0; t < ntiles; ++t) ATT_BODY(t, vfA, vfB);
    }
#undef ATT_BODY
#undef ATT_LOADK
#undef ATT_LOADV
#pragma unroll
    for (int nt = 0; nt < NT; ++nt) {
        float l = lrun[nt]; l += __shfl_xor(l, 16); l += __shfl_xor(l, 32);
        const float inv = 1.0f / l;
#pragma unroll
        for (int dt = 0; dt < DT; ++dt) {
            const f32x4 v = o[dt][nt] * inv; u32x2 w; w.x = cvt_pk_bf16(v[0], v[1]); w.y = cvt_pk_bf16(v[2], v[3]);
            *(u32x2*)(Op + (size_t)(nt * 16 + fr) * ldo + dt * 16 + 4 * fq) = w;
        }
    }
}

#define XB_TMO      128
#define XB_XCNT(j)  (256  + 64 * (j))
#define XB_XSUB(j)  (1280 + 64 * (j))
#define XB_XGEN(j)  (2304 + 64 * (j))
#define XB_TOP      3328
#define XB_TOPGEN   3392
#define XCD_BAR_WORDS 3456
#define XB_SPIN_CAP (1u << 22)
__device__ __forceinline__ unsigned xb_ld(unsigned* p)              { return __hip_atomic_load(p, __ATOMIC_RELAXED, __HIP_MEMORY_SCOPE_AGENT); }
__device__ __forceinline__ unsigned xb_add(unsigned* p, unsigned v) { return __hip_atomic_fetch_add(p, v, __ATOMIC_RELAXED, __HIP_MEMORY_SCOPE_AGENT); }
__device__ __forceinline__ unsigned xb_xcc_id() { return (unsigned)__builtin_amdgcn_s_getreg((3 << 11) | 20) & 0xFu; }
#define XB_SPIN(cond, bar) do { unsigned _sp = 0; while (cond) { __builtin_amdgcn_s_sleep(1); \
    if ((++_sp & 255u) == 0u) { if (xb_ld(&(bar)[XB_TMO])) break; if (_sp > XB_SPIN_CAP) { atomicAdd(&(bar)[XB_TMO], 1u); break; } } } } while (0)
struct XcdBarrier { unsigned* bar; unsigned x; volatile LAS unsigned* st; };
__device__ __forceinline__ XcdBarrier xcd_barrier_post(unsigned* bar, volatile LAS unsigned* st) {
    XcdBarrier b; b.bar = bar; b.x = xb_xcc_id(); b.st = st;
    if (threadIdx.x == 0) (void)xb_add(&bar[XB_XCNT(b.x)], 1u);
    return b;
}
__device__ __forceinline__ void xcd_barrier_complete(unsigned* bar, unsigned x, unsigned& nloc, unsigned& nx) {
    const unsigned G = gridDim.x * gridDim.y * gridDim.z;
    unsigned sum, cnt, mine, sp = 0u;
    for (;;) {
        sum = 0u; cnt = 0u; mine = 0u;
#pragma unroll
        for (unsigned j = 0; j < 16; ++j) { const unsigned c = xb_ld(&bar[XB_XCNT(j)]); sum += c; cnt += (c > 0u) ? 1u : 0u; mine = (j == x) ? c : mine; }
        if (sum == G) break;
        __builtin_amdgcn_s_sleep(1);
        if ((++sp & 255u) == 0u) { if (xb_ld(&bar[XB_TMO])) break; if (sp > XB_SPIN_CAP) { atomicAdd(&bar[XB_TMO], 1u); break; } }
    }
    nloc = mine > 0u ? mine : 1u; nx = cnt > 0u ? cnt : 1u;
}
__device__ __forceinline__ void xcd_barrier(const XcdBarrier& b) {
    asm volatile("s_waitcnt vmcnt(0)" ::: "memory");
    __syncthreads();
    if (threadIdx.x == 0) {
        unsigned* bar = b.bar;
        __builtin_amdgcn_s_waitcnt(0);
        unsigned nloc = b.st[0], nx = b.st[1];
        if (nloc == 0u) { xcd_barrier_complete(bar, b.x, nloc, nx); b.st[0] = nloc; b.st[1] = nx; }
        const unsigned old = xb_add(&bar[XB_XSUB(b.x)], 1u);
        const unsigned gen = old / nloc;
        if (old + 1u == (gen + 1u) * nloc) {
            __builtin_amdgcn_fence(__ATOMIC_RELEASE, "agent");
            asm volatile("s_waitcnt vmcnt(0)" ::: "memory");
            const unsigned og = xb_add(&bar[XB_TOP], 1u);
            const unsigned tg = og / nx;
            if (og + 1u == (tg + 1u) * nx) xb_add(&bar[XB_TOPGEN], 1u);
            else XB_SPIN(xb_ld(&bar[XB_TOPGEN]) == tg, bar);
            __builtin_amdgcn_fence(__ATOMIC_ACQUIRE, "agent");
            xb_add(&bar[XB_XGEN(b.x)], 1u);
            asm volatile("s_waitcnt vmcnt(0)" ::: "memory");
        } else {
            XB_SPIN(xb_ld(&bar[XB_XGEN(b.x)]) == gen, bar);
            __builtin_amdgcn_fence(__ATOMIC_ACQUIRE, "agent");
            asm volatile("s_waitcnt vmcnt(0)" ::: "memory");
        }
    }
    __syncthreads();
}

struct Params {
    const float* x; const float* mem;
    const float* ffn1_norm; const float* ffn1_wg; const float* ffn1_wu; const float* ffn1_wd;
    const float* mix_norm; const float* w_in; const float* rel_bias; const float* w_pool; const float* pool_scale; const float* w_out;
    const float* cross_norm; const float* mem_norm; const float* w_cq; const float* w_ckv; const float* w_co;
    const float* ffn2_norm; const float* ffn2_wg; const float* ffn2_wu; const float* ffn2_wd; const float* final_norm;
    float* out; unsigned char* ws;
};

__device__ __forceinline__ void p0_transpose_item(const float* __restrict__ W, int K, int N, bf16_t* __restrict__ WT, int mode, int row_off, const float* __restrict__ gain, LAS float* scr, int item, int lane) {
    const int nblk = N / 32, kb = item / nblk, nb = item - kb * nblk, k0 = 64 * kb, n0 = 32 * nb;
#pragma unroll 8
    for (int i = 0; i < 32; ++i) { const int kk = 2 * i + (lane >> 5); const float gk = gain ? gain[k0 + kk] : 1.0f; scr[kk * 33 + (lane & 31)] = W[(size_t)(k0 + kk) * N + n0 + (lane & 31)] * gk; }
    asm volatile("s_waitcnt lgkmcnt(0)" ::: "memory");
    const int c = lane & 7;
    const int d0 = (mode == 0) ? (row_off + n0) : ((n0 >> 7) * 256 + (n0 & 127) + (mode == 2 ? 128 : 0));
#pragma unroll
    for (int j = 0; j < 4; ++j) { const int n = (lane >> 3) + 8 * j; const LAS float* s = scr + (8 * c) * 33 + n;
        u32x4 o; o.x = cvt_pk_bf16(s[0 * 33], s[1 * 33]); o.y = cvt_pk_bf16(s[2 * 33], s[3 * 33]); o.z = cvt_pk_bf16(s[4 * 33], s[5 * 33]); o.w = cvt_pk_bf16(s[6 * 33], s[7 * 33]);
        *(u32x4*)(WT + (size_t)(d0 + n) * K + k0 + 8 * c) = o; }
    asm volatile("s_waitcnt lgkmcnt(0)" ::: "memory");
}

#define rowss ((float*)(P.ws + WS_ROWSS))
#define Wgu1 ((bf16_t*)(P.ws + WS_WGU1))
#define Wd1 ((bf16_t*)(P.ws + WS_WD1))
#define Win ((bf16_t*)(P.ws + WS_WIN))
#define Wp ((bf16_t*)(P.ws + WS_WP))
#define Wout ((bf16_t*)(P.ws + WS_WOUT))
#define Wcq ((bf16_t*)(P.ws + WS_WCQ))
#define Wckv ((bf16_t*)(P.ws + WS_WCKV))
#define Wco ((bf16_t*)(P.ws + WS_WCO))
#define Wgu2 ((bf16_t*)(P.ws + WS_WGU2))
#define Wd2 ((bf16_t*)(P.ws + WS_WD2))
#define HB ((bf16_t*)(P.ws + WS_HB))
#define ACT ((bf16_t*)(P.ws + WS_ACT))
#define Z ((bf16_t*)(P.ws + WS_Z))
#define VT ((bf16_t*)(P.ws + WS_VT))
#define Y ((bf16_t*)(P.ws + WS_Y))
#define CQ ((bf16_t*)(P.ws + WS_CQ))
#define CO ((bf16_t*)(P.ws + WS_CO))
#define DP ((bf16_t*)(P.ws + WS_DP))
#define MEMN ((bf16_t*)(P.ws + WS_MEMN))
#define KC ((bf16_t*)(P.ws + WS_KC))
#define VCT ((bf16_t*)(P.ws + WS_VCT))
__global__ void __launch_bounds__(512, 2) fwd_megakernel(Params P) {
    extern __shared__ __attribute__((aligned(16))) unsigned char lds_raw[];
    cg::grid_group grid = cg::this_grid();
    LAS unsigned char* lds = (LAS unsigned char*)lds_raw;
    const int tid = threadIdx.x, lane = tid & 63, wave = __builtin_amdgcn_readfirstlane(tid >> 6);
    const int G = gridDim.x, bx = blockIdx.x;
    const int gw = bx * 8 + wave, NGW = G * 8;
    volatile LAS unsigned* bst = (volatile LAS unsigned*)(lds + 131072 + 64);
    if (tid < 2) bst[tid] = 0u;
    __syncthreads();
    const XcdBarrier xbar = xcd_barrier_post((unsigned*)(P.ws + WS_BAR), bst);
#define RUN_GEMM(EPI, gM, gN, gdesc, edesc) do { pg8::StaticOrder S_; S_.init((gM), (gN), G, bx); pg8::gemm_phase<EPI>(lds, (gdesc), S_, (edesc)); } while (0)

    for (int rep_ = 0; rep_ < REP_P0; ++rep_) {
        LAS float* scr = (LAS float*)(lds + wave * 16384);
        constexpr int I_G = (DM / 64) * (DFF / 32), I_D = (DFF / 64) * (DM / 32), I_IN = (DM / 64) * (DIN / 32), I_P = (256 / 64) * (256 / 32), I_O = (DM / 64) * (DM / 32),
                      I_CQ = (DM / 64) * (DCROSS / 32), I_CKV = (DM / 64) * (2 * DCROSS / 32), I_CO = (DCROSS / 64) * (DM / 32);
        constexpr int NITEMS = 4 * I_G + 2 * I_D + I_IN + 4 * I_P + I_O + I_CQ + I_CKV + I_CO;
        for (int it = gw; it < NITEMS; it += NGW) {
            int r = it;
            if (r < I_G) { p0_transpose_item(P.ffn1_wg, DM, DFF, Wgu1, 1, 0, P.ffn1_norm, scr, r, lane); continue; } r -= I_G;
            if (r < I_G) { p0_transpose_item(P.ffn1_wu, DM, DFF, Wgu1, 2, 0, P.ffn1_norm, scr, r, lane); continue; } r -= I_G;
            if (r < I_D) { p0_transpose_item(P.ffn1_wd, DFF, DM, Wd1, 0, 0, nullptr, scr, r, lane); continue; } r -= I_D;
            if (r < I_G) { p0_transpose_item(P.ffn2_wg, DM, DFF, Wgu2, 1, 0, P.ffn2_norm, scr, r, lane); continue; } r -= I_G;
            if (r < I_G) { p0_transpose_item(P.ffn2_wu, DM, DFF, Wgu2, 2, 0, P.ffn2_norm, scr, r, lane); continue; } r -= I_G;
            if (r < I_D) { p0_transpose_item(P.ffn2_wd, DFF, DM, Wd2, 0, 0, nullptr, scr, r, lane); continue; } r -= I_D;
            if (r < I_IN) { p0_transpose_item(P.w_in, DM, DIN, Win, 0, 0, P.mix_norm, scr, r, lane); continue; } r -= I_IN;
            if (r < 4 * I_P) { const int gi = r / I_P; p0_transpose_item(P.w_pool + (size_t)gi * 65536, 256, 256, Wp, 0, gi * 256, nullptr, scr, r - gi * I_P, lane); continue; } r -= 4 * I_P;
            if (r < I_O) { p0_transpose_item(P.w_out, DM, DM, Wout, 0, 0, nullptr, scr, r, lane); continue; } r -= I_O;
            if (r < I_CQ) { p0_transpose_item(P.w_cq, DM, DCROSS, Wcq, 0, 0, P.cross_norm, scr, r, lane); continue; } r -= I_CQ;
            if (r < I_CKV) { p0_transpose_item(P.w_ckv, DM, 2 * DCROSS, Wckv, 0, 0, nullptr, scr, r, lane); continue; } r -= I_CKV;
            p0_transpose_item(P.w_co, DCROSS, DM, Wco, 0, 0, nullptr, scr, r, lane);
        }
        for (int i = bx * 512 + tid; i < 4 * MTOK; i += G * 512) rowss[MTOK + i] = 0.f;
        for (int m = gw; m < MTOK; m += NGW) {
            const f32x4* xr = (const f32x4*)(P.x + (size_t)m * DM) + lane; u32x2* o8 = (u32x2*)(HB + (size_t)m * DM) + lane; float s = 0.f;
#pragma unroll
            for (int j = 0; j < 8; ++j) { const f32x4 v = xr[64 * j]; s += (v[0] * v[0] + v[1] * v[1]) + (v[2] * v[2] + v[3] * v[3]); u32x2 w; w.x = cvt_pk_bf16(v[0], v[1]); w.y = cvt_pk_bf16(v[2], v[3]); o8[64 * j] = w; }
            s = wave_sum(s); if (lane == 0) rowss[m] = s;
        }
        for (int m = gw; m < BATCH * NMEM; m += NGW) {
            const f32x4* xr = (const f32x4*)(P.mem + (size_t)m * DM) + lane; const f32x4* gr = (const f32x4*)P.mem_norm + lane; u32x2* o8 = (u32x2*)(MEMN + (size_t)m * DM) + lane;
            f32x4 v[8]; float s = 0.f;
#pragma unroll
            for (int j = 0; j < 8; ++j) { v[j] = xr[64 * j]; s += (v[j][0] * v[j][0] + v[j][1] * v[j][1]) + (v[j][2] * v[j][2] + v[j][3] * v[j][3]); }
            const float rs = __builtin_amdgcn_rsqf(wave_sum(s) * (1.0f / DM) + EPS);
#pragma unroll
            for (int j = 0; j < 8; ++j) { const f32x4 gg = gr[64 * j]; const f32x4 y = v[j] * rs * gg; u32x2 w; w.x = cvt_pk_bf16(y[0], y[1]); w.y = cvt_pk_bf16(y[2], y[3]); o8[64 * j] = w; }
        }
    }
    grid.sync();
    for (int rep_ = 0; rep_ < REP_G1; ++rep_)
    RUN_GEMM(pg8::EpiSwiglu, MTOK, 2 * DFF, (pg8::Gemm{HB, Wgu1, DM, DM, DM, 0}), (pg8::EpiSwiglu{ACT, DFF, rowss}));
    for (int rep_ = 0; rep_ < REP_G1NULL; ++rep_)
    RUN_GEMM(pg8::EpiNull, MTOK, 2 * DFF, (pg8::Gemm{HB, Wgu1, DM, DM, DM, 0}), (pg8::EpiNull{}));
    for (int rep_ = 0; rep_ < REP_SYNC; ++rep_) grid.sync();
    RUN_GEMM(pg8::EpiBf, BATCH * NMEM, 2 * DCROSS, (pg8::Gemm{MEMN, Wckv, DM, DM, DM, 0}), (pg8::EpiBf{KC, DCROSS, 0, nullptr, nullptr, 2, 4, NMEM, DCROSS, VCT}));
    xcd_barrier(xbar);
    for (int rep_ = 0; rep_ < REP_G2; ++rep_)
    RUN_GEMM(pg8::EpiRes<true>, MTOK, DM, (pg8::Gemm{ACT, Wd1, DFF, DFF, DFF, 0}), (pg8::EpiRes<true>{P.x, HB, nullptr, 0.5f}));
    RUN_GEMM(pg8::EpiRes<true>, MTOK, DM, (pg8::Gemm{ACT, Wd1, DFF, DFF, DFF, 0}), (pg8::EpiRes<true>{P.x, HB, rowss + 1 * MTOK, 0.5f}));
    xcd_barrier(xbar);
    for (int rep_ = 0; rep_ < REP_G3; ++rep_)
    RUN_GEMM(pg8::EpiBf, MTOK, DIN, (pg8::Gemm{HB, Win, DM, DM, DM, 0}), (pg8::EpiBf{Z, DIN, 0, rowss + 1 * MTOK, nullptr, 8, 12, SEQ, DATT, VT}));
    xcd_barrier(xbar);
    for (int rep_ = 0; rep_ < REP_ATT; ++rep_) {
        for (int task = gw; task < (MTOK / 64) * 4; task += NGW) {
            const int gi = task & 3, rt = task >> 2, sub = lane >> 5, cgi = lane & 31, w = 2 << gi;
            const int t0 = rt * 64 + sub * 32, tpos = t0 & (SEQ - 1);
            const bf16_t* up = Z + (size_t)t0 * DIN + 3 * DATT + gi * 256 + cgi * 8;
            bf16_t* dp = DP + (size_t)t0 * DPOOL + gi * 256 + cgi * 8;
            float sum[8];
#pragma unroll
            for (int e = 0; e < 8; ++e) sum[e] = 0.f;
            for (int i = 1; i < w; ++i) if (tpos - i >= 0) { const u32x4 v = *(const u32x4*)(up - (size_t)i * DIN);
                sum[0] += bf_lo(v.x); sum[1] += bf_hi(v.x); sum[2] += bf_lo(v.y); sum[3] += bf_hi(v.y); sum[4] += bf_lo(v.z); sum[5] += bf_hi(v.z); sum[6] += bf_lo(v.w); sum[7] += bf_hi(v.w); }
#pragma nounroll
            for (int r0 = 0; r0 < 32; r0 += 8) {
                u32x4 cv[8], ov[8];
#pragma unroll
                for (int j = 0; j < 8; ++j) cv[j] = *(const u32x4*)(up + (size_t)(r0 + j) * DIN);
#pragma unroll
                for (int j = 0; j < 8; ++j) { const int rr = r0 + j - w + 1; ov[j] = (tpos + rr >= 0) ? *(const u32x4*)(up + (ptrdiff_t)rr * DIN) : (u32x4){0u, 0u, 0u, 0u}; }
#pragma unroll
                for (int j = 0; j < 8; ++j) {
                    const u32x4 v = cv[j], q = ov[j];
                    const float cur[8] = {bf_lo(v.x), bf_hi(v.x), bf_lo(v.y), bf_hi(v.y), bf_lo(v.z), bf_hi(v.z), bf_lo(v.w), bf_hi(v.w)};
                    const float old[8] = {bf_lo(q.x), bf_hi(q.x), bf_lo(q.y), bf_hi(q.y), bf_lo(q.z), bf_hi(q.z), bf_lo(q.w), bf_hi(q.w)};
                    const int have = tpos + r0 + j + 1; const float inv = 1.0f / (float)(have < w ? have : w);
                    float d[8];
#pragma unroll
                    for (int e = 0; e < 8; ++e) { sum[e] += cur[e]; d[e] = sum[e] * inv - cur[e]; sum[e] -= old[e]; }
                    u32x4 o; o.x = cvt_pk_bf16(d[0], d[1]); o.y = cvt_pk_bf16(d[2], d[3]); o.z = cvt_pk_bf16(d[4], d[5]); o.w = cvt_pk_bf16(d[6], d[7]);
                    *(u32x4*)(dp + (size_t)(r0 + j) * DPOOL) = o;
                }
            }
        }
        LAS float* tab = (LAS float*)lds;
        for (int bh = bx; bh < BATCH * 16; bh += G) {
            const int b = bh >> 4, h = bh & 15;
            __syncthreads();
            for (int i = tid; i < NREL; i += 512) tab[i] = P.rel_bias[h * NREL + i] * LOG2E;
            __syncthreads();
#pragma nounroll
            for (int i = 0; i < 8; ++i) {
                const int c = i * 4 + (wave >> 1), half = wave & 1, j0 = c < 8 ? 8 - c : 0, kstart = (c - 8 + j0) * 64;
                const size_t qrow = (size_t)b * SEQ + c * 64 + half * 32;
#ifndef NO_ATT5
                attn_wave32<64, true, 2, true>(Z + qrow * DIN + h * 64, DIN, Z + ((size_t)b * SEQ + kstart) * DIN + DATT + h * 64, DIN,
                                      VT + ((size_t)b * DATT + h * 64) * SEQ + kstart, SEQ, Y + qrow * DM + h * 64, DM, 9 - j0, 0.125f * LOG2E, tab, half * 32 + (8 - j0) * 64, lane);
#endif
            }
        }
        __syncthreads();
    }
    xcd_barrier(xbar);
    RUN_GEMM(pg8::EpiBf, MTOK, DPOOL, (pg8::Gemm{DP, Wp, DPOOL, 256, 256, 512}), (pg8::EpiBf{Y, DM, DATT, nullptr, P.pool_scale, 0, 0, 1, 1, nullptr}));
    xcd_barrier(xbar);
    RUN_GEMM(pg8::EpiRes<false>, MTOK, DM, (pg8::Gemm{Y, Wout, DM, DM, DM, 0}), (pg8::EpiRes<false>{nullptr, HB, rowss + 2 * MTOK, 1.0f}));
    xcd_barrier(xbar);
    RUN_GEMM(pg8::EpiBf, MTOK, DCROSS, (pg8::Gemm{HB, Wcq, DM, DM, DM, 0}), (pg8::EpiBf{CQ, DCROSS, 0, rowss + 2 * MTOK, nullptr, 0, 0, 1, 1, nullptr}));
    xcd_barrier(xbar);
    {
        for (int it = bx; it < BATCH * 16; it += G) {
            const int b = it >> 4, sub = it & 15;
#pragma nounroll
            for (int r = 0; r < 4; ++r) {
                const int wu = r * 8 + wave, head = wu & 3, qblk = wu >> 2;
                const size_t qrow = (size_t)b * SEQ + sub * 128 + qblk * 16;
#ifndef NO_ATT9
                attn_wave32<128, false, 1, false>(CQ + qrow * DCROSS + head * 128, DCROSS, KC + (size_t)b * NMEM * DCROSS + head * 128, DCROSS,
                                        VCT + ((size_t)b * DCROSS + head * 128) * NMEM, NMEM, CO + qrow * DCROSS + head * 128, DCROSS, 4, 0.08838834764831845f * LOG2E, nullptr, 0, lane);
#endif
            }
        }
    }
    xcd_barrier(xbar);
    RUN_GEMM(pg8::EpiRes<false>, MTOK, DM, (pg8::Gemm{CO, Wco, DCROSS, DCROSS, DCROSS, 0}), (pg8::EpiRes<false>{nullptr, HB, rowss + 3 * MTOK, 1.0f}));
    xcd_barrier(xbar);
    RUN_GEMM(pg8::EpiSwiglu, MTOK, 2 * DFF, (pg8::Gemm{HB, Wgu2, DM, DM, DM, 0}), (pg8::EpiSwiglu{ACT, DFF, rowss + 3 * MTOK}));
    xcd_barrier(xbar);
    RUN_GEMM(pg8::EpiRes<false>, MTOK, DM, (pg8::Gemm{ACT, Wd2, DFF, DFF, DFF, 0}), (pg8::EpiRes<false>{nullptr, HB, rowss + 4 * MTOK, 0.5f}));
    xcd_barrier(xbar);
    {
        const float* rs4 = rowss + 4 * MTOK;
        for (int m = gw; m < MTOK; m += NGW) {
            const u32x2* hr = (const u32x2*)(HB + (size_t)m * DM) + lane; f32x4* xr = (f32x4*)(P.out + (size_t)m * DM) + lane; const f32x4* gr = (const f32x4*)P.final_norm + lane;
            const float rs = __builtin_amdgcn_rsqf(rs4[m] * (1.0f / DM) + EPS);
#pragma unroll
            for (int j = 0; j < 8; ++j) { const u32x2 q = hr[64 * j]; const f32x4 v = (f32x4){bf_lo(q.x), bf_hi(q.x), bf_lo(q.y), bf_hi(q.y)}; xr[64 * j] = v * rs * gr[64 * j]; }
        }
    }
#undef RUN_GEMM
}

extern "C" void kernel_launch(void* const* d_in, const int* in_sizes, int n_in, void* d_out, int out_size, void* d_ws, size_t ws_size, hipStream_t stream) {
    static int grid_blocks = 0;
    if (grid_blocks == 0) {
        if (n_in != 22 || in_sizes[0] != MTOK * DM || out_size != MTOK * DM || ws_size < WS_END) {
            fprintf(stderr, "kernel_launch: unexpected shapes (n_in %d, in0 %d, out %d, ws %zu)\n", n_in, n_in > 0 ? in_sizes[0] : -1, out_size, ws_size); grid_blocks = -1; return; }
        int dev = 0, cus = 0, per_cu = 0;
        hipGetDevice(&dev);
        hipDeviceGetAttribute(&cus, hipDeviceAttributeMultiprocessorCount, dev);
        if (hipFuncSetAttribute((const void*)fwd_megakernel, hipFuncAttributeMaxDynamicSharedMemorySize, LDS_BYTES) != hipSuccess) { fprintf(stderr, "kernel_launch: hipFuncSetAttribute failed\n"); grid_blocks = -1; return; }
        if (hipOccupancyMaxActiveBlocksPerMultiprocessor(&per_cu, (const void*)fwd_megakernel, 512, LDS_BYTES) != hipSuccess || per_cu < 1) { fprintf(stderr, "kernel_launch: occupancy query gave %d\n", per_cu); per_cu = 1; }
        (void)hipGetLastError();
        grid_blocks = cus * per_cu;
    }
    if (grid_blocks < 0) return;
    Params p{};
    const float* const* in = (const float* const*)d_in;
    p.x = in[0]; p.mem = in[1]; p.ffn1_norm = in[2]; p.ffn1_wg = in[3]; p.ffn1_wu = in[4]; p.ffn1_wd = in[5]; p.mix_norm = in[6]; p.w_in = in[7]; p.rel_bias = in[8];
    p.w_pool = in[9]; p.pool_scale = in[10]; p.w_out = in[11]; p.cross_norm = in[12]; p.mem_norm = in[13]; p.w_cq = in[14]; p.w_ckv = in[15]; p.w_co = in[16];
    p.ffn2_norm = in[17]; p.ffn2_wg = in[18]; p.ffn2_wu = in[19]; p.ffn2_wd = in[20]; p.final_norm = in[21];
    p.out = (float*)d_out; p.ws = (unsigned char*)d_ws;
    if (hipMemsetAsync((char*)d_ws + WS_BAR, 0, WS_BAR_BYTES, stream) != hipSuccess) { fprintf(stderr, "kernel_launch: memset of the barrier words failed\n"); return; }
    void* args[] = {&p};
    hipError_t e = hipLaunchCooperativeKernel((const void*)fwd_megakernel, dim3(grid_blocks), dim3(512), args, LDS_BYTES, stream);
    if (e != hipSuccess) fprintf(stderr, "cooperative launch failed: %s (grid %d)\n", hipGetErrorString(e), grid_blocks);
}
```

```cpp
#include <hip/hip_runtime.h>
#include <hip/hip_cooperative_groups.h>
#include <cstdio>
#include <cstdint>
namespace cg = cooperative_groups;

#define LAS __attribute__((address_space(3)))
typedef unsigned short bf16_t;
typedef short bf16x8 __attribute__((ext_vector_type(8)));
typedef float f32x4 __attribute__((ext_vector_type(4)));
typedef float f32x2 __attribute__((ext_vector_type(2)));
typedef unsigned u32x4 __attribute__((ext_vector_type(4)));
typedef unsigned u32x2 __attribute__((ext_vector_type(2)));

constexpr int BATCH = 16, SEQ = 2048, DM = 2048, MTOK = BATCH * SEQ;
constexpr int DFF = 5632, DIN = 4096, DATT = 1024, DPOOL = 1024, NMEM = 256, DCROSS = 512;
constexpr int NREL = 257;
constexpr float EPS = 1e-6f;
constexpr float LOG2E = 1.4426950408889634f;

constexpr size_t MiB = 1u << 20;
constexpr size_t WS_ROWSS = 0;
constexpr size_t WS_BAR = 896 * 1024, WS_BAR_BYTES = 16384;
constexpr size_t WS_WGU1 = 1 * MiB, WS_WD1 = 45 * MiB, WS_WIN = 67 * MiB, WS_WP = 83 * MiB, WS_WOUT = 84 * MiB, WS_WCQ = 92 * MiB,
                 WS_WCKV = 94 * MiB, WS_WCO = 98 * MiB, WS_WGU2 = 100 * MiB, WS_WD2 = 144 * MiB;
constexpr size_t WS_HB = 166 * MiB;
constexpr size_t WS_ACT = 294 * MiB;
constexpr size_t WS_Z = 294 * MiB;
constexpr size_t WS_VT = 550 * MiB;
constexpr size_t WS_Y = 646 * MiB;
constexpr size_t WS_CQ = 646 * MiB, WS_CO = 678 * MiB;
constexpr size_t WS_DP = 774 * MiB;
constexpr size_t WS_MEMN = 838 * MiB;
constexpr size_t WS_KC = 854 * MiB;
constexpr size_t WS_VCT = 858 * MiB;
constexpr size_t WS_KF = 862 * MiB;
constexpr size_t WS_END = 926 * MiB;

#ifndef REP_G1NULL
#define REP_G1NULL 0
#endif
#ifndef REP_SYNC
#define REP_SYNC 0
#endif
#ifndef REP_G2
#define REP_G2 0
#endif
#ifndef REP_G2NULL
#define REP_G2NULL 0
#endif
#ifndef REP_ATTC
#define REP_ATTC 0
#endif
#ifndef REP_P0
#define REP_P0 1
#endif
#ifndef REP_G1
#define REP_G1 1
#endif
#ifndef REP_ATT
#define REP_ATT 1
#endif
#ifndef REP_G3
#define REP_G3 1
#endif
constexpr int LDS_BYTES = 147456;

__device__ __forceinline__ unsigned cvt_pk_bf16(float lo, float hi) { unsigned r; asm volatile("v_cvt_pk_bf16_f32 %0, %1, %2" : "=v"(r) : "v"(lo), "v"(hi)); return r; }
__device__ __forceinline__ float bf_lo(unsigned w) { return __uint_as_float(w << 16); }
__device__ __forceinline__ float bf_hi(unsigned w) { return __uint_as_float(w & 0xffff0000u); }
__device__ __forceinline__ float wave_sum(float v) {
#pragma unroll
    for (int o = 1; o < 64; o <<= 1) v += __shfl_xor(v, o);
    return v;
}

namespace pg8 {
constexpr int BM = 256, BK = 64, HALF = 128, HTB = HALF * BK * 2, STAGE_BYTES = 8 * HTB, NXCD = 8;
__host__ __device__ __forceinline__ int lds_byte(int r, int c) { const int st = (r >> 4) * 2 + (c >> 5), rr = r & 15, cc = c & 31, ob = rr * 64 + cc * 2; return st * 1024 + (ob ^ (((ob >> 9) & 1) << 5)); }
__host__ __device__ __forceinline__ void stage_rc(int b, int& R, int& C) { const int st = b / 1024, sb = b % 1024, swz = sb ^ (((sb >> 9) & 1) << 5); R = (st >> 1) * 16 + swz / 64; C = (st & 1) * 32 + (swz % 64) / 2; }
__host__ __device__ __forceinline__ int perm32(int rho) { const int n = rho >> 4, i = rho & 15; return 8 * (i >> 2) + 4 * n + (i & 3); }

struct Unit { int pm, pn; };
struct Gemm { const bf16_t* A; const bf16_t* Bt; int lda, ldb, K, a_pn_step; };

struct StaticOrder {
    int nM, nN, nwg, G, c, WGM, rev;
    __device__ void init(int M, int N, int G_, int c_, int wgm = 8, int rev_ = 0) { nM = M / BM; nN = N / BM; nwg = nM * nN; G = G_; c = c_; WGM = wgm; rev = rev_; }
    __device__ bool next(int i, Unit& u) const {
        const int nr = (nwg + G - 1) / G; if (i >= nr) return false;
        long L = (long)(rev ? nr - 1 - i : i) * G + c;
        if (L >= nwg) { if (!rev) return false; L = (long)(nr - 2 - i) * G + c; if (i + 1 >= nr) return false; }
        int wgid = (int)L; { const int q = nwg / NXCD, r = nwg % NXCD, xcd = wgid % NXCD, off = wgid / NXCD; wgid = (xcd < r ? xcd * (q + 1) : r * (q + 1) + (xcd - r) * q) + off; }
        const int nig = WGM * nN, gid = wgid / nig, fm = gid * WGM, gsz = (nM - fm) < WGM ? (nM - fm) : WGM;
        u.pm = fm + ((wgid % nig) % gsz); u.pn = (wgid % nig) / gsz; return true;
    }
};

template <bool FM> struct EpiBf {
    bf16_t* O; int ldc; int col_off; const float* rowss; const float* colscale; int t_lo, t_hi, t_rows, t_cols; bf16_t* VT; int k_lo, k_hi; bf16_t* KF;
    __device__ __forceinline__ void operator()(const f32x4 (&acc)[2][2][4][2], const Unit& u, int wr, int wc, int fr, int fq) const {
        const int row0 = u.pm * BM + wr * 64 + fr, cl = wc * 32 + 8 * fq;
        const bool tr = (u.pn >= t_lo) && (u.pn < t_hi);
        const bool kfm = FM && (u.pn >= k_lo) && (u.pn < k_hi);
        f32x4 cs[2][2]; float rsv[8];
#pragma unroll
        for (int bj = 0; bj < 2; ++bj)
#pragma unroll
            for (int n = 0; n < 2; ++n) cs[bj][n] = colscale ? *(const f32x4*)(colscale + u.pn * BM + bj * HALF + cl + 4 * n) : (f32x4){1.f, 1.f, 1.f, 1.f};
#pragma unroll
        for (int i = 0; i < 8; ++i) rsv[i] = rowss ? rowss[row0 + (i >> 2) * HALF + (i & 3) * 16] : 0.f;
        asm volatile("" ::: "memory");
#pragma unroll
        for (int ai = 0; ai < 2; ++ai)
#pragma unroll
            for (int m = 0; m < 4; ++m) {
                const int row = row0 + ai * HALF + m * 16;
                const float rsc = rowss ? __builtin_amdgcn_rsqf(rsv[ai * 4 + m] * (1.0f / DM) + EPS) : 1.0f;
#pragma unroll
                for (int bj = 0; bj < 2; ++bj) {
                    const f32x4 v0 = acc[ai][bj][m][0] * rsc * cs[bj][0], v1 = acc[ai][bj][m][1] * rsc * cs[bj][1];
                    u32x4 w; w.x = cvt_pk_bf16(v0[0], v0[1]); w.y = cvt_pk_bf16(v0[2], v0[3]); w.z = cvt_pk_bf16(v1[0], v1[1]); w.w = cvt_pk_bf16(v1[2], v1[3]);
                    if (FM && (kfm || tr)) {
                        const int c = (u.pn - (kfm ? k_lo : t_lo)) * BM + bj * HALF + cl, hh = c >> 6, d = c & 63;
                        const int bb = row >> 11, s = row & (SEQ - 1), tile = s >> 6, k = s & 63;
                        const size_t tbase = ((size_t)((bb * 16 + hh) * 32 + tile)) * 4096;
                        if (kfm) {
                            const int kb = k >> 5, r = k & 31, mt = kb * 2 + ((r >> 2) & 1), fra = (r >> 3) * 4 + (r & 3), ks = d >> 5, fqa = (d >> 3) & 3;
                            *(u32x4*)(KF + tbase + ((mt * 2 + ks) * 64 + fqa * 16 + fra) * 8) = w;
                        } else {
                            const int dt = d >> 4, fra0 = d & 15, kb = k >> 5, fqa = (k & 31) >> 3, e8 = k & 7;
                            bf16_t* p = VT + tbase + ((dt * 2 + kb) * 64 + fqa * 16 + fra0) * 8 + e8;
                            p[0] = (bf16_t)(w.x & 0xffffu); p[8] = (bf16_t)(w.x >> 16); p[16] = (bf16_t)(w.y & 0xffffu); p[24] = (bf16_t)(w.y >> 16);
                            p[32] = (bf16_t)(w.z & 0xffffu); p[40] = (bf16_t)(w.z >> 16); p[48] = (bf16_t)(w.w & 0xffffu); p[56] = (bf16_t)(w.w >> 16);
                        }
                    } else if (!tr) { *(u32x4*)(O + (size_t)row * ldc + col_off + u.pn * BM + bj * HALF + cl) = w; }
                    else {
                        const int cv = (u.pn - t_lo) * BM + bj * HALF + cl, b = row / t_rows, s = row - b * t_rows;
                        bf16_t* p = VT + ((size_t)b * t_cols + cv) * t_rows + s;
                        p[0] = (bf16_t)(w.x & 0xffffu); p[(size_t)t_rows] = (bf16_t)(w.x >> 16); p[(size_t)2 * t_rows] = (bf16_t)(w.y & 0xffffu); p[(size_t)3 * t_rows] = (bf16_t)(w.y >> 16);
                        p[(size_t)4 * t_rows] = (bf16_t)(w.z & 0xffffu); p[(size_t)5 * t_rows] = (bf16_t)(w.z >> 16); p[(size_t)6 * t_rows] = (bf16_t)(w.w & 0xffffu); p[(size_t)7 * t_rows] = (bf16_t)(w.w >> 16);
                    }
                }
            }
    }
};
__device__ __forceinline__ float silu_mul(float g, float u) { return g * __builtin_amdgcn_rcpf(1.0f + __expf(-g)) * u; }
struct EpiSwiglu {
    bf16_t* O; int ldc; const float* rowss;
    __device__ __forceinline__ void operator()(const f32x4 (&acc)[2][2][4][2], const Unit& u, int wr, int wc, int fr, int fq) const {
        const int row0 = u.pm * BM + wr * 64 + fr, cl = wc * 32 + 8 * fq;
        float rsv[8];
#pragma unroll
        for (int i = 0; i < 8; ++i) rsv[i] = rowss[row0 + (i >> 2) * HALF + (i & 3) * 16];
        asm volatile("" ::: "memory");
#pragma unroll
        for (int ai = 0; ai < 2; ++ai)
#pragma unroll
            for (int m = 0; m < 4; ++m) {
                const int row = row0 + ai * HALF + m * 16;
                const float rsc = __builtin_amdgcn_rsqf(rsv[ai * 4 + m] * (1.0f / DM) + EPS);
                const f32x4 g0 = acc[ai][0][m][0] * rsc, g1 = acc[ai][0][m][1] * rsc, u0 = acc[ai][1][m][0] * rsc, u1 = acc[ai][1][m][1] * rsc;
                u32x4 w;
                w.x = cvt_pk_bf16(silu_mul(g0[0], u0[0]), silu_mul(g0[1], u0[1])); w.y = cvt_pk_bf16(silu_mul(g0[2], u0[2]), silu_mul(g0[3], u0[3]));
                w.z = cvt_pk_bf16(silu_mul(g1[0], u1[0]), silu_mul(g1[1], u1[1])); w.w = cvt_pk_bf16(silu_mul(g1[2], u1[2]), silu_mul(g1[3], u1[3]));
                *(u32x4*)(O + (size_t)row * ldc + u.pn * HALF + cl) = w;
            }
    }
};
template <bool F32IN> struct EpiRes {
    const float* hin_f; bf16_t* hb; float* rowss_out; float alpha;
    static constexpr int DEPTH = F32IN ? 2 : 4, NV = F32IN ? 4 : 2;
    __device__ __forceinline__ void ld(f32x4 (&hv)[4], size_t off) const {
        if (F32IN) { hv[0] = *(const f32x4*)(hin_f + off); hv[1] = *(const f32x4*)(hin_f + off + 4); hv[2] = *(const f32x4*)(hin_f + off + HALF); hv[3] = *(const f32x4*)(hin_f + off + HALF + 4); }
        else { hv[0] = __builtin_bit_cast(f32x4, *(const u32x4*)(hb + off)); hv[1] = __builtin_bit_cast(f32x4, *(const u32x4*)(hb + off + HALF)); }
    }
    __device__ __forceinline__ void operator()(const f32x4 (&acc)[2][2][4][2], const Unit& u, int wr, int wc, int fr, int fq) const {
        const int row0 = u.pm * BM + wr * 64 + fr, cl = u.pn * BM + wc * 32 + 8 * fq;
        f32x4 hv[DEPTH][4];
#pragma unroll
        for (int gi = 0; gi < DEPTH; ++gi) ld(hv[gi], (size_t)(row0 + (gi >> 2) * HALF + (gi & 3) * 16) * DM + cl);
#pragma unroll
        for (int gi = 0; gi < 8; ++gi) {
            const int ai = gi >> 2, m = gi & 3, cb = gi % DEPTH;
            asm volatile("" ::: "memory");
            const int row = row0 + ai * HALF + m * 16; const size_t off = (size_t)row * DM + cl;
            float ss = 0.f;
            u32x4 wv[2];
#pragma unroll
            for (int bj = 0; bj < 2; ++bj) {
                f32x4 o0, o1;
                if (F32IN) { o0 = hv[cb][2 * bj]; o1 = hv[cb][2 * bj + 1]; }
                else { const u32x4 q = __builtin_bit_cast(u32x4, hv[cb][bj]); o0 = (f32x4){bf_lo(q.x), bf_hi(q.x), bf_lo(q.y), bf_hi(q.y)}; o1 = (f32x4){bf_lo(q.z), bf_hi(q.z), bf_lo(q.w), bf_hi(q.w)}; }
                const f32x4 h0 = o0 + acc[ai][bj][m][0] * alpha, h1 = o1 + acc[ai][bj][m][1] * alpha;
                ss += (h0[0] * h0[0] + h0[1] * h0[1]) + (h0[2] * h0[2] + h0[3] * h0[3]) + (h1[0] * h1[0] + h1[1] * h1[1]) + (h1[2] * h1[2] + h1[3] * h1[3]);
                wv[bj].x = cvt_pk_bf16(h0[0], h0[1]); wv[bj].y = cvt_pk_bf16(h0[2], h0[3]); wv[bj].z = cvt_pk_bf16(h1[0], h1[1]); wv[bj].w = cvt_pk_bf16(h1[2], h1[3]);
            }
            if (gi + DEPTH < 8) ld(hv[cb], (size_t)(row0 + ((gi + DEPTH) >> 2) * HALF + ((gi + DEPTH) & 3) * 16) * DM + cl);
            *(u32x4*)(hb + off) = wv[0]; *(u32x4*)(hb + off + HALF) = wv[1];
            ss += __shfl_xor(ss, 16); ss += __shfl_xor(ss, 32);
            if (rowss_out && fq == 0) unsafeAtomicAdd(rowss_out + row, ss);
        }
    }
};

struct EpiNull {
    __device__ __forceinline__ void operator()(const f32x4 (&acc)[2][2][4][2], const Unit& u, int wr, int wc, int fr, int fq) const {
#pragma unroll
        for (int ai = 0; ai < 2; ++ai)
#pragma unroll
            for (int bj = 0; bj < 2; ++bj)
#pragma unroll
                for (int m = 0; m < 4; ++m) asm volatile("" :: "v"(acc[ai][bj][m][0]), "v"(acc[ai][bj][m][1]));
    }
};

template <class Epi, bool ALIGN_EPI = true, int AUX_A = 0>
__device__ __forceinline__ void gemm_phase(LAS unsigned char* lds, const Gemm g, const StaticOrder& S, const Epi& E) {
    int tid_l = threadIdx.x; asm volatile("" : "+v"(tid_l));
    const int tid = tid_l, wid = __builtin_amdgcn_readfirstlane(tid >> 6), lane = tid & 63, wr = wid >> 2, wc = wid & 3, fr = lane & 15, fq = lane >> 4;
    const int K = g.K, nt = K / BK;
    unsigned voffA[2], voffB[2];
#pragma unroll
    for (int i = 0; i < 2; ++i) { int R, C; stage_rc(tid * 16 + i * 8192, R, C); const int Rb = (R & ~31) + perm32(R & 31);
        voffA[i] = (unsigned)(R * g.lda + C) * 2u; voffB[i] = (unsigned)(Rb * g.ldb + C) * 2u; }
    const size_t kstep = (size_t)(BK * 2);
    const size_t hstepA = (size_t)HALF * g.lda * 2, hstepB = (size_t)HALF * g.ldb * 2;
    const size_t tstepA = 2 * hstepA, tstepB = 2 * hstepB;
    const unsigned ldsw = (unsigned)wid * 1024u;
    const int aoff = lds_byte(wr * 64 + fr, fq * 8), boff = lds_byte(wc * 32 + fr, fq * 8);
#define PG8_SA(b, h) (((b) * 2 + (h)) * HTB)
#define PG8_SB(b, h) ((4 + (b) * 2 + (h)) * HTB)
#define PG8_STAGE_X(bufoff, gbase, voff, aux) do { _Pragma("unroll") for (int _i = 0; _i < 2; ++_i) \
        __builtin_amdgcn_global_load_lds((const unsigned*)((const char*)(gbase) + (voff)[_i]), (LAS unsigned*)(lds + (bufoff) + ldsw + _i * 8192), 16, 0, aux); } while (0)
#define PG8_STAGE(bufoff, gbase, voff) PG8_STAGE_X(bufoff, gbase, voff, 0)
#define PG8_LDA(dst, b, h) do { _Pragma("unroll") for (int m = 0; m < 4; ++m) _Pragma("unroll") for (int k = 0; k < 2; ++k) dst[m][k] = *(const LAS bf16x8*)(lds + PG8_SA(b, h) + aoff + m * 2048 + k * 1024); } while (0)
#define PG8_LDB(dst, b, h) do { _Pragma("unroll") for (int n = 0; n < 2; ++n) _Pragma("unroll") for (int k = 0; k < 2; ++k) dst[n][k] = *(const LAS bf16x8*)(lds + PG8_SB(b, h) + boff + n * 2048 + k * 1024); } while (0)
#define PG8_MMA(ai, bj, At, Bt) do { __builtin_amdgcn_s_setprio(1); _Pragma("unroll") for (int m = 0; m < 4; ++m) _Pragma("unroll") for (int n = 0; n < 2; ++n) _Pragma("unroll") for (int k = 0; k < 2; ++k) \
        acc[ai][bj][m][n] = __builtin_amdgcn_mfma_f32_16x16x32_bf16(Bt[n][k], At[m][k], acc[ai][bj][m][n], 0, 0, 0); __builtin_amdgcn_s_setprio(0); } while (0)
#define PG8_WAIT_V(n) asm volatile("s_waitcnt vmcnt(" #n ")" ::: "memory")
#define PG8_WAIT_L(n) asm volatile("s_waitcnt lgkmcnt(" #n ")" ::: "memory")
#define PG8_BAR __builtin_amdgcn_s_barrier()
#define PG8_SCHED __builtin_amdgcn_sched_barrier(0)
    Unit cur, nxt; int ui = 0;
    if (!S.next(0, cur)) return;
    f32x4 acc[2][2][4][2];
#pragma unroll
    for (int a = 0; a < 2; ++a)
#pragma unroll
        for (int b = 0; b < 2; ++b)
#pragma unroll
            for (int m = 0; m < 4; ++m)
#pragma unroll
                for (int n = 0; n < 2; ++n) acc[a][b][m][n] = (f32x4){0.f, 0.f, 0.f, 0.f};
    bf16x8 At[4][2], B0[2][2], B1[2][2];
    const char* cA = (const char*)g.A + (size_t)cur.pm * tstepA + (size_t)cur.pn * g.a_pn_step; const char* cB = (const char*)g.Bt + (size_t)cur.pn * tstepB;
    PG8_STAGE(PG8_SB(0, 0), cB, voffB); PG8_STAGE(PG8_SB(0, 1), cB + hstepB, voffB); PG8_STAGE_X(PG8_SA(0, 0), cA, voffA, AUX_A); PG8_STAGE_X(PG8_SA(0, 1), cA + hstepA, voffA, AUX_A);
    if (wr == 1) PG8_BAR;
    PG8_WAIT_V(2); PG8_BAR;
    PG8_STAGE(PG8_SB(1, 0), cB + kstep, voffB); PG8_STAGE_X(PG8_SA(1, 0), cA + kstep, voffA, AUX_A); PG8_STAGE(PG8_SB(1, 1), cB + hstepB + kstep, voffB);
    PG8_WAIT_V(6); PG8_BAR;
    for (;;) {
        const bool has_next = S.next(ui + 1, nxt);
        const char* nA = has_next ? (const char*)g.A + (size_t)nxt.pm * tstepA + (size_t)nxt.pn * g.a_pn_step : cA; const char* nB = has_next ? (const char*)g.Bt + (size_t)nxt.pn * tstepB : cB;
        for (int t = 0; t < nt; t += 2) {
            const bool last = (t == nt - 2);
            const char* a1 = cA + (size_t)(t + 1) * kstep;
            const char* a2 = last ? nA : cA + (size_t)(t + 2) * kstep; const char* b2 = last ? nB : cB + (size_t)(t + 2) * kstep;
            const char* a3 = a2 + kstep; const char* b3 = b2 + kstep;
            PG8_LDB(B0, 0, 0); PG8_LDB(B1, 0, 1); PG8_SCHED; PG8_LDA(At, 0, 0); PG8_STAGE_X(PG8_SA(1, 1), a1 + hstepA, voffA, AUX_A);
            PG8_WAIT_V(8); PG8_WAIT_L(0); PG8_BAR; PG8_MMA(0, 0, At, B0); PG8_MMA(0, 1, At, B1); PG8_BAR; PG8_SCHED;
            PG8_LDA(At, 0, 1); PG8_STAGE(PG8_SB(0, 0), b2, voffB); PG8_STAGE(PG8_SB(0, 1), b2 + hstepB, voffB); PG8_STAGE_X(PG8_SA(0, 0), a2, voffA, AUX_A);
            PG8_WAIT_V(8); PG8_WAIT_L(0); PG8_BAR; PG8_MMA(1, 0, At, B0); PG8_MMA(1, 1, At, B1); PG8_BAR; PG8_SCHED;
            PG8_LDB(B0, 1, 0); PG8_LDB(B1, 1, 1); PG8_SCHED; PG8_LDA(At, 1, 0); PG8_STAGE_X(PG8_SA(0, 1), a2 + hstepA, voffA, AUX_A);
            PG8_WAIT_V(8); PG8_WAIT_L(0); PG8_BAR; PG8_MMA(0, 0, At, B0); PG8_MMA(0, 1, At, B1); PG8_BAR; PG8_SCHED;
            PG8_LDA(At, 1, 1); PG8_STAGE(PG8_SB(1, 0), b3, voffB); PG8_STAGE(PG8_SB(1, 1), b3 + hstepB, voffB); PG8_STAGE_X(PG8_SA(1, 0), a3, voffA, AUX_A);
            PG8_WAIT_V(8); PG8_WAIT_L(0); PG8_BAR; PG8_MMA(1, 0, At, B0); PG8_MMA(1, 1, At, B1); PG8_BAR; PG8_SCHED;
        }
        if constexpr (ALIGN_EPI) { if (wr == 0) PG8_BAR; }
        E(acc, cur, wr, wc, fr, fq);
        if (!has_next) break;
#pragma unroll
        for (int a = 0; a < 2; ++a)
#pragma unroll
            for (int b = 0; b < 2; ++b)
#pragma unroll
                for (int m = 0; m < 4; ++m)
#pragma unroll
                    for (int n = 0; n < 2; ++n) acc[a][b][m][n] = (f32x4){0.f, 0.f, 0.f, 0.f};
        cur = nxt; cA = nA; cB = nB; ++ui;
        if constexpr (ALIGN_EPI) { if (wr == 1) PG8_BAR; }
    }
    PG8_WAIT_V(0);
    if constexpr (!ALIGN_EPI) { if (wr == 0) PG8_BAR; }
    PG8_BAR;
#undef PG8_SA
#undef PG8_SB
#undef PG8_STAGE
#undef PG8_STAGE_X
#undef PG8_LDA
#undef PG8_LDB
#undef PG8_MMA
#undef PG8_WAIT_V
#undef PG8_WAIT_L
#undef PG8_BAR
#undef PG8_SCHED
}
}

template <int DH, bool BIAS, int NT, bool PF, bool COAL = false>
__device__ __forceinline__ void attn_wave32(const bf16_t* __restrict__ Qp, int ldq, const bf16_t* __restrict__ Kp, int ldk, const bf16_t* __restrict__ Vp, int ldv,
                                            bf16_t* __restrict__ Op, int ldo, int ntiles, float sc, const LAS float* tab, int rel_base, int lane) {
    constexpr int KS = DH / 32, DT = DH / 16;
    asm volatile("" : "+v"(lane));
    const int fr = lane & 15, fq = lane >> 4;
    bf16x8 qf[NT][KS];
#pragma unroll
    for (int nt = 0; nt < NT; ++nt)
#pragma unroll
        for (int ks = 0; ks < KS; ++ks) qf[nt][ks] = *(const bf16x8*)(Qp + (size_t)(nt * 16 + fr) * ldq + ks * 32 + fq * 8);
    f32x4 o[DT][NT];
#pragma unroll
    for (int dt = 0; dt < DT; ++dt)
#pragma unroll
        for (int nt = 0; nt < NT; ++nt) o[dt][nt] = (f32x4){0.f, 0.f, 0.f, 0.f};
    float mrun[NT], lrun[NT];
#pragma unroll
    for (int nt = 0; nt < NT; ++nt) { mrun[nt] = -1e30f; lrun[nt] = 0.f; }
    const bf16_t* kbase = Kp + (size_t)(8 * (fr >> 2) + (fr & 3)) * ldk + fq * 8;
    const bf16_t* vbase = Vp + (size_t)fr * ldv + fq * 8;
    bf16x8 kf[4][KS], vfA[DT][2], vfB[DT][2];
#define ATT_LOADK(tt) do { _Pragma("unroll") for (int mt = 0; mt < 4; ++mt) _Pragma("unroll") for (int ks = 0; ks < KS; ++ks) \
        kf[mt][ks] = COAL ? *(const bf16x8*)(Kp + (size_t)(tt) * (64 * DH) + (mt * KS + ks) * 512 + lane * 8) \
                          : *(const bf16x8*)(kbase + (size_t)((tt) * 64 + (mt >> 1) * 32 + 4 * (mt & 1)) * ldk + ks * 32); } while (0)
#define ATT_LOADV(dst, tt) do { _Pragma("unroll") for (int dt = 0; dt < DT; ++dt) _Pragma("unroll") for (int kb = 0; kb < 2; ++kb) \
        dst[dt][kb] = COAL ? *(const bf16x8*)(Vp + (size_t)(tt) * (64 * DH) + (dt * 2 + kb) * 512 + lane * 8) \
                           : *(const bf16x8*)(vbase + (size_t)(dt * 16) * ldv + (tt) * 64 + kb * 32); } while (0)
#define ATT_BODY(t, vcur, vnext) do { \
        const int tn_ = ((t) + 1 < ntiles) ? (t) + 1 : (t); \
        if (PF) ATT_LOADV(vnext, tn_); else ATT_LOADK(t); \
        f32x4 s[4][NT]; \
        _Pragma("unroll") for (int mt = 0; mt < 4; ++mt) _Pragma("unroll") for (int nt = 0; nt < NT; ++nt) { s[mt][nt] = (f32x4){0.f, 0.f, 0.f, 0.f}; \
            _Pragma("unroll") for (int ks = 0; ks < KS; ++ks) s[mt][nt] = __builtin_amdgcn_mfma_f32_16x16x32_bf16(kf[mt][ks], qf[nt][ks], s[mt][nt], 0, 0, 0); } \
        if (PF) ATT_LOADK(tn_); \
        bf16x8 pf[NT][2]; \
          \
        const LAS float* tb_ = tab + (rel_base - 64 * (t) + fr - 8 * fq + 63 - 39); \
        _Pragma("unroll") for (int nt = 0; nt < NT; ++nt) { \
            float mloc = -1e30f; \
            _Pragma("unroll") for (int mt = 0; mt < 4; ++mt) _Pragma("unroll") for (int j = 0; j < 4; ++j) { \
                float v = s[mt][nt][j] * sc; \
                if (BIAS) v += tb_[39 + nt * 16 - ((mt >> 1) * 32 + 4 * (mt & 1) + j)]; \
                s[mt][nt][j] = v; mloc = fmaxf(mloc, v); } \
            mloc = fmaxf(mloc, __shfl_xor(mloc, 16)); mloc = fmaxf(mloc, __shfl_xor(mloc, 32)); \
            const float mnew = fmaxf(mrun[nt], mloc), alpha = __builtin_amdgcn_exp2f(mrun[nt] - mnew); \
            mrun[nt] = mnew; \
            float ls = 0.f; \
            _Pragma("unroll") for (int mt = 0; mt < 4; ++mt) _Pragma("unroll") for (int j = 0; j < 4; ++j) { const float p = __builtin_amdgcn_exp2f(s[mt][nt][j] - mnew); s[mt][nt][j] = p; ls += p; } \
            lrun[nt] = lrun[nt] * alpha + ls; \
            _Pragma("unroll") for (int dt = 0; dt < DT; ++dt) o[dt][nt] = o[dt][nt] * alpha; \
            _Pragma("unroll") for (int kb = 0; kb < 2; ++kb) { \
                u32x4 w; w.x = cvt_pk_bf16(s[2 * kb][nt][0], s[2 * kb][nt][1]); w.y = cvt_pk_bf16(s[2 * kb][nt][2], s[2 * kb][nt][3]); \
                w.z = cvt_pk_bf16(s[2 * kb + 1][nt][0], s[2 * kb + 1][nt][1]); w.w = cvt_pk_bf16(s[2 * kb + 1][nt][2], s[2 * kb + 1][nt][3]); \
                pf[nt][kb] = __builtin_bit_cast(bf16x8, w); } } \
        if (!PF) { asm volatile("" ::: "memory"); ATT_LOADV(vcur, t); } \
        _Pragma("unroll") for (int dt = 0; dt < DT; ++dt) _Pragma("unroll") for (int nt = 0; nt < NT; ++nt) _Pragma("unroll") for (int kb = 0; kb < 2; ++kb) \
            o[dt][nt] = __builtin_amdgcn_mfma_f32_16x16x32_bf16(vcur[dt][kb], pf[nt][kb], o[dt][nt], 0, 0, 0); \
    } while (0)
    if (PF) { ATT_LOADK(0); ATT_LOADV(vfA, 0);
#pragma nounroll
        for (int t = 0; t < ntiles; t += 2) {
            ATT_BODY(t, vfA, vfB);
            if (t + 1 < ntiles) ATT_BODY(t + 1, vfB, vfA);
        }
    } else {
#pragma nounroll
        for (int t = 0; t < ntiles; ++t) ATT_BODY(t, vfA, vfB);
    }
#undef ATT_BODY
#undef ATT_LOADK
#undef ATT_LOADV
#pragma unroll
    for (int nt = 0; nt < NT; ++nt) {
        float l = lrun[nt]; l += __shfl_xor(l, 16); l += __shfl_xor(l, 32);
        const float inv = 1.0f / l;
#pragma unroll
        for (int dt = 0; dt < DT; ++dt) {
            const f32x4 v = o[dt][nt] * inv; u32x2 w; w.x = cvt_pk_bf16(v[0], v[1]); w.y = cvt_pk_bf16(v[2], v[3]);
            *(u32x2*)(Op + (size_t)(nt * 16 + fr) * ldo + dt * 16 + 4 * fq) = w;
        }
    }
}

#define XB_TMO      128
#define XB_XCNT(j)  (256  + 64 * (j))
#define XB_XSUB(j)  (1280 + 64 * (j))
#define XB_XGEN(j)  (2304 + 64 * (j))
#define XB_TOP      3328
#define XB_TOPGEN   3392
#define XCD_BAR_WORDS 3456
#define XB_SPIN_CAP (1u << 22)
__device__ __forceinline__ unsigned xb_ld(unsigned* p)              { return __hip_atomic_load(p, __ATOMIC_RELAXED, __HIP_MEMORY_SCOPE_AGENT); }
__device__ __forceinline__ unsigned xb_add(unsigned* p, unsigned v) { return __hip_atomic_fetch_add(p, v, __ATOMIC_RELAXED, __HIP_MEMORY_SCOPE_AGENT); }
__device__ __forceinline__ unsigned xb_xcc_id() { return (unsigned)__builtin_amdgcn_s_getreg((3 << 11) | 20) & 0xFu; }
#define XB_SPIN(cond, bar) do { unsigned _sp = 0; while (cond) { __builtin_amdgcn_s_sleep(1); \
    if ((++_sp & 255u) == 0u) { if (xb_ld(&(bar)[XB_TMO])) break; if (_sp > XB_SPIN_CAP) { atomicAdd(&(bar)[XB_TMO], 1u); break; } } } } while (0)
struct XcdBarrier { unsigned* bar; unsigned x; volatile LAS unsigned* st; };
__device__ __forceinline__ XcdBarrier xcd_barrier_post(unsigned* bar, volatile LAS unsigned* st) {
    XcdBarrier b; b.bar = bar; b.x = xb_xcc_id(); b.st = st;
    if (threadIdx.x == 0) (void)xb_add(&bar[XB_XCNT(b.x)], 1u);
    return b;
}
__device__ __forceinline__ void xcd_barrier_complete(unsigned* bar, unsigned x, unsigned& nloc, unsigned& nx) {
    const unsigned G = gridDim.x * gridDim.y * gridDim.z;
    unsigned sum, cnt, mine, sp = 0u;
    for (;;) {
        sum = 0u; cnt = 0u; mine = 0u;
#pragma unroll
        for (unsigned j = 0; j < 16; ++j) { const unsigned c = xb_ld(&bar[XB_XCNT(j)]); sum += c; cnt += (c > 0u) ? 1u : 0u; mine = (j == x) ? c : mine; }
        if (sum == G) break;
        __builtin_amdgcn_s_sleep(1);
        if ((++sp & 255u) == 0u) { if (xb_ld(&bar[XB_TMO])) break; if (sp > XB_SPIN_CAP) { atomicAdd(&bar[XB_TMO], 1u); break; } }
    }
    nloc = mine > 0u ? mine : 1u; nx = cnt > 0u ? cnt : 1u;
}
__device__ __forceinline__ void xcd_barrier(const XcdBarrier& b) {
    asm volatile("s_waitcnt vmcnt(0)" ::: "memory");
    __syncthreads();
    if (threadIdx.x == 0) {
        unsigned* bar = b.bar;
        __builtin_amdgcn_s_waitcnt(0);
        unsigned nloc = b.st[0], nx = b.st[1];
        if (nloc == 0u) { xcd_barrier_complete(bar, b.x, nloc, nx); b.st[0] = nloc; b.st[1] = nx; }
        const unsigned old = xb_add(&bar[XB_XSUB(b.x)], 1u);
        const unsigned gen = old / nloc;
        if (old + 1u == (gen + 1u) * nloc) {
            __builtin_amdgcn_fence(__ATOMIC_RELEASE, "agent");
            asm volatile("s_waitcnt vmcnt(0)" ::: "memory");
            const unsigned og = xb_add(&bar[XB_TOP], 1u);
            const unsigned tg = og / nx;
            if (og + 1u == (tg + 1u) * nx) xb_add(&bar[XB_TOPGEN], 1u);
            else XB_SPIN(xb_ld(&bar[XB_TOPGEN]) == tg, bar);
            __builtin_amdgcn_fence(__ATOMIC_ACQUIRE, "agent");
            xb_add(&bar[XB_XGEN(b.x)], 1u);
            asm volatile("s_waitcnt vmcnt(0)" ::: "memory");
        } else {
            XB_SPIN(xb_ld(&bar[XB_XGEN(b.x)]) == gen, bar);
            __builtin_amdgcn_fence(__ATOMIC_ACQUIRE, "agent");
            asm volatile("s_waitcnt vmcnt(0)" ::: "memory");
        }
    }
    __syncthreads();
}

struct Params {
    const float* x; const float* mem;
    const float* ffn1_norm; const float* ffn1_wg; const float* ffn1_wu; const float* ffn1_wd;
    const float* mix_norm; const float* w_in; const float* rel_bias; const float* w_pool; const float* pool_scale; const float* w_out;
    const float* cross_norm; const float* mem_norm; const float* w_cq; const float* w_ckv; const float* w_co;
    const float* ffn2_norm; const float* ffn2_wg; const float* ffn2_wu; const float* ffn2_wd; const float* final_norm;
    float* out; unsigned char* ws;
};

__device__ __forceinline__ void p0_transpose_item(const float* __restrict__ W, int K, int N, bf16_t* __restrict__ WT, int mode, int row_off, const float* __restrict__ gain, LAS float* scr, int item, int lane) {
    const int nblk = N / 32, kb = item / nblk, nb = item - kb * nblk, k0 = 64 * kb, n0 = 32 * nb;
#pragma unroll 8
    for (int i = 0; i < 32; ++i) { const int kk = 2 * i + (lane >> 5); const float gk = gain ? gain[k0 + kk] : 1.0f; scr[kk * 33 + (lane & 31)] = W[(size_t)(k0 + kk) * N + n0 + (lane & 31)] * gk; }
    asm volatile("s_waitcnt lgkmcnt(0)" ::: "memory");
    const int c = lane & 7;
    const int d0 = (mode == 0) ? (row_off + n0) : ((n0 >> 7) * 256 + (n0 & 127) + (mode == 2 ? 128 : 0));
#pragma unroll
    for (int j = 0; j < 4; ++j) { const int n = (lane >> 3) + 8 * j; const LAS float* s = scr + (8 * c) * 33 + n;
        u32x4 o; o.x = cvt_pk_bf16(s[0 * 33], s[1 * 33]); o.y = cvt_pk_bf16(s[2 * 33], s[3 * 33]); o.z = cvt_pk_bf16(s[4 * 33], s[5 * 33]); o.w = cvt_pk_bf16(s[6 * 33], s[7 * 33]);
        *(u32x4*)(WT + (size_t)(d0 + n) * K + k0 + 8 * c) = o; }
    asm volatile("s_waitcnt lgkmcnt(0)" ::: "memory");
}

#define rowss ((float*)(P.ws + WS_ROWSS))
#define Wgu1 ((bf16_t*)(P.ws + WS_WGU1))
#define Wd1 ((bf16_t*)(P.ws + WS_WD1))
#define Win ((bf16_t*)(P.ws + WS_WIN))
#define Wp ((bf16_t*)(P.ws + WS_WP))
#define Wout ((bf16_t*)(P.ws + WS_WOUT))
#define Wcq ((bf16_t*)(P.ws + WS_WCQ))
#define Wckv ((bf16_t*)(P.ws + WS_WCKV))
#define Wco ((bf16_t*)(P.ws + WS_WCO))
#define Wgu2 ((bf16_t*)(P.ws + WS_WGU2))
#define Wd2 ((bf16_t*)(P.ws + WS_WD2))
#define HB ((bf16_t*)(P.ws + WS_HB))
#define ACT ((bf16_t*)(P.ws + WS_ACT))
#define Z ((bf16_t*)(P.ws + WS_Z))
#define VT ((bf16_t*)(P.ws + WS_VT))
#define Y ((bf16_t*)(P.ws + WS_Y))
#define CQ ((bf16_t*)(P.ws + WS_CQ))
#define CO ((bf16_t*)(P.ws + WS_CO))
#define DP ((bf16_t*)(P.ws + WS_DP))
#define MEMN ((bf16_t*)(P.ws + WS_MEMN))
#define KC ((bf16_t*)(P.ws + WS_KC))
#define VCT ((bf16_t*)(P.ws + WS_VCT))
#define KF ((bf16_t*)(P.ws + WS_KF))
__global__ void __launch_bounds__(512, 2) fwd_megakernel(Params P) {
    extern __shared__ __attribute__((aligned(16))) unsigned char lds_raw[];
    cg::grid_group grid = cg::this_grid();
    LAS unsigned char* lds = (LAS unsigned char*)lds_raw;
    const int tid = threadIdx.x, lane = tid & 63, wave = __builtin_amdgcn_readfirstlane(tid >> 6);
    const int G = gridDim.x, bx = blockIdx.x;
    const int gw = bx * 8 + wave, NGW = G * 8;
    volatile LAS unsigned* bst = (volatile LAS unsigned*)(lds + 131072 + 64);
    if (tid < 2) bst[tid] = 0u;
    __syncthreads();
    const XcdBarrier xbar = xcd_barrier_post((unsigned*)(P.ws + WS_BAR), bst);
#ifndef WGM_RES
#define WGM_RES 8
#endif
#ifndef REV_DOWN
#define REV_DOWN 1
#endif
#define RUN_GEMM(EPI, gM, gN, gdesc, edesc) do { pg8::StaticOrder S_; S_.init((gM), (gN), G, bx, ((gN) == DM) ? WGM_RES : 8); pg8::gemm_phase<EPI>(lds, (gdesc), S_, (edesc)); } while (0)
#ifndef AUX_DOWN
#define AUX_DOWN 0
#endif
#define RUN_GEMM_NT(EPI, gM, gN, gdesc, edesc) do { pg8::StaticOrder S_; S_.init((gM), (gN), G, bx, ((gN) == DM) ? WGM_RES : 8, REV_DOWN); pg8::gemm_phase<EPI, true, AUX_DOWN>(lds, (gdesc), S_, (edesc)); } while (0)

    for (int rep_ = 0; rep_ < REP_P0; ++rep_) {
        LAS float* scr = (LAS float*)(lds + wave * 16384);
        constexpr int I_G = (DM / 64) * (DFF / 32), I_D = (DFF / 64) * (DM / 32), I_IN = (DM / 64) * (DIN / 32), I_P = (256 / 64) * (256 / 32), I_O = (DM / 64) * (DM / 32),
                      I_CQ = (DM / 64) * (DCROSS / 32), I_CKV = (DM / 64) * (2 * DCROSS / 32), I_CO = (DCROSS / 64) * (DM / 32);
        constexpr int NITEMS = 4 * I_G + 2 * I_D + I_IN + 4 * I_P + I_O + I_CQ + I_CKV + I_CO;
        for (int it = gw; it < NITEMS; it += NGW) {
            int r = it;
            if (r < I_G) { p0_transpose_item(P.ffn1_wg, DM, DFF, Wgu1, 1, 0, P.ffn1_norm, scr, r, lane); continue; } r -= I_G;
            if (r < I_G) { p0_transpose_item(P.ffn1_wu, DM, DFF, Wgu1, 2, 0, P.ffn1_norm, scr, r, lane); continue; } r -= I_G;
            if (r < I_D) { p0_transpose_item(P.ffn1_wd, DFF, DM, Wd1, 0, 0, nullptr, scr, r, lane); continue; } r -= I_D;
            if (r < I_G) { p0_transpose_item(P.ffn2_wg, DM, DFF, Wgu2, 1, 0, P.ffn2_norm, scr, r, lane); continue; } r -= I_G;
            if (r < I_G) { p0_transpose_item(P.ffn2_wu, DM, DFF, Wgu2, 2, 0, P.ffn2_norm, scr, r, lane); continue; } r -= I_G;
            if (r < I_D) { p0_transpose_item(P.ffn2_wd, DFF, DM, Wd2, 0, 0, nullptr, scr, r, lane); continue; } r -= I_D;
            if (r < I_IN) { p0_transpose_item(P.w_in, DM, DIN, Win, 0, 0, P.mix_norm, scr, r, lane); continue; } r -= I_IN;
            if (r < 4 * I_P) { const int gi = r / I_P; p0_transpose_item(P.w_pool + (size_t)gi * 65536, 256, 256, Wp, 0, gi * 256, nullptr, scr, r - gi * I_P, lane); continue; } r -= 4 * I_P;
            if (r < I_O) { p0_transpose_item(P.w_out, DM, DM, Wout, 0, 0, nullptr, scr, r, lane); continue; } r -= I_O;
            if (r < I_CQ) { p0_transpose_item(P.w_cq, DM, DCROSS, Wcq, 0, 0, P.cross_norm, scr, r, lane); continue; } r -= I_CQ;
            if (r < I_CKV) { p0_transpose_item(P.w_ckv, DM, 2 * DCROSS, Wckv, 0, 0, nullptr, scr, r, lane); continue; } r -= I_CKV;
            p0_transpose_item(P.w_co, DCROSS, DM, Wco, 0, 0, nullptr, scr, r, lane);
        }
        for (int i = bx * 512 + tid; i < 4 * MTOK; i += G * 512) rowss[MTOK + i] = 0.f;
        for (int m = gw; m < MTOK; m += NGW) {
            const f32x4* xr = (const f32x4*)(P.x + (size_t)m * DM) + lane; u32x2* o8 = (u32x2*)(HB + (size_t)m * DM) + lane; float s = 0.f;
#pragma unroll
            for (int j = 0; j < 8; ++j) { const f32x4 v = xr[64 * j]; s += (v[0] * v[0] + v[1] * v[1]) + (v[2] * v[2] + v[3] * v[3]); u32x2 w; w.x = cvt_pk_bf16(v[0], v[1]); w.y = cvt_pk_bf16(v[2], v[3]); o8[64 * j] = w; }
            s = wave_sum(s); if (lane == 0) rowss[m] = s;
        }
        for (int m = gw; m < BATCH * NMEM; m += NGW) {
            const f32x4* xr = (const f32x4*)(P.mem + (size_t)m * DM) + lane; const f32x4* gr = (const f32x4*)P.mem_norm + lane; u32x2* o8 = (u32x2*)(MEMN + (size_t)m * DM) + lane;
            f32x4 v[8]; float s = 0.f;
#pragma unroll
            for (int j = 0; j < 8; ++j) { v[j] = xr[64 * j]; s += (v[j][0] * v[j][0] + v[j][1] * v[j][1]) + (v[j][2] * v[j][2] + v[j][3] * v[j][3]); }
            const float rs = __builtin_amdgcn_rsqf(wave_sum(s) * (1.0f / DM) + EPS);
#pragma unroll
            for (int j = 0; j < 8; ++j) { const f32x4 gg = gr[64 * j]; const f32x4 y = v[j] * rs * gg; u32x2 w; w.x = cvt_pk_bf16(y[0], y[1]); w.y = cvt_pk_bf16(y[2], y[3]); o8[64 * j] = w; }
        }
    }
    grid.sync();
    for (int rep_ = 0; rep_ < REP_G1; ++rep_)
    RUN_GEMM(pg8::EpiSwiglu, MTOK, 2 * DFF, (pg8::Gemm{HB, Wgu1, DM, DM, DM, 0}), (pg8::EpiSwiglu{ACT, DFF, rowss}));
    for (int rep_ = 0; rep_ < REP_G1NULL; ++rep_)
    RUN_GEMM(pg8::EpiNull, MTOK, 2 * DFF, (pg8::Gemm{HB, Wgu1, DM, DM, DM, 0}), (pg8::EpiNull{}));
    for (int rep_ = 0; rep_ < REP_SYNC; ++rep_) grid.sync();
    RUN_GEMM(pg8::EpiBf<false>, BATCH * NMEM, 2 * DCROSS, (pg8::Gemm{MEMN, Wckv, DM, DM, DM, 0}), (pg8::EpiBf<false>{KC, DCROSS, 0, nullptr, nullptr, 2, 4, NMEM, DCROSS, VCT, 0, 0, nullptr}));
    xcd_barrier(xbar);
    for (int rep_ = 0; rep_ < REP_G2NULL; ++rep_)
    RUN_GEMM(pg8::EpiNull, MTOK, DM, (pg8::Gemm{ACT, Wd1, DFF, DFF, DFF, 0}), (pg8::EpiNull{}));
    for (int rep_ = 0; rep_ < REP_G2; ++rep_)
    RUN_GEMM(pg8::EpiRes<true>, MTOK, DM, (pg8::Gemm{ACT, Wd1, DFF, DFF, DFF, 0}), (pg8::EpiRes<true>{P.x, HB, nullptr, 0.5f}));
    RUN_GEMM_NT(pg8::EpiRes<true>, MTOK, DM, (pg8::Gemm{ACT, Wd1, DFF, DFF, DFF, 0}), (pg8::EpiRes<true>{P.x, HB, rowss + 1 * MTOK, 0.5f}));
    xcd_barrier(xbar);
    for (int rep_ = 0; rep_ < REP_G3; ++rep_)
    RUN_GEMM(pg8::EpiBf<true>, MTOK, DIN, (pg8::Gemm{HB, Win, DM, DM, DM, 0}), (pg8::EpiBf<true>{Z, DIN, 0, rowss + 1 * MTOK, nullptr, 8, 12, SEQ, DATT, VT, 4, 8, KF}));
    xcd_barrier(xbar);
    for (int rep_ = 0; rep_ < REP_ATT; ++rep_) {
        for (int task = gw; task < (MTOK / 64) * 4; task += NGW) {
            const int gi = task & 3, rt = task >> 2, sub = lane >> 5, cgi = lane & 31, w = 2 << gi;
            const int t0 = rt * 64 + sub * 32, tpos = t0 & (SEQ - 1);
            const bf16_t* up = Z + (size_t)t0 * DIN + 3 * DATT + gi * 256 + cgi * 8;
            bf16_t* dp = DP + (size_t)t0 * DPOOL + gi * 256 + cgi * 8;
            float sum[8];
#pragma unroll
            for (int e = 0; e < 8; ++e) sum[e] = 0.f;
            for (int i = 1; i < w; ++i) if (tpos - i >= 0) { const u32x4 v = *(const u32x4*)(up - (size_t)i * DIN);
                sum[0] += bf_lo(v.x); sum[1] += bf_hi(v.x); sum[2] += bf_lo(v.y); sum[3] += bf_hi(v.y); sum[4] += bf_lo(v.z); sum[5] += bf_hi(v.z); sum[6] += bf_lo(v.w); sum[7] += bf_hi(v.w); }
#pragma nounroll
            for (int r0 = 0; r0 < 32; r0 += 8) {
                u32x4 cv[8], ov[8];
#pragma unroll
                for (int j = 0; j < 8; ++j) cv[j] = *(const u32x4*)(up + (size_t)(r0 + j) * DIN);
#pragma unroll
                for (int j = 0; j < 8; ++j) { const int rr = r0 + j - w + 1; ov[j] = (tpos + rr >= 0) ? *(const u32x4*)(up + (ptrdiff_t)rr * DIN) : (u32x4){0u, 0u, 0u, 0u}; }
#pragma unroll
                for (int j = 0; j < 8; ++j) {
                    const u32x4 v = cv[j], q = ov[j];
                    const float cur[8] = {bf_lo(v.x), bf_hi(v.x), bf_lo(v.y), bf_hi(v.y), bf_lo(v.z), bf_hi(v.z), bf_lo(v.w), bf_hi(v.w)};
                    const float old[8] = {bf_lo(q.x), bf_hi(q.x), bf_lo(q.y), bf_hi(q.y), bf_lo(q.z), bf_hi(q.z), bf_lo(q.w), bf_hi(q.w)};
                    const int have = tpos + r0 + j + 1; const float inv = 1.0f / (float)(have < w ? have : w);
                    float d[8];
#pragma unroll
                    for (int e = 0; e < 8; ++e) { sum[e] += cur[e]; d[e] = sum[e] * inv - cur[e]; sum[e] -= old[e]; }
                    u32x4 o; o.x = cvt_pk_bf16(d[0], d[1]); o.y = cvt_pk_bf16(d[2], d[3]); o.z = cvt_pk_bf16(d[4], d[5]); o.w = cvt_pk_bf16(d[6], d[7]);
                    *(u32x4*)(dp + (size_t)(r0 + j) * DPOOL) = o;
                }
            }
        }
        LAS float* tab = (LAS float*)lds;
        for (int bh = bx; bh < BATCH * 16; bh += G) {
            const int b = bh >> 4, h = bh & 15;
            __syncthreads();
            for (int i = tid; i < 704; i += 512) { int rel = i - 63; rel = rel < -128 ? -128 : (rel > 128 ? 128 : rel); tab[i] = P.rel_bias[h * NREL + rel + 128] * LOG2E; }
            __syncthreads();
#pragma nounroll
            for (int i = 0; i < 8; ++i) {
                const int c = i * 4 + (wave >> 1), half = wave & 1, j0 = c < 8 ? 8 - c : 0, kstart = (c - 8 + j0) * 64;
                const size_t qrow = (size_t)b * SEQ + c * 64 + half * 32;
#ifndef NO_ATT5
                attn_wave32<64, true, 2, true, true>(Z + qrow * DIN + h * 64, DIN, KF + ((size_t)(b * 16 + h) * SEQ + kstart) * 64, 0,
                                      VT + ((size_t)(b * 16 + h) * SEQ + kstart) * 64, 0, Y + qrow * DM + h * 64, DM, 9 - j0, 0.125f * LOG2E, tab, half * 32 + (8 - j0) * 64, lane);
#endif
            }
        }
        __syncthreads();
    }
    xcd_barrier(xbar);
    RUN_GEMM(pg8::EpiBf<false>, MTOK, DPOOL, (pg8::Gemm{DP, Wp, DPOOL, 256, 256, 512}), (pg8::EpiBf<false>{Y, DM, DATT, nullptr, P.pool_scale, 0, 0, 1, 1, nullptr, 0, 0, nullptr}));
    xcd_barrier(xbar);
    RUN_GEMM(pg8::EpiRes<false>, MTOK, DM, (pg8::Gemm{Y, Wout, DM, DM, DM, 0}), (pg8::EpiRes<false>{nullptr, HB, rowss + 2 * MTOK, 1.0f}));
    xcd_barrier(xbar);
    RUN_GEMM(pg8::EpiBf<false>, MTOK, DCROSS, (pg8::Gemm{HB, Wcq, DM, DM, DM, 0}), (pg8::EpiBf<false>{CQ, DCROSS, 0, rowss + 2 * MTOK, nullptr, 0, 0, 1, 1, nullptr, 0, 0, nullptr}));
    xcd_barrier(xbar);
    {
        for (int it = bx; it < BATCH * 16; it += G) {
            const int b = it >> 4, sub = it & 15;
#pragma nounroll
            for (int r = 0; r < 4; ++r) {
                const int wu = r * 8 + wave, head = wu & 3, qblk = wu >> 2;
                const size_t qrow = (size_t)b * SEQ + sub * 128 + qblk * 16;
#ifndef NO_ATT9
                attn_wave32<128, false, 1, false>(CQ + qrow * DCROSS + head * 128, DCROSS, KC + (size_t)b * NMEM * DCROSS + head * 128, DCROSS,
                                        VCT + ((size_t)b * DCROSS + head * 128) * NMEM, NMEM, CO + qrow * DCROSS + head * 128, DCROSS, 4, 0.08838834764831845f * LOG2E, nullptr, 0, lane);
#endif
            }
        }
    }
    xcd_barrier(xbar);
    RUN_GEMM(pg8::EpiRes<false>, MTOK, DM, (pg8::Gemm{CO, Wco, DCROSS, DCROSS, DCROSS, 0}), (pg8::EpiRes<false>{nullptr, HB, rowss + 3 * MTOK, 1.0f}));
    xcd_barrier(xbar);
    RUN_GEMM(pg8::EpiSwiglu, MTOK, 2 * DFF, (pg8::Gemm{HB, Wgu2, DM, DM, DM, 0}), (pg8::EpiSwiglu{ACT, DFF, rowss + 3 * MTOK}));
    xcd_barrier(xbar);
    RUN_GEMM_NT(pg8::EpiRes<false>, MTOK, DM, (pg8::Gemm{ACT, Wd2, DFF, DFF, DFF, 0}), (pg8::EpiRes<false>{nullptr, HB, rowss + 4 * MTOK, 0.5f}));
    xcd_barrier(xbar);
    {
        const float* rs4 = rowss + 4 * MTOK;
        for (int m = gw; m < MTOK; m += NGW) {
            const u32x2* hr = (const u32x2*)(HB + (size_t)m * DM) + lane; f32x4* xr = (f32x4*)(P.out + (size_t)m * DM) + lane; const f32x4* gr = (const f32x4*)P.final_norm + lane;
            const float rs = __builtin_amdgcn_rsqf(rs4[m] * (1.0f / DM) + EPS);
#pragma unroll
            for (int j = 0; j < 8; ++j) { const u32x2 q = hr[64 * j]; const f32x4 v = (f32x4){bf_lo(q.x), bf_hi(q.x), bf_lo(q.y), bf_hi(q.y)}; xr[64 * j] = v * rs * gr[64 * j]; }
        }
    }
#undef RUN_GEMM
#undef RUN_GEMM_NT
}

extern "C" void kernel_launch(void* const* d_in, const int* in_sizes, int n_in, void* d_out, int out_size, void* d_ws, size_t ws_size, hipStream_t stream) {
    static int grid_blocks = 0;
    if (grid_blocks == 0) {
        if (n_in != 22 || in_sizes[0] != MTOK * DM || out_size != MTOK * DM || ws_size < WS_END) {
            fprintf(stderr, "kernel_launch: unexpected shapes (n_in %d, in0 %d, out %d, ws %zu)\n", n_in, n_in > 0 ? in_sizes[0] : -1, out_size, ws_size); grid_blocks = -1; return; }
        int dev = 0, cus = 0, per_cu = 0;
        hipGetDevice(&dev);
        hipDeviceGetAttribute(&cus, hipDeviceAttributeMultiprocessorCount, dev);
        if (hipFuncSetAttribute((const void*)fwd_megakernel, hipFuncAttributeMaxDynamicSharedMemorySize, LDS_BYTES) != hipSuccess) { fprintf(stderr, "kernel_launch: hipFuncSetAttribute failed\n"); grid_blocks = -1; return; }
        if (hipOccupancyMaxActiveBlocksPerMultiprocessor(&per_cu, (const void*)fwd_megakernel, 512, LDS_BYTES) != hipSuccess || per_cu < 1) { fprintf(stderr, "kernel_launch: occupancy query gave %d\n", per_cu); per_cu = 1; }
        (void)hipGetLastError();
        grid_blocks = cus * per_cu;
    }
    if (grid_blocks < 0) return;
    Params p{};
    const float* const* in = (const float* const*)d_in;
    p.x = in[0]; p.mem = in[1]; p.ffn1_norm = in[2]; p.ffn1_wg = in[3]; p.ffn1_wu = in[4]; p.ffn1_wd = in[5]; p.mix_norm = in[6]; p.w_in = in[7]; p.rel_bias = in[8];
    p.w_pool = in[9]; p.pool_scale = in[10]; p.w_out = in[11]; p.cross_norm = in[12]; p.mem_norm = in[13]; p.w_cq = in[14]; p.w_ckv = in[15]; p.w_co = in[16];
    p.ffn2_norm = in[17]; p.ffn2_wg = in[18]; p.ffn2_wu = in[19]; p.ffn2_wd = in[20]; p.final_norm = in[21];
    p.out = (float*)d_out; p.ws = (unsigned char*)d_ws;
    if (hipMemsetAsync((char*)d_ws + WS_BAR, 0, WS_BAR_BYTES, stream) != hipSuccess) { fprintf(stderr, "kernel_launch: memset of the barrier words failed\n"); return; }
    void* args[] = {&p};
    hipError_t e = hipLaunchCooperativeKernel((const void*)fwd_megakernel, dim3(grid_blocks), dim3(512), args, LDS_BYTES, stream);
    if (e != hipSuccess) fprintf(stderr, "cooperative launch failed: %s (grid %d)\n", hipGetErrorString(e), grid_blocks);
}
```

```cpp
#include <hip/hip_runtime.h>
#include <hip/hip_cooperative_groups.h>
#include <cstdio>
#include <cstdint>
namespace cg = cooperative_groups;

#define LAS __attribute__((address_space(3)))
typedef unsigned short bf16_t;
typedef short bf16x8 __attribute__((ext_vector_type(8)));
typedef float f32x4 __attribute__((ext_vector_type(4)));
typedef float f32x2 __attribute__((ext_vector_type(2)));
typedef unsigned u32x4 __attribute__((ext_vector_type(4)));
typedef unsigned u32x2 __attribute__((ext_vector_type(2)));

constexpr int BATCH = 16, SEQ = 2048, DM = 2048, MTOK = BATCH * SEQ;
constexpr int DFF = 5632, DIN = 4096, DATT = 1024, DPOOL = 1024, NMEM = 256, DCROSS = 512;
constexpr int NREL = 257;
constexpr float EPS = 1e-6f;
constexpr float LOG2E = 1.4426950408889634f;

constexpr size_t MiB = 1u << 20;
constexpr size_t WS_ROWSS = 0;
constexpr size_t WS_BAR = 896 * 1024, WS_BAR_BYTES = 16384;
constexpr size_t WS_WGU1 = 1 * MiB, WS_WD1 = 45 * MiB, WS_WIN = 67 * MiB, WS_WP = 83 * MiB, WS_WOUT = 84 * MiB, WS_WCQ = 92 * MiB,
                 WS_WCKV = 94 * MiB, WS_WCO = 98 * MiB, WS_WGU2 = 100 * MiB, WS_WD2 = 144 * MiB;
constexpr size_t WS_HB = 166 * MiB;
constexpr size_t WS_ACT = 294 * MiB;
constexpr size_t WS_Z = 294 * MiB;
constexpr size_t WS_VT = 550 * MiB;
constexpr size_t WS_Y = 646 * MiB;
constexpr size_t WS_CQ = 646 * MiB, WS_CO = 678 * MiB;
constexpr size_t WS_DP = 774 * MiB;
constexpr size_t WS_MEMN = 838 * MiB;
constexpr size_t WS_KC = 854 * MiB;
constexpr size_t WS_VCT = 858 * MiB;
constexpr size_t WS_KF = 862 * MiB;
constexpr size_t WS_END = 926 * MiB;

#ifndef REP_G1NULL
#define REP_G1NULL 0
#endif
#ifndef REP_SYNC
#define REP_SYNC 0
#endif
#ifndef REP_G2
#define REP_G2 0
#endif
#ifndef REP_G2NULL
#define REP_G2NULL 0
#endif
#ifndef REP_ATTC
#define REP_ATTC 0
#endif
#ifndef REP_XATT
#define REP_XATT 1
#endif
#ifndef REP_P0
#define REP_P0 1
#endif
#ifndef REP_G1
#define REP_G1 1
#endif
#ifndef REP_ATT
#define REP_ATT 1
#endif
#ifndef REP_G3
#define REP_G3 1
#endif
constexpr int LDS_BYTES = 147456;

__device__ __forceinline__ unsigned cvt_pk_bf16(float lo, float hi) { unsigned r; asm volatile("v_cvt_pk_bf16_f32 %0, %1, %2" : "=v"(r) : "v"(lo), "v"(hi)); return r; }
__device__ __forceinline__ float bf_lo(unsigned w) { return __uint_as_float(w << 16); }
__device__ __forceinline__ float bf_hi(unsigned w) { return __uint_as_float(w & 0xffff0000u); }
__device__ __forceinline__ float wave_sum(float v) {
#pragma unroll
    for (int o = 1; o < 64; o <<= 1) v += __shfl_xor(v, o);
    return v;
}

namespace pg8 {
constexpr int BM = 256, BK = 64, HALF = 128, HTB = HALF * BK * 2, STAGE_BYTES = 8 * HTB, NXCD = 8;
__host__ __device__ __forceinline__ int lds_byte(int r, int c) { const int st = (r >> 4) * 2 + (c >> 5), rr = r & 15, cc = c & 31, ob = rr * 64 + cc * 2; return st * 1024 + (ob ^ (((ob >> 9) & 1) << 5)); }
__host__ __device__ __forceinline__ void stage_rc(int b, int& R, int& C) { const int st = b / 1024, sb = b % 1024, swz = sb ^ (((sb >> 9) & 1) << 5); R = (st >> 1) * 16 + swz / 64; C = (st & 1) * 32 + (swz % 64) / 2; }
__host__ __device__ __forceinline__ int perm32(int rho) { const int n = rho >> 4, i = rho & 15; return 8 * (i >> 2) + 4 * n + (i & 3); }

struct Unit { int pm, pn; };
struct Gemm { const bf16_t* A; const bf16_t* Bt; int lda, ldb, K, a_pn_step; };

struct StaticOrder {
    int nM, nN, nwg, G, c, WGM, rev;
    __device__ void init(int M, int N, int G_, int c_, int wgm = 8, int rev_ = 0) { nM = M / BM; nN = N / BM; nwg = nM * nN; G = G_; c = c_; WGM = wgm; rev = rev_; }
    __device__ bool next(int i, Unit& u) const {
        const int nr = (nwg + G - 1) / G; if (i >= nr) return false;
        long L = (long)(rev ? nr - 1 - i : i) * G + c;
        if (L >= nwg) { if (!rev) return false; L = (long)(nr - 2 - i) * G + c; if (i + 1 >= nr) return false; }
        int wgid = (int)L; { const int q = nwg / NXCD, r = nwg % NXCD, xcd = wgid % NXCD, off = wgid / NXCD; wgid = (xcd < r ? xcd * (q + 1) : r * (q + 1) + (xcd - r) * q) + off; }
        const int nig = WGM * nN, gid = wgid / nig, fm = gid * WGM, gsz = (nM - fm) < WGM ? (nM - fm) : WGM;
        u.pm = fm + ((wgid % nig) % gsz); u.pn = (wgid % nig) / gsz; return true;
    }
};

template <int FMD> struct EpiBf {
    bf16_t* O; int ldc; int col_off; const float* rowss; const float* colscale; int t_lo, t_hi, t_rows, t_cols; bf16_t* VT; int k_lo, k_hi; bf16_t* KF;
    __device__ __forceinline__ void operator()(const f32x4 (&acc)[2][2][4][2], const Unit& u, int wr, int wc, int fr, int fq) const {
        const int row0 = u.pm * BM + wr * 64 + fr, cl = wc * 32 + 8 * fq;
        const bool tr = (u.pn >= t_lo) && (u.pn < t_hi);
        constexpr bool FM = FMD != 0;
        constexpr int FDH = FM ? FMD : 64, FKS = FDH / 32, FROWS = (FMD == 128) ? NMEM : SEQ, FNH = (FMD == 128) ? 4 : 16, FTPB = FROWS / 64;
        const bool kfm = FM && (u.pn >= k_lo) && (u.pn < k_hi);
        f32x4 cs[2][2]; float rsv[8];
#pragma unroll
        for (int bj = 0; bj < 2; ++bj)
#pragma unroll
            for (int n = 0; n < 2; ++n) cs[bj][n] = colscale ? *(const f32x4*)(colscale + u.pn * BM + bj * HALF + cl + 4 * n) : (f32x4){1.f, 1.f, 1.f, 1.f};
#pragma unroll
        for (int i = 0; i < 8; ++i) rsv[i] = rowss ? rowss[row0 + (i >> 2) * HALF + (i & 3) * 16] : 0.f;
        asm volatile("" ::: "memory");
#pragma unroll
        for (int ai = 0; ai < 2; ++ai)
#pragma unroll
            for (int m = 0; m < 4; ++m) {
                const int row = row0 + ai * HALF + m * 16;
                const float rsc = rowss ? __builtin_amdgcn_rsqf(rsv[ai * 4 + m] * (1.0f / DM) + EPS) : 1.0f;
#pragma unroll
                for (int bj = 0; bj < 2; ++bj) {
                    const f32x4 v0 = acc[ai][bj][m][0] * rsc * cs[bj][0], v1 = acc[ai][bj][m][1] * rsc * cs[bj][1];
                    u32x4 w; w.x = cvt_pk_bf16(v0[0], v0[1]); w.y = cvt_pk_bf16(v0[2], v0[3]); w.z = cvt_pk_bf16(v1[0], v1[1]); w.w = cvt_pk_bf16(v1[2], v1[3]);
                    if (FM && (kfm || tr)) {
                        const int c = (u.pn - (kfm ? k_lo : t_lo)) * BM + bj * HALF + cl, hh = c / FDH, d = c % FDH;
                        const int bb = row / FROWS, s = row % FROWS, tile = s >> 6, k = s & 63;
                        const size_t tbase = ((size_t)((bb * FNH + hh) * FTPB + tile)) * (64 * FDH);
                        if (kfm) {
                            const int kb = k >> 5, r = k & 31, mt = kb * 2 + ((r >> 2) & 1), fra = (r >> 3) * 4 + (r & 3), ks = d >> 5, fqa = (d >> 3) & 3;
                            *(u32x4*)(KF + tbase + ((mt * FKS + ks) * 64 + fqa * 16 + fra) * 8) = w;
                        } else {
                            const int dt = d >> 4, fra0 = d & 15, kb = k >> 5, fqa = (k & 31) >> 3, e8 = k & 7;
                            bf16_t* p = VT + tbase + ((dt * 2 + kb) * 64 + fqa * 16 + fra0) * 8 + e8;
                            p[0] = (bf16_t)(w.x & 0xffffu); p[8] = (bf16_t)(w.x >> 16); p[16] = (bf16_t)(w.y & 0xffffu); p[24] = (bf16_t)(w.y >> 16);
                            p[32] = (bf16_t)(w.z & 0xffffu); p[40] = (bf16_t)(w.z >> 16); p[48] = (bf16_t)(w.w & 0xffffu); p[56] = (bf16_t)(w.w >> 16);
                        }
                    } else if (!tr) { *(u32x4*)(O + (size_t)row * ldc + col_off + u.pn * BM + bj * HALF + cl) = w; }
                    else {
                        const int cv = (u.pn - t_lo) * BM + bj * HALF + cl, b = row / t_rows, s = row - b * t_rows;
                        bf16_t* p = VT + ((size_t)b * t_cols + cv) * t_rows + s;
                        p[0] = (bf16_t)(w.x & 0xffffu); p[(size_t)t_rows] = (bf16_t)(w.x >> 16); p[(size_t)2 * t_rows] = (bf16_t)(w.y & 0xffffu); p[(size_t)3 * t_rows] = (bf16_t)(w.y >> 16);
                        p[(size_t)4 * t_rows] = (bf16_t)(w.z & 0xffffu); p[(size_t)5 * t_rows] = (bf16_t)(w.z >> 16); p[(size_t)6 * t_rows] = (bf16_t)(w.w & 0xffffu); p[(size_t)7 * t_rows] = (bf16_t)(w.w >> 16);
                    }
                }
            }
    }
};
__device__ __forceinline__ float silu_mul(float g, float u) { return g * __builtin_amdgcn_rcpf(1.0f + __expf(-g)) * u; }
struct EpiSwiglu {
    bf16_t* O; int ldc; const float* rowss;
    __device__ __forceinline__ void operator()(const f32x4 (&acc)[2][2][4][2], const Unit& u, int wr, int wc, int fr, int fq) const {
        const int row0 = u.pm * BM + wr * 64 + fr, cl = wc * 32 + 8 * fq;
        float rsv[8];
#pragma unroll
        for (int i = 0; i < 8; ++i) rsv[i] = rowss[row0 + (i >> 2) * HALF + (i & 3) * 16];
        asm volatile("" ::: "memory");
#pragma unroll
        for (int ai = 0; ai < 2; ++ai)
#pragma unroll
            for (int m = 0; m < 4; ++m) {
                const int row = row0 + ai * HALF + m * 16;
                const float rsc = __builtin_amdgcn_rsqf(rsv[ai * 4 + m] * (1.0f / DM) + EPS);
                const f32x4 g0 = acc[ai][0][m][0] * rsc, g1 = acc[ai][0][m][1] * rsc, u0 = acc[ai][1][m][0] * rsc, u1 = acc[ai][1][m][1] * rsc;
                u32x4 w;
                w.x = cvt_pk_bf16(silu_mul(g0[0], u0[0]), silu_mul(g0[1], u0[1])); w.y = cvt_pk_bf16(silu_mul(g0[2], u0[2]), silu_mul(g0[3], u0[3]));
                w.z = cvt_pk_bf16(silu_mul(g1[0], u1[0]), silu_mul(g1[1], u1[1])); w.w = cvt_pk_bf16(silu_mul(g1[2], u1[2]), silu_mul(g1[3], u1[3]));
                *(u32x4*)(O + (size_t)row * ldc + u.pn * HALF + cl) = w;
            }
    }
};
template <bool F32IN> struct EpiRes {
    const float* hin_f; bf16_t* hb; float* rowss_out; float alpha;
    static constexpr int DEPTH = F32IN ? 2 : 4, NV = F32IN ? 4 : 2;
    __device__ __forceinline__ void ld(f32x4 (&hv)[4], size_t off) const {
        if (F32IN) { hv[0] = *(const f32x4*)(hin_f + off); hv[1] = *(const f32x4*)(hin_f + off + 4); hv[2] = *(const f32x4*)(hin_f + off + HALF); hv[3] = *(const f32x4*)(hin_f + off + HALF + 4); }
        else { hv[0] = __builtin_bit_cast(f32x4, *(const u32x4*)(hb + off)); hv[1] = __builtin_bit_cast(f32x4, *(const u32x4*)(hb + off + HALF)); }
    }
    __device__ __forceinline__ void operator()(const f32x4 (&acc)[2][2][4][2], const Unit& u, int wr, int wc, int fr, int fq) const {
        const int row0 = u.pm * BM + wr * 64 + fr, cl = u.pn * BM + wc * 32 + 8 * fq;
        f32x4 hv[DEPTH][4];
#pragma unroll
        for (int gi = 0; gi < DEPTH; ++gi) ld(hv[gi], (size_t)(row0 + (gi >> 2) * HALF + (gi & 3) * 16) * DM + cl);
#pragma unroll
        for (int gi = 0; gi < 8; ++gi) {
            const int ai = gi >> 2, m = gi & 3, cb = gi % DEPTH;
            asm volatile("" ::: "memory");
            const int row = row0 + ai * HALF + m * 16; const size_t off = (size_t)row * DM + cl;
            float ss = 0.f;
            u32x4 wv[2];
#pragma unroll
            for (int bj = 0; bj < 2; ++bj) {
                f32x4 o0, o1;
                if (F32IN) { o0 = hv[cb][2 * bj]; o1 = hv[cb][2 * bj + 1]; }
                else { const u32x4 q = __builtin_bit_cast(u32x4, hv[cb][bj]); o0 = (f32x4){bf_lo(q.x), bf_hi(q.x), bf_lo(q.y), bf_hi(q.y)}; o1 = (f32x4){bf_lo(q.z), bf_hi(q.z), bf_lo(q.w), bf_hi(q.w)}; }
                const f32x4 h0 = o0 + acc[ai][bj][m][0] * alpha, h1 = o1 + acc[ai][bj][m][1] * alpha;
                ss += (h0[0] * h0[0] + h0[1] * h0[1]) + (h0[2] * h0[2] + h0[3] * h0[3]) + (h1[0] * h1[0] + h1[1] * h1[1]) + (h1[2] * h1[2] + h1[3] * h1[3]);
                wv[bj].x = cvt_pk_bf16(h0[0], h0[1]); wv[bj].y = cvt_pk_bf16(h0[2], h0[3]); wv[bj].z = cvt_pk_bf16(h1[0], h1[1]); wv[bj].w = cvt_pk_bf16(h1[2], h1[3]);
            }
            if (gi + DEPTH < 8) ld(hv[cb], (size_t)(row0 + ((gi + DEPTH) >> 2) * HALF + ((gi + DEPTH) & 3) * 16) * DM + cl);
            *(u32x4*)(hb + off) = wv[0]; *(u32x4*)(hb + off + HALF) = wv[1];
            ss += __shfl_xor(ss, 16); ss += __shfl_xor(ss, 32);
            if (rowss_out && fq == 0) unsafeAtomicAdd(rowss_out + row, ss);
        }
    }
};

struct EpiNull {
    __device__ __forceinline__ void operator()(const f32x4 (&acc)[2][2][4][2], const Unit& u, int wr, int wc, int fr, int fq) const {
#pragma unroll
        for (int ai = 0; ai < 2; ++ai)
#pragma unroll
            for (int bj = 0; bj < 2; ++bj)
#pragma unroll
                for (int m = 0; m < 4; ++m) asm volatile("" :: "v"(acc[ai][bj][m][0]), "v"(acc[ai][bj][m][1]));
    }
};

template <class Epi, bool ALIGN_EPI = true, int AUX_A = 0>
__device__ __forceinline__ void gemm_phase(LAS unsigned char* lds, const Gemm g, const StaticOrder& S, const Epi& E) {
    int tid_l = threadIdx.x; asm volatile("" : "+v"(tid_l));
    const int tid = tid_l, wid = __builtin_amdgcn_readfirstlane(tid >> 6), lane = tid & 63, wr = wid >> 2, wc = wid & 3, fr = lane & 15, fq = lane >> 4;
    const int K = g.K, nt = K / BK;
    unsigned voffA[2], voffB[2];
#pragma unroll
    for (int i = 0; i < 2; ++i) { int R, C; stage_rc(tid * 16 + i * 8192, R, C); const int Rb = (R & ~31) + perm32(R & 31);
        voffA[i] = (unsigned)(R * g.lda + C) * 2u; voffB[i] = (unsigned)(Rb * g.ldb + C) * 2u; }
    const size_t kstep = (size_t)(BK * 2);
    const size_t hstepA = (size_t)HALF * g.lda * 2, hstepB = (size_t)HALF * g.ldb * 2;
    const size_t tstepA = 2 * hstepA, tstepB = 2 * hstepB;
    const unsigned ldsw = (unsigned)wid * 1024u;
    const int aoff = lds_byte(wr * 64 + fr, fq * 8), boff = lds_byte(wc * 32 + fr, fq * 8);
#define PG8_SA(b, h) (((b) * 2 + (h)) * HTB)
#define PG8_SB(b, h) ((4 + (b) * 2 + (h)) * HTB)
#define PG8_STAGE_X(bufoff, gbase, voff, aux) do { _Pragma("unroll") for (int _i = 0; _i < 2; ++_i) \
        __builtin_amdgcn_global_load_lds((const unsigned*)((const char*)(gbase) + (voff)[_i]), (LAS unsigned*)(lds + (bufoff) + ldsw + _i * 8192), 16, 0, aux); } while (0)
#define PG8_STAGE(bufoff, gbase, voff) PG8_STAGE_X(bufoff, gbase, voff, 0)
#define PG8_LDA(dst, b, h) do { _Pragma("unroll") for (int m = 0; m < 4; ++m) _Pragma("unroll") for (int k = 0; k < 2; ++k) dst[m][k] = *(const LAS bf16x8*)(lds + PG8_SA(b, h) + aoff + m * 2048 + k * 1024); } while (0)
#define PG8_LDB(dst, b, h) do { _Pragma("unroll") for (int n = 0; n < 2; ++n) _Pragma("unroll") for (int k = 0; k < 2; ++k) dst[n][k] = *(const LAS bf16x8*)(lds + PG8_SB(b, h) + boff + n * 2048 + k * 1024); } while (0)
#define PG8_MMA(ai, bj, At, Bt) do { __builtin_amdgcn_s_setprio(1); _Pragma("unroll") for (int m = 0; m < 4; ++m) _Pragma("unroll") for (int n = 0; n < 2; ++n) _Pragma("unroll") for (int k = 0; k < 2; ++k) \
        acc[ai][bj][m][n] = __builtin_amdgcn_mfma_f32_16x16x32_bf16(Bt[n][k], At[m][k], acc[ai][bj][m][n], 0, 0, 0); __builtin_amdgcn_s_setprio(0); } while (0)
#define PG8_WAIT_V(n) asm volatile("s_waitcnt vmcnt(" #n ")" ::: "memory")
#define PG8_WAIT_L(n) asm volatile("s_waitcnt lgkmcnt(" #n ")" ::: "memory")
#define PG8_BAR __builtin_amdgcn_s_barrier()
#define PG8_SCHED __builtin_amdgcn_sched_barrier(0)
    Unit cur, nxt; int ui = 0;
    if (!S.next(0, cur)) return;
    f32x4 acc[2][2][4][2];
#pragma unroll
    for (int a = 0; a < 2; ++a)
#pragma unroll
        for (int b = 0; b < 2; ++b)
#pragma unroll
            for (int m = 0; m < 4; ++m)
#pragma unroll
                for (int n = 0; n < 2; ++n) acc[a][b][m][n] = (f32x4){0.f, 0.f, 0.f, 0.f};
    bf16x8 At[4][2], B0[2][2], B1[2][2];
    const char* cA = (const char*)g.A + (size_t)cur.pm * tstepA + (size_t)cur.pn * g.a_pn_step; const char* cB = (const char*)g.Bt + (size_t)cur.pn * tstepB;
    PG8_STAGE(PG8_SB(0, 0), cB, voffB); PG8_STAGE(PG8_SB(0, 1), cB + hstepB, voffB); PG8_STAGE_X(PG8_SA(0, 0), cA, voffA, AUX_A); PG8_STAGE_X(PG8_SA(0, 1), cA + hstepA, voffA, AUX_A);
    if (wr == 1) PG8_BAR;
    PG8_WAIT_V(2); PG8_BAR;
    PG8_STAGE(PG8_SB(1, 0), cB + kstep, voffB); PG8_STAGE_X(PG8_SA(1, 0), cA + kstep, voffA, AUX_A); PG8_STAGE(PG8_SB(1, 1), cB + hstepB + kstep, voffB);
    PG8_WAIT_V(6); PG8_BAR;
    for (;;) {
        const bool has_next = S.next(ui + 1, nxt);
        const char* nA = has_next ? (const char*)g.A + (size_t)nxt.pm * tstepA + (size_t)nxt.pn * g.a_pn_step : cA; const char* nB = has_next ? (const char*)g.Bt + (size_t)nxt.pn * tstepB : cB;
        for (int t = 0; t < nt; t += 2) {
            const bool last = (t == nt - 2);
            const char* a1 = cA + (size_t)(t + 1) * kstep;
            const char* a2 = last ? nA : cA + (size_t)(t + 2) * kstep; const char* b2 = last ? nB : cB + (size_t)(t + 2) * kstep;
            const char* a3 = a2 + kstep; const char* b3 = b2 + kstep;
            PG8_LDB(B0, 0, 0); PG8_LDB(B1, 0, 1); PG8_SCHED; PG8_LDA(At, 0, 0); PG8_STAGE_X(PG8_SA(1, 1), a1 + hstepA, voffA, AUX_A);
            PG8_WAIT_V(8); PG8_WAIT_L(0); PG8_BAR; PG8_MMA(0, 0, At, B0); PG8_MMA(0, 1, At, B1); PG8_BAR; PG8_SCHED;
            PG8_LDA(At, 0, 1); PG8_STAGE(PG8_SB(0, 0), b2, voffB); PG8_STAGE(PG8_SB(0, 1), b2 + hstepB, voffB); PG8_STAGE_X(PG8_SA(0, 0), a2, voffA, AUX_A);
            PG8_WAIT_V(8); PG8_WAIT_L(0); PG8_BAR; PG8_MMA(1, 0, At, B0); PG8_MMA(1, 1, At, B1); PG8_BAR; PG8_SCHED;
            PG8_LDB(B0, 1, 0); PG8_LDB(B1, 1, 1); PG8_SCHED; PG8_LDA(At, 1, 0); PG8_STAGE_X(PG8_SA(0, 1), a2 + hstepA, voffA, AUX_A);
            PG8_WAIT_V(8); PG8_WAIT_L(0); PG8_BAR; PG8_MMA(0, 0, At, B0); PG8_MMA(0, 1, At, B1); PG8_BAR; PG8_SCHED;
            PG8_LDA(At, 1, 1); PG8_STAGE(PG8_SB(1, 0), b3, voffB); PG8_STAGE(PG8_SB(1, 1), b3 + hstepB, voffB); PG8_STAGE_X(PG8_SA(1, 0), a3, voffA, AUX_A);
            PG8_WAIT_V(8); PG8_WAIT_L(0); PG8_BAR; PG8_MMA(1, 0, At, B0); PG8_MMA(1, 1, At, B1); PG8_BAR; PG8_SCHED;
        }
        if constexpr (ALIGN_EPI) { if (wr == 0) PG8_BAR; }
        E(acc, cur, wr, wc, fr, fq);
        if (!has_next) break;
#pragma unroll
        for (int a = 0; a < 2; ++a)
#pragma unroll
            for (int b = 0; b < 2; ++b)
#pragma unroll
                for (int m = 0; m < 4; ++m)
#pragma unroll
                    for (int n = 0; n < 2; ++n) acc[a][b][m][n] = (f32x4){0.f, 0.f, 0.f, 0.f};
        cur = nxt; cA = nA; cB = nB; ++ui;
        if constexpr (ALIGN_EPI) { if (wr == 1) PG8_BAR; }
    }
    PG8_WAIT_V(0);
    if constexpr (!ALIGN_EPI) { if (wr == 0) PG8_BAR; }
    PG8_BAR;
#undef PG8_SA
#undef PG8_SB
#undef PG8_STAGE
#undef PG8_STAGE_X
#undef PG8_LDA
#undef PG8_LDB
#undef PG8_MMA
#undef PG8_WAIT_V
#undef PG8_WAIT_L
#undef PG8_BAR
#undef PG8_SCHED
}
}

template <int DH, bool BIAS, int NT, bool PF, bool COAL = false, bool VDB = true>
__device__ __forceinline__ void attn_wave32(const bf16_t* __restrict__ Qp, int ldq, const bf16_t* __restrict__ Kp, int ldk, const bf16_t* __restrict__ Vp, int ldv,
                                            bf16_t* __restrict__ Op, int ldo, int ntiles, float sc, const LAS float* tab, int rel_base, int lane) {
    constexpr int KS = DH / 32, DT = DH / 16;
    asm volatile("" : "+v"(lane));
    const int fr = lane & 15, fq = lane >> 4;
    bf16x8 qf[NT][KS];
#pragma unroll
    for (int nt = 0; nt < NT; ++nt)
#pragma unroll
        for (int ks = 0; ks < KS; ++ks) qf[nt][ks] = *(const bf16x8*)(Qp + (size_t)(nt * 16 + fr) * ldq + ks * 32 + fq * 8);
    f32x4 o[DT][NT];
#pragma unroll
    for (int dt = 0; dt < DT; ++dt)
#pragma unroll
        for (int nt = 0; nt < NT; ++nt) o[dt][nt] = (f32x4){0.f, 0.f, 0.f, 0.f};
    float mrun[NT], lrun[NT];
#pragma unroll
    for (int nt = 0; nt < NT; ++nt) { mrun[nt] = -1e30f; lrun[nt] = 0.f; }
    const bf16_t* kbase = Kp + (size_t)(8 * (fr >> 2) + (fr & 3)) * ldk + fq * 8;
    const bf16_t* vbase = Vp + (size_t)fr * ldv + fq * 8;
    bf16x8 kf[4][KS], vfA[DT][2], vfB[DT][2];
#define ATT_LOADK(tt) do { _Pragma("unroll") for (int mt = 0; mt < 4; ++mt) _Pragma("unroll") for (int ks = 0; ks < KS; ++ks) \
        kf[mt][ks] = COAL ? *(const bf16x8*)(Kp + (size_t)(tt) * (64 * DH) + (mt * KS + ks) * 512 + lane * 8) \
                          : *(const bf16x8*)(kbase + (size_t)((tt) * 64 + (mt >> 1) * 32 + 4 * (mt & 1)) * ldk + ks * 32); } while (0)
#define ATT_LOADV(dst, tt) do { _Pragma("unroll") for (int dt = 0; dt < DT; ++dt) _Pragma("unroll") for (int kb = 0; kb < 2; ++kb) \
        dst[dt][kb] = COAL ? *(const bf16x8*)(Vp + (size_t)(tt) * (64 * DH) + (dt * 2 + kb) * 512 + lane * 8) \
                           : *(const bf16x8*)(vbase + (size_t)(dt * 16) * ldv + (tt) * 64 + kb * 32); } while (0)
#define ATT_BODY(t, vcur, vnext) do { \
        const int tn_ = ((t) + 1 < ntiles) ? (t) + 1 : (t); \
        if (PF && VDB) ATT_LOADV(vnext, tn_); else if (PF) ATT_LOADV(vcur, t); else ATT_LOADK(t); \
        f32x4 s[4][NT]; \
        _Pragma("unroll") for (int mt = 0; mt < 4; ++mt) _Pragma("unroll") for (int nt = 0; nt < NT; ++nt) { s[mt][nt] = (f32x4){0.f, 0.f, 0.f, 0.f}; \
            _Pragma("unroll") for (int ks = 0; ks < KS; ++ks) s[mt][nt] = __builtin_amdgcn_mfma_f32_16x16x32_bf16(kf[mt][ks], qf[nt][ks], s[mt][nt], 0, 0, 0); } \
        if (PF) ATT_LOADK(tn_); \
        bf16x8 pf[NT][2]; \
          \
        const LAS float* tb_ = tab + (rel_base - 64 * (t) + fr - 8 * fq + 63 - 39); \
        _Pragma("unroll") for (int nt = 0; nt < NT; ++nt) { \
            float mloc = -1e30f; \
            _Pragma("unroll") for (int mt = 0; mt < 4; ++mt) _Pragma("unroll") for (int j = 0; j < 4; ++j) { \
                float v = s[mt][nt][j] * sc; \
                if (BIAS) v += tb_[39 + nt * 16 - ((mt >> 1) * 32 + 4 * (mt & 1) + j)]; \
                s[mt][nt][j] = v; mloc = fmaxf(mloc, v); } \
            mloc = fmaxf(mloc, __shfl_xor(mloc, 16)); mloc = fmaxf(mloc, __shfl_xor(mloc, 32)); \
            const float mnew = fmaxf(mrun[nt], mloc), alpha = __builtin_amdgcn_exp2f(mrun[nt] - mnew); \
            mrun[nt] = mnew; \
            float ls = 0.f; \
            _Pragma("unroll") for (int mt = 0; mt < 4; ++mt) _Pragma("unroll") for (int j = 0; j < 4; ++j) { const float p = __builtin_amdgcn_exp2f(s[mt][nt][j] - mnew); s[mt][nt][j] = p; ls += p; } \
            lrun[nt] = lrun[nt] * alpha + ls; \
            _Pragma("unroll") for (int dt = 0; dt < DT; ++dt) o[dt][nt] = o[dt][nt] * alpha; \
            _Pragma("unroll") for (int kb = 0; kb < 2; ++kb) { \
                u32x4 w; w.x = cvt_pk_bf16(s[2 * kb][nt][0], s[2 * kb][nt][1]); w.y = cvt_pk_bf16(s[2 * kb][nt][2], s[2 * kb][nt][3]); \
                w.z = cvt_pk_bf16(s[2 * kb + 1][nt][0], s[2 * kb + 1][nt][1]); w.w = cvt_pk_bf16(s[2 * kb + 1][nt][2], s[2 * kb + 1][nt][3]); \
                pf[nt][kb] = __builtin_bit_cast(bf16x8, w); } } \
        if (!PF) { asm volatile("" ::: "memory"); ATT_LOADV(vcur, t); } \
        _Pragma("unroll") for (int dt = 0; dt < DT; ++dt) _Pragma("unroll") for (int nt = 0; nt < NT; ++nt) _Pragma("unroll") for (int kb = 0; kb < 2; ++kb) \
            o[dt][nt] = __builtin_amdgcn_mfma_f32_16x16x32_bf16(vcur[dt][kb], pf[nt][kb], o[dt][nt], 0, 0, 0); \
    } while (0)
    if (PF && VDB) { ATT_LOADK(0); ATT_LOADV(vfA, 0);
#pragma nounroll
        for (int t = 0; t < ntiles; t += 2) {
            ATT_BODY(t, vfA, vfB);
            if (t + 1 < ntiles) ATT_BODY(t + 1, vfB, vfA);
        }
    } else if (PF) { ATT_LOADK(0);
#pragma nounroll
        for (int t = 0; t < ntiles; ++t) ATT_BODY(t, vfA, vfB);
    } else {
#pragma nounroll
        for (int t = 0; t < ntiles; ++t) ATT_BODY(t, vfA, vfB);
    }
#undef ATT_BODY
#undef ATT_LOADK
#undef ATT_LOADV
#pragma unroll
    for (int nt = 0; nt < NT; ++nt) {
        float l = lrun[nt]; l += __shfl_xor(l, 16); l += __shfl_xor(l, 32);
        const float inv = 1.0f / l;
#pragma unroll
        for (int dt = 0; dt < DT; ++dt) {
            const f32x4 v = o[dt][nt] * inv; u32x2 w; w.x = cvt_pk_bf16(v[0], v[1]); w.y = cvt_pk_bf16(v[2], v[3]);
            *(u32x2*)(Op + (size_t)(nt * 16 + fr) * ldo + dt * 16 + 4 * fq) = w;
        }
    }
}

#define XB_TMO      128
#define XB_XCNT(j)  (256  + 64 * (j))
#define XB_XSUB(j)  (1280 + 64 * (j))
#define XB_XGEN(j)  (2304 + 64 * (j))
#define XB_TOP      3328
#define XB_TOPGEN   3392
#define XCD_BAR_WORDS 3456
#define XB_SPIN_CAP (1u << 22)
__device__ __forceinline__ unsigned xb_ld(unsigned* p)              { return __hip_atomic_load(p, __ATOMIC_RELAXED, __HIP_MEMORY_SCOPE_AGENT); }
__device__ __forceinline__ unsigned xb_add(unsigned* p, unsigned v) { return __hip_atomic_fetch_add(p, v, __ATOMIC_RELAXED, __HIP_MEMORY_SCOPE_AGENT); }
__device__ __forceinline__ unsigned xb_xcc_id() { return (unsigned)__builtin_amdgcn_s_getreg((3 << 11) | 20) & 0xFu; }
#define XB_SPIN(cond, bar) do { unsigned _sp = 0; while (cond) { __builtin_amdgcn_s_sleep(1); \
    if ((++_sp & 255u) == 0u) { if (xb_ld(&(bar)[XB_TMO])) break; if (_sp > XB_SPIN_CAP) { atomicAdd(&(bar)[XB_TMO], 1u); break; } } } } while (0)
struct XcdBarrier { unsigned* bar; unsigned x; volatile LAS unsigned* st; };
__device__ __forceinline__ XcdBarrier xcd_barrier_post(unsigned* bar, volatile LAS unsigned* st) {
    XcdBarrier b; b.bar = bar; b.x = xb_xcc_id(); b.st = st;
    if (threadIdx.x == 0) (void)xb_add(&bar[XB_XCNT(b.x)], 1u);
    return b;
}
__device__ __forceinline__ void xcd_barrier_complete(unsigned* bar, unsigned x, unsigned& nloc, unsigned& nx) {
    const unsigned G = gridDim.x * gridDim.y * gridDim.z;
    unsigned sum, cnt, mine, sp = 0u;
    for (;;) {
        sum = 0u; cnt = 0u; mine = 0u;
#pragma unroll
        for (unsigned j = 0; j < 16; ++j) { const unsigned c = xb_ld(&bar[XB_XCNT(j)]); sum += c; cnt += (c > 0u) ? 1u : 0u; mine = (j == x) ? c : mine; }
        if (sum == G) break;
        __builtin_amdgcn_s_sleep(1);
        if ((++sp & 255u) == 0u) { if (xb_ld(&bar[XB_TMO])) break; if (sp > XB_SPIN_CAP) { atomicAdd(&bar[XB_TMO], 1u); break; } }
    }
    nloc = mine > 0u ? mine : 1u; nx = cnt > 0u ? cnt : 1u;
}
__device__ __forceinline__ void xcd_barrier(const XcdBarrier& b) {
    asm volatile("s_waitcnt vmcnt(0)" ::: "memory");
    __syncthreads();
    if (threadIdx.x == 0) {
        unsigned* bar = b.bar;
        __builtin_amdgcn_s_waitcnt(0);
        unsigned nloc = b.st[0], nx = b.st[1];
        if (nloc == 0u) { xcd_barrier_complete(bar, b.x, nloc, nx); b.st[0] = nloc; b.st[1] = nx; }
        const unsigned old = xb_add(&bar[XB_XSUB(b.x)], 1u);
        const unsigned gen = old / nloc;
        if (old + 1u == (gen + 1u) * nloc) {
            __builtin_amdgcn_fence(__ATOMIC_RELEASE, "agent");
            asm volatile("s_waitcnt vmcnt(0)" ::: "memory");
            const unsigned og = xb_add(&bar[XB_TOP], 1u);
            const unsigned tg = og / nx;
            if (og + 1u == (tg + 1u) * nx) xb_add(&bar[XB_TOPGEN], 1u);
            else XB_SPIN(xb_ld(&bar[XB_TOPGEN]) == tg, bar);
            __builtin_amdgcn_fence(__ATOMIC_ACQUIRE, "agent");
            xb_add(&bar[XB_XGEN(b.x)], 1u);
            asm volatile("s_waitcnt vmcnt(0)" ::: "memory");
        } else {
            XB_SPIN(xb_ld(&bar[XB_XGEN(b.x)]) == gen, bar);
            __builtin_amdgcn_fence(__ATOMIC_ACQUIRE, "agent");
            asm volatile("s_waitcnt vmcnt(0)" ::: "memory");
        }
    }
    __syncthreads();
}

struct Params {
    const float* x; const float* mem;
    const float* ffn1_norm; const float* ffn1_wg; const float* ffn1_wu; const float* ffn1_wd;
    const float* mix_norm; const float* w_in; const float* rel_bias; const float* w_pool; const float* pool_scale; const float* w_out;
    const float* cross_norm; const float* mem_norm; const float* w_cq; const float* w_ckv; const float* w_co;
    const float* ffn2_norm; const float* ffn2_wg; const float* ffn2_wu; const float* ffn2_wd; const float* final_norm;
    float* out; unsigned char* ws;
};

__device__ __forceinline__ void p0_transpose_item(const float* __restrict__ W, int K, int N, bf16_t* __restrict__ WT, int mode, int row_off, const float* __restrict__ gain, LAS float* scr, int item, int lane) {
    const int nblk = N / 32, kb = item / nblk, nb = item - kb * nblk, k0 = 64 * kb, n0 = 32 * nb;
#pragma unroll 8
    for (int i = 0; i < 32; ++i) { const int kk = 2 * i + (lane >> 5); const float gk = gain ? gain[k0 + kk] : 1.0f; scr[kk * 33 + (lane & 31)] = W[(size_t)(k0 + kk) * N + n0 + (lane & 31)] * gk; }
    asm volatile("s_waitcnt lgkmcnt(0)" ::: "memory");
    const int c = lane & 7;
    const int d0 = (mode == 0) ? (row_off + n0) : ((n0 >> 7) * 256 + (n0 & 127) + (mode == 2 ? 128 : 0));
#pragma unroll
    for (int j = 0; j < 4; ++j) { const int n = (lane >> 3) + 8 * j; const LAS float* s = scr + (8 * c) * 33 + n;
        u32x4 o; o.x = cvt_pk_bf16(s[0 * 33], s[1 * 33]); o.y = cvt_pk_bf16(s[2 * 33], s[3 * 33]); o.z = cvt_pk_bf16(s[4 * 33], s[5 * 33]); o.w = cvt_pk_bf16(s[6 * 33], s[7 * 33]);
        *(u32x4*)(WT + (size_t)(d0 + n) * K + k0 + 8 * c) = o; }
    asm volatile("s_waitcnt lgkmcnt(0)" ::: "memory");
}

#define rowss ((float*)(P.ws + WS_ROWSS))
#define Wgu1 ((bf16_t*)(P.ws + WS_WGU1))
#define Wd1 ((bf16_t*)(P.ws + WS_WD1))
#define Win ((bf16_t*)(P.ws + WS_WIN))
#define Wp ((bf16_t*)(P.ws + WS_WP))
#define Wout ((bf16_t*)(P.ws + WS_WOUT))
#define Wcq ((bf16_t*)(P.ws + WS_WCQ))
#define Wckv ((bf16_t*)(P.ws + WS_WCKV))
#define Wco ((bf16_t*)(P.ws + WS_WCO))
#define Wgu2 ((bf16_t*)(P.ws + WS_WGU2))
#define Wd2 ((bf16_t*)(P.ws + WS_WD2))
#define HB ((bf16_t*)(P.ws + WS_HB))
#define ACT ((bf16_t*)(P.ws + WS_ACT))
#define Z ((bf16_t*)(P.ws + WS_Z))
#define VT ((bf16_t*)(P.ws + WS_VT))
#define Y ((bf16_t*)(P.ws + WS_Y))
#define CQ ((bf16_t*)(P.ws + WS_CQ))
#define CO ((bf16_t*)(P.ws + WS_CO))
#define DP ((bf16_t*)(P.ws + WS_DP))
#define MEMN ((bf16_t*)(P.ws + WS_MEMN))
#define KC ((bf16_t*)(P.ws + WS_KC))
#define VCT ((bf16_t*)(P.ws + WS_VCT))
#define KF ((bf16_t*)(P.ws + WS_KF))
__global__ void __launch_bounds__(512, 2) fwd_megakernel(Params P) {
    extern __shared__ __attribute__((aligned(16))) unsigned char lds_raw[];
    cg::grid_group grid = cg::this_grid();
    LAS unsigned char* lds = (LAS unsigned char*)lds_raw;
    const int tid = threadIdx.x, lane = tid & 63, wave = __builtin_amdgcn_readfirstlane(tid >> 6);
    const int G = gridDim.x, bx = blockIdx.x;
    const int gw = bx * 8 + wave, NGW = G * 8;
    volatile LAS unsigned* bst = (volatile LAS unsigned*)(lds + 131072 + 64);
    if (tid < 2) bst[tid] = 0u;
    __syncthreads();
    const XcdBarrier xbar = xcd_barrier_post((unsigned*)(P.ws + WS_BAR), bst);
#ifndef WGM_RES
#define WGM_RES 8
#endif
#ifndef REV_DOWN
#define REV_DOWN 1
#endif
#define RUN_GEMM_ON(EPI, gM, gN, gdesc, edesc, G_, c_) do { pg8::StaticOrder S_; S_.init((gM), (gN), (G_), (c_), ((gN) == DM) ? WGM_RES : 8); pg8::gemm_phase<EPI>(lds, (gdesc), S_, (edesc)); } while (0)
#define RUN_GEMM(EPI, gM, gN, gdesc, edesc) RUN_GEMM_ON(EPI, gM, gN, gdesc, edesc, G, bx)
#ifndef AUX_DOWN
#define AUX_DOWN 0
#endif
#define RUN_GEMM_NT(EPI, gM, gN, gdesc, edesc) do { pg8::StaticOrder S_; S_.init((gM), (gN), G, bx, ((gN) == DM) ? WGM_RES : 8, REV_DOWN); pg8::gemm_phase<EPI, true, AUX_DOWN>(lds, (gdesc), S_, (edesc)); } while (0)

    for (int rep_ = 0; rep_ < REP_P0; ++rep_) {
        LAS float* scr = (LAS float*)(lds + wave * 16384);
        constexpr int I_G = (DM / 64) * (DFF / 32), I_D = (DFF / 64) * (DM / 32), I_IN = (DM / 64) * (DIN / 32), I_P = (256 / 64) * (256 / 32), I_O = (DM / 64) * (DM / 32),
                      I_CQ = (DM / 64) * (DCROSS / 32), I_CKV = (DM / 64) * (2 * DCROSS / 32), I_CO = (DCROSS / 64) * (DM / 32);
        constexpr int NITEMS = 4 * I_G + 2 * I_D + I_IN + 4 * I_P + I_O + I_CQ + I_CKV + I_CO;
        for (int it = gw; it < NITEMS; it += NGW) {
            int r = it;
            if (r < I_G) { p0_transpose_item(P.ffn1_wg, DM, DFF, Wgu1, 1, 0, P.ffn1_norm, scr, r, lane); continue; } r -= I_G;
            if (r < I_G) { p0_transpose_item(P.ffn1_wu, DM, DFF, Wgu1, 2, 0, P.ffn1_norm, scr, r, lane); continue; } r -= I_G;
            if (r < I_D) { p0_transpose_item(P.ffn1_wd, DFF, DM, Wd1, 0, 0, nullptr, scr, r, lane); continue; } r -= I_D;
            if (r < I_G) { p0_transpose_item(P.ffn2_wg, DM, DFF, Wgu2, 1, 0, P.ffn2_norm, scr, r, lane); continue; } r -= I_G;
            if (r < I_G) { p0_transpose_item(P.ffn2_wu, DM, DFF, Wgu2, 2, 0, P.ffn2_norm, scr, r, lane); continue; } r -= I_G;
            if (r < I_D) { p0_transpose_item(P.ffn2_wd, DFF, DM, Wd2, 0, 0, nullptr, scr, r, lane); continue; } r -= I_D;
            if (r < I_IN) { p0_transpose_item(P.w_in, DM, DIN, Win, 0, 0, P.mix_norm, scr, r, lane); continue; } r -= I_IN;
            if (r < 4 * I_P) { const int gi = r / I_P; p0_transpose_item(P.w_pool + (size_t)gi * 65536, 256, 256, Wp, 0, gi * 256, nullptr, scr, r - gi * I_P, lane); continue; } r -= 4 * I_P;
            if (r < I_O) { p0_transpose_item(P.w_out, DM, DM, Wout, 0, 0, nullptr, scr, r, lane); continue; } r -= I_O;
            if (r < I_CQ) { p0_transpose_item(P.w_cq, DM, DCROSS, Wcq, 0, 0, P.cross_norm, scr, r, lane); continue; } r -= I_CQ;
            if (r < I_CKV) { p0_transpose_item(P.w_ckv, DM, 2 * DCROSS, Wckv, 0, 0, nullptr, scr, r, lane); continue; } r -= I_CKV;
            p0_transpose_item(P.w_co, DCROSS, DM, Wco, 0, 0, nullptr, scr, r, lane);
        }
        for (int i = bx * 512 + tid; i < 4 * MTOK; i += G * 512) rowss[MTOK + i] = 0.f;
        for (int m = gw; m < MTOK; m += NGW) {
            const f32x4* xr = (const f32x4*)(P.x + (size_t)m * DM) + lane; u32x2* o8 = (u32x2*)(HB + (size_t)m * DM) + lane; float s = 0.f;
#pragma unroll
            for (int j = 0; j < 8; ++j) { const f32x4 v = xr[64 * j]; s += (v[0] * v[0] + v[1] * v[1]) + (v[2] * v[2] + v[3] * v[3]); u32x2 w; w.x = cvt_pk_bf16(v[0], v[1]); w.y = cvt_pk_bf16(v[2], v[3]); o8[64 * j] = w; }
            s = wave_sum(s); if (lane == 0) rowss[m] = s;
        }
        for (int m = gw; m < BATCH * NMEM; m += NGW) {
            const f32x4* xr = (const f32x4*)(P.mem + (size_t)m * DM) + lane; const f32x4* gr = (const f32x4*)P.mem_norm + lane; u32x2* o8 = (u32x2*)(MEMN + (size_t)m * DM) + lane;
            f32x4 v[8]; float s = 0.f;
#pragma unroll
            for (int j = 0; j < 8; ++j) { v[j] = xr[64 * j]; s += (v[j][0] * v[j][0] + v[j][1] * v[j][1]) + (v[j][2] * v[j][2] + v[j][3] * v[j][3]); }
            const float rs = __builtin_amdgcn_rsqf(wave_sum(s) * (1.0f / DM) + EPS);
#pragma unroll
            for (int j = 0; j < 8; ++j) { const f32x4 gg = gr[64 * j]; const f32x4 y = v[j] * rs * gg; u32x2 w; w.x = cvt_pk_bf16(y[0], y[1]); w.y = cvt_pk_bf16(y[2], y[3]); o8[64 * j] = w; }
        }
    }
    grid.sync();
    for (int rep_ = 0; rep_ < REP_G1; ++rep_)
    RUN_GEMM(pg8::EpiSwiglu, MTOK, 2 * DFF, (pg8::Gemm{HB, Wgu1, DM, DM, DM, 0}), (pg8::EpiSwiglu{ACT, DFF, rowss}));
    for (int rep_ = 0; rep_ < REP_G1NULL; ++rep_)
    RUN_GEMM(pg8::EpiNull, MTOK, 2 * DFF, (pg8::Gemm{HB, Wgu1, DM, DM, DM, 0}), (pg8::EpiNull{}));
    for (int rep_ = 0; rep_ < REP_SYNC; ++rep_) grid.sync();
    xcd_barrier(xbar);
    for (int rep_ = 0; rep_ < REP_G2NULL; ++rep_)
    RUN_GEMM(pg8::EpiNull, MTOK, DM, (pg8::Gemm{ACT, Wd1, DFF, DFF, DFF, 0}), (pg8::EpiNull{}));
    for (int rep_ = 0; rep_ < REP_G2; ++rep_)
    RUN_GEMM(pg8::EpiRes<true>, MTOK, DM, (pg8::Gemm{ACT, Wd1, DFF, DFF, DFF, 0}), (pg8::EpiRes<true>{P.x, HB, nullptr, 0.5f}));
    RUN_GEMM_NT(pg8::EpiRes<true>, MTOK, DM, (pg8::Gemm{ACT, Wd1, DFF, DFF, DFF, 0}), (pg8::EpiRes<true>{P.x, HB, rowss + 1 * MTOK, 0.5f}));
    xcd_barrier(xbar);
    for (int rep_ = 0; rep_ < REP_G3; ++rep_)
    RUN_GEMM(pg8::EpiBf<64>, MTOK, DIN, (pg8::Gemm{HB, Win, DM, DM, DM, 0}), (pg8::EpiBf<64>{Z, DIN, 0, rowss + 1 * MTOK, nullptr, 8, 12, SEQ, DATT, VT, 4, 8, KF}));
    xcd_barrier(xbar);
    for (int rep_ = 0; rep_ < REP_ATT; ++rep_) {
        for (int task = gw; task < (MTOK / 64) * 4; task += NGW) {
            const int gi = task & 3, rt = task >> 2, sub = lane >> 5, cgi = lane & 31, w = 2 << gi;
            const int t0 = rt * 64 + sub * 32, tpos = t0 & (SEQ - 1);
            const bf16_t* up = Z + (size_t)t0 * DIN + 3 * DATT + gi * 256 + cgi * 8;
            bf16_t* dp = DP + (size_t)t0 * DPOOL + gi * 256 + cgi * 8;
            float sum[8];
#pragma unroll
            for (int e = 0; e < 8; ++e) sum[e] = 0.f;
            for (int i = 1; i < w; ++i) if (tpos - i >= 0) { const u32x4 v = *(const u32x4*)(up - (size_t)i * DIN);
                sum[0] += bf_lo(v.x); sum[1] += bf_hi(v.x); sum[2] += bf_lo(v.y); sum[3] += bf_hi(v.y); sum[4] += bf_lo(v.z); sum[5] += bf_hi(v.z); sum[6] += bf_lo(v.w); sum[7] += bf_hi(v.w); }
#pragma nounroll
            for (int r0 = 0; r0 < 32; r0 += 8) {
                u32x4 cv[8], ov[8];
#pragma unroll
                for (int j = 0; j < 8; ++j) cv[j] = *(const u32x4*)(up + (size_t)(r0 + j) * DIN);
#pragma unroll
                for (int j = 0; j < 8; ++j) { const int rr = r0 + j - w + 1; ov[j] = (tpos + rr >= 0) ? *(const u32x4*)(up + (ptrdiff_t)rr * DIN) : (u32x4){0u, 0u, 0u, 0u}; }
#pragma unroll
                for (int j = 0; j < 8; ++j) {
                    const u32x4 v = cv[j], q = ov[j];
                    const float cur[8] = {bf_lo(v.x), bf_hi(v.x), bf_lo(v.y), bf_hi(v.y), bf_lo(v.z), bf_hi(v.z), bf_lo(v.w), bf_hi(v.w)};
                    const float old[8] = {bf_lo(q.x), bf_hi(q.x), bf_lo(q.y), bf_hi(q.y), bf_lo(q.z), bf_hi(q.z), bf_lo(q.w), bf_hi(q.w)};
                    const int have = tpos + r0 + j + 1; const float inv = 1.0f / (float)(have < w ? have : w);
                    float d[8];
#pragma unroll
                    for (int e = 0; e < 8; ++e) { sum[e] += cur[e]; d[e] = sum[e] * inv - cur[e]; sum[e] -= old[e]; }
                    u32x4 o; o.x = cvt_pk_bf16(d[0], d[1]); o.y = cvt_pk_bf16(d[2], d[3]); o.z = cvt_pk_bf16(d[4], d[5]); o.w = cvt_pk_bf16(d[6], d[7]);
                    *(u32x4*)(dp + (size_t)(r0 + j) * DPOOL) = o;
                }
            }
        }
        LAS float* tab = (LAS float*)lds;
        for (int bh = bx; bh < BATCH * 16; bh += G) {
            const int b = bh >> 4, h = bh & 15;
            __syncthreads();
            for (int i = tid; i < 704; i += 512) { int rel = i - 63; rel = rel < -128 ? -128 : (rel > 128 ? 128 : rel); tab[i] = P.rel_bias[h * NREL + rel + 128] * LOG2E; }
            __syncthreads();
#pragma nounroll
            for (int i = 0; i < 8; ++i) {
                const int c = i * 4 + (wave >> 1), half = wave & 1, j0 = c < 8 ? 8 - c : 0, kstart = (c - 8 + j0) * 64;
                const size_t qrow = (size_t)b * SEQ + c * 64 + half * 32;
#ifndef NO_ATT5
                attn_wave32<64, true, 2, true, true>(Z + qrow * DIN + h * 64, DIN, KF + ((size_t)(b * 16 + h) * SEQ + kstart) * 64, 0,
                                      VT + ((size_t)(b * 16 + h) * SEQ + kstart) * 64, 0, Y + qrow * DM + h * 64, DM, 9 - j0, 0.125f * LOG2E, tab, half * 32 + (8 - j0) * 64, lane);
#endif
            }
        }
        __syncthreads();
    }
    xcd_barrier(xbar);
    if (G >= 128 && bx < 64) {
        RUN_GEMM_ON(pg8::EpiBf<128>, BATCH * NMEM, 2 * DCROSS, (pg8::Gemm{MEMN, Wckv, DM, DM, DM, 0}), (pg8::EpiBf<128>{KC, DCROSS, 0, nullptr, nullptr, 2, 4, NMEM, DCROSS, VCT, 0, 2, KC}), 64, bx);
    } else if (G >= 128) {
        RUN_GEMM_ON(pg8::EpiBf<0>, MTOK, DPOOL, (pg8::Gemm{DP, Wp, DPOOL, 256, 256, 512}), (pg8::EpiBf<0>{Y, DM, DATT, nullptr, P.pool_scale, 0, 0, 1, 1, nullptr, 0, 0, nullptr}), G - 64, bx - 64);
    } else {
        RUN_GEMM(pg8::EpiBf<128>, BATCH * NMEM, 2 * DCROSS, (pg8::Gemm{MEMN, Wckv, DM, DM, DM, 0}), (pg8::EpiBf<128>{KC, DCROSS, 0, nullptr, nullptr, 2, 4, NMEM, DCROSS, VCT, 0, 2, KC}));
        RUN_GEMM(pg8::EpiBf<0>, MTOK, DPOOL, (pg8::Gemm{DP, Wp, DPOOL, 256, 256, 512}), (pg8::EpiBf<0>{Y, DM, DATT, nullptr, P.pool_scale, 0, 0, 1, 1, nullptr, 0, 0, nullptr}));
    }
    xcd_barrier(xbar);
    RUN_GEMM(pg8::EpiRes<false>, MTOK, DM, (pg8::Gemm{Y, Wout, DM, DM, DM, 0}), (pg8::EpiRes<false>{nullptr, HB, rowss + 2 * MTOK, 1.0f}));
    xcd_barrier(xbar);
    RUN_GEMM(pg8::EpiBf<0>, MTOK, DCROSS, (pg8::Gemm{HB, Wcq, DM, DM, DM, 0}), (pg8::EpiBf<0>{CQ, DCROSS, 0, rowss + 2 * MTOK, nullptr, 0, 0, 1, 1, nullptr, 0, 0, nullptr}));
    xcd_barrier(xbar);
    for (int rep_ = 0; rep_ < REP_XATT; ++rep_) {
        for (int it = bx; it < BATCH * 16; it += G) {
            const int b = it >> 4, sub = it & 15;
#pragma nounroll
            for (int r = 0; r < 4; ++r) {
                const int wu = r * 8 + wave, head = wu & 3, qblk = wu >> 2;
                const size_t qrow = (size_t)b * SEQ + sub * 128 + qblk * 16;
#ifndef NO_ATT9
                attn_wave32<128, false, 1, true, true, false>(CQ + qrow * DCROSS + head * 128, DCROSS, KC + (size_t)(b * 4 + head) * NMEM * 128, 0,
                                        VCT + (size_t)(b * 4 + head) * NMEM * 128, 0, CO + qrow * DCROSS + head * 128, DCROSS, 4, 0.08838834764831845f * LOG2E, nullptr, 0, lane);
#endif
            }
        }
    }
    xcd_barrier(xbar);
    RUN_GEMM(pg8::EpiRes<false>, MTOK, DM, (pg8::Gemm{CO, Wco, DCROSS, DCROSS, DCROSS, 0}), (pg8::EpiRes<false>{nullptr, HB, rowss + 3 * MTOK, 1.0f}));
    xcd_barrier(xbar);
    RUN_GEMM(pg8::EpiSwiglu, MTOK, 2 * DFF, (pg8::Gemm{HB, Wgu2, DM, DM, DM, 0}), (pg8::EpiSwiglu{ACT, DFF, rowss + 3 * MTOK}));
    xcd_barrier(xbar);
    RUN_GEMM_NT(pg8::EpiRes<false>, MTOK, DM, (pg8::Gemm{ACT, Wd2, DFF, DFF, DFF, 0}), (pg8::EpiRes<false>{nullptr, HB, rowss + 4 * MTOK, 0.5f}));
    xcd_barrier(xbar);
    {
        const float* rs4 = rowss + 4 * MTOK;
        for (int m = gw; m < MTOK; m += NGW) {
            const u32x2* hr = (const u32x2*)(HB + (size_t)m * DM) + lane; f32x4* xr = (f32x4*)(P.out + (size_t)m * DM) + lane; const f32x4* gr = (const f32x4*)P.final_norm + lane;
            const float rs = __builtin_amdgcn_rsqf(rs4[m] * (1.0f / DM) + EPS);
#pragma unroll
            for (int j = 0; j < 8; ++j) { const u32x2 q = hr[64 * j]; const f32x4 v = (f32x4){bf_lo(q.x), bf_hi(q.x), bf_lo(q.y), bf_hi(q.y)}; xr[64 * j] = v * rs * gr[64 * j]; }
        }
    }
#undef RUN_GEMM
#undef RUN_GEMM_ON
#undef RUN_GEMM_NT
}

extern "C" void kernel_launch(void* const* d_in, const int* in_sizes, int n_in, void* d_out, int out_size, void* d_ws, size_t ws_size, hipStream_t stream) {
    static int grid_blocks = 0;
    if (grid_blocks == 0) {
        if (n_in != 22 || in_sizes[0] != MTOK * DM || out_size != MTOK * DM || ws_size < WS_END) {
            fprintf(stderr, "kernel_launch: unexpected shapes (n_in %d, in0 %d, out %d, ws %zu)\n", n_in, n_in > 0 ? in_sizes[0] : -1, out_size, ws_size); grid_blocks = -1; return; }
        int dev = 0, cus = 0, per_cu = 0;
        hipGetDevice(&dev);
        hipDeviceGetAttribute(&cus, hipDeviceAttributeMultiprocessorCount, dev);
        if (hipFuncSetAttribute((const void*)fwd_megakernel, hipFuncAttributeMaxDynamicSharedMemorySize, LDS_BYTES) != hipSuccess) { fprintf(stderr, "kernel_launch: hipFuncSetAttribute failed\n"); grid_blocks = -1; return; }
        if (hipOccupancyMaxActiveBlocksPerMultiprocessor(&per_cu, (const void*)fwd_megakernel, 512, LDS_BYTES) != hipSuccess || per_cu < 1) { fprintf(stderr, "kernel_launch: occupancy query gave %d\n", per_cu); per_cu = 1; }
        (void)hipGetLastError();
        grid_blocks = cus * per_cu;
    }
    if (grid_blocks < 0) return;
    Params p{};
    const float* const* in = (const float* const*)d_in;
    p.x = in[0]; p.mem = in[1]; p.ffn1_norm = in[2]; p.ffn1_wg = in[3]; p.ffn1_wu = in[4]; p.ffn1_wd = in[5]; p.mix_norm = in[6]; p.w_in = in[7]; p.rel_bias = in[8];
    p.w_pool = in[9]; p.pool_scale = in[10]; p.w_out = in[11]; p.cross_norm = in[12]; p.mem_norm = in[13]; p.w_cq = in[14]; p.w_ckv = in[15]; p.w_co = in[16];
    p.ffn2_norm = in[17]; p.ffn2_wg = in[18]; p.ffn2_wu = in[19]; p.ffn2_wd = in[20]; p.final_norm = in[21];
    p.out = (float*)d_out; p.ws = (unsigned char*)d_ws;
    if (hipMemsetAsync((char*)d_ws + WS_BAR, 0, WS_BAR_BYTES, stream) != hipSuccess) { fprintf(stderr, "kernel_launch: memset of the barrier words failed\n"); return; }
    void* args[] = {&p};
    hipError_t e = hipLaunchCooperativeKernel((const void*)fwd_megakernel, dim3(grid_blocks), dim3(512), args, LDS_BYTES, stream);
    if (e != hipSuccess) fprintf(stderr, "cooperative launch failed: %s (grid %d)\n", hipGetErrorString(e), grid_blocks);
}
```

```cpp
#include <hip/hip_runtime.h>
#include <hip/hip_cooperative_groups.h>
#include <cstdio>
#include <cstdint>
namespace cg = cooperative_groups;

#define LAS __attribute__((address_space(3)))
typedef unsigned short bf16_t;
typedef short bf16x8 __attribute__((ext_vector_type(8)));
typedef float f32x4 __attribute__((ext_vector_type(4)));
typedef float f32x2 __attribute__((ext_vector_type(2)));
typedef unsigned u32x4 __attribute__((ext_vector_type(4)));
typedef unsigned u32x2 __attribute__((ext_vector_type(2)));

constexpr int BATCH = 16, SEQ = 2048, DM = 2048, MTOK = BATCH * SEQ;
constexpr int DFF = 5632, DIN = 4096, DATT = 1024, DPOOL = 1024, NMEM = 256, DCROSS = 512;
constexpr int NREL = 257;
constexpr float EPS = 1e-6f;
constexpr float LOG2E = 1.4426950408889634f;

constexpr size_t MiB = 1u << 20;
constexpr size_t WS_ROWSS = 0;
constexpr size_t WS_BAR = 896 * 1024, WS_BAR_BYTES = 16384;
constexpr size_t WS_WGU1 = 1 * MiB, WS_WD1 = 45 * MiB, WS_WIN = 67 * MiB, WS_WP = 83 * MiB, WS_WOUT = 84 * MiB, WS_WCQ = 92 * MiB,
                 WS_WCKV = 94 * MiB, WS_WCO = 98 * MiB, WS_WGU2 = 100 * MiB, WS_WD2 = 144 * MiB;
constexpr size_t WS_HB = 166 * MiB;
constexpr size_t WS_ACT = 294 * MiB;
constexpr size_t WS_Z = 294 * MiB;
constexpr size_t WS_VT = 550 * MiB;
constexpr size_t WS_Y = 646 * MiB;
constexpr size_t WS_CQ = 646 * MiB, WS_CO = 678 * MiB;
constexpr size_t WS_DP = 774 * MiB;
constexpr size_t WS_MEMN = 838 * MiB;
constexpr size_t WS_KC = 854 * MiB;
constexpr size_t WS_VCT = 858 * MiB;
constexpr size_t WS_KF = 862 * MiB;
constexpr size_t WS_END = 926 * MiB;

#ifndef REP_G1NULL
#define REP_G1NULL 0
#endif
#ifndef REP_SYNC
#define REP_SYNC 0
#endif
#ifndef REP_G2
#define REP_G2 0
#endif
#ifndef REP_G2NULL
#define REP_G2NULL 0
#endif
#ifndef REP_ATTC
#define REP_ATTC 0
#endif
#ifndef REP_XATT
#define REP_XATT 1
#endif
#ifndef REP_P0
#define REP_P0 1
#endif
#ifndef REP_G1
#define REP_G1 1
#endif
#ifndef REP_ATT
#define REP_ATT 1
#endif
#ifndef REP_G3
#define REP_G3 1
#endif
constexpr int LDS_BYTES = 147456;

__device__ __forceinline__ unsigned cvt_pk_bf16(float lo, float hi) { unsigned r; asm volatile("v_cvt_pk_bf16_f32 %0, %1, %2" : "=v"(r) : "v"(lo), "v"(hi)); return r; }
__device__ __forceinline__ float bf_lo(unsigned w) { return __uint_as_float(w << 16); }
__device__ __forceinline__ float bf_hi(unsigned w) { return __uint_as_float(w & 0xffff0000u); }
__device__ __forceinline__ float wave_sum(float v) {
#pragma unroll
    for (int o = 1; o < 64; o <<= 1) v += __shfl_xor(v, o);
    return v;
}

namespace pg8 {
constexpr int BM = 256, BK = 64, HALF = 128, HTB = HALF * BK * 2, STAGE_BYTES = 8 * HTB, NXCD = 8;
__host__ __device__ __forceinline__ int lds_byte(int r, int c) { const int st = (r >> 4) * 2 + (c >> 5), rr = r & 15, cc = c & 31, ob = rr * 64 + cc * 2; return st * 1024 + (ob ^ (((ob >> 9) & 1) << 5)); }
__host__ __device__ __forceinline__ void stage_rc(int b, int& R, int& C) { const int st = b / 1024, sb = b % 1024, swz = sb ^ (((sb >> 9) & 1) << 5); R = (st >> 1) * 16 + swz / 64; C = (st & 1) * 32 + (swz % 64) / 2; }
__host__ __device__ __forceinline__ int perm32(int rho) { const int n = rho >> 4, i = rho & 15; return 8 * (i >> 2) + 4 * n + (i & 3); }

struct Unit { int pm, pn; };
struct Gemm { const bf16_t* A; const bf16_t* Bt; int lda, ldb, K, a_pn_step; size_t kblkA = 256, kblkB = 256; };

struct StaticOrder {
    int nM, nN, nwg, G, c, WGM, rev;
    __device__ void init(int M, int N, int G_, int c_, int wgm = 8, int rev_ = 0) { nM = M / BM; nN = N / BM; nwg = nM * nN; G = G_; c = c_; WGM = wgm; rev = rev_; }
    __device__ bool next(int i, Unit& u) const {
        const int nr = (nwg + G - 1) / G; if (i >= nr) return false;
        long L = (long)(rev ? nr - 1 - i : i) * G + c;
        if (L >= nwg) { if (!rev) return false; L = (long)(nr - 2 - i) * G + c; if (i + 1 >= nr) return false; }
        int wgid = (int)L; { const int q = nwg / NXCD, r = nwg % NXCD, xcd = wgid % NXCD, off = wgid / NXCD; wgid = (xcd < r ? xcd * (q + 1) : r * (q + 1) + (xcd - r) * q) + off; }
        const int nig = WGM * nN, gid = wgid / nig, fm = gid * WGM, gsz = (nM - fm) < WGM ? (nM - fm) : WGM;
        u.pm = fm + ((wgid % nig) % gsz); u.pn = (wgid % nig) / gsz; return true;
    }
};

template <int FMD> struct EpiBf {
    bf16_t* O; int ldc; int col_off; const float* rowss; const float* colscale; int t_lo, t_hi, t_rows, t_cols; bf16_t* VT; int k_lo, k_hi; bf16_t* KF;
    __device__ __forceinline__ void operator()(const f32x4 (&acc)[2][2][4][2], const Unit& u, int wr, int wc, int fr, int fq) const {
        const int row0 = u.pm * BM + wr * 64 + fr, cl = wc * 32 + 8 * fq;
        const bool tr = (u.pn >= t_lo) && (u.pn < t_hi);
        constexpr bool FM = FMD != 0;
        constexpr int FDH = FM ? FMD : 64, FKS = FDH / 32, FROWS = (FMD == 128) ? NMEM : SEQ, FNH = (FMD == 128) ? 4 : 16, FTPB = FROWS / 64;
        const bool kfm = FM && (u.pn >= k_lo) && (u.pn < k_hi);
        f32x4 cs[2][2]; float rsv[8];
#pragma unroll
        for (int bj = 0; bj < 2; ++bj)
#pragma unroll
            for (int n = 0; n < 2; ++n) cs[bj][n] = colscale ? *(const f32x4*)(colscale + u.pn * BM + bj * HALF + cl + 4 * n) : (f32x4){1.f, 1.f, 1.f, 1.f};
#pragma unroll
        for (int i = 0; i < 8; ++i) rsv[i] = rowss ? rowss[row0 + (i >> 2) * HALF + (i & 3) * 16] : 0.f;
        asm volatile("" ::: "memory");
#pragma unroll
        for (int ai = 0; ai < 2; ++ai)
#pragma unroll
            for (int m = 0; m < 4; ++m) {
                const int row = row0 + ai * HALF + m * 16;
                const float rsc = rowss ? __builtin_amdgcn_rsqf(rsv[ai * 4 + m] * (1.0f / DM) + EPS) : 1.0f;
#pragma unroll
                for (int bj = 0; bj < 2; ++bj) {
                    const f32x4 v0 = acc[ai][bj][m][0] * rsc * cs[bj][0], v1 = acc[ai][bj][m][1] * rsc * cs[bj][1];
                    u32x4 w; w.x = cvt_pk_bf16(v0[0], v0[1]); w.y = cvt_pk_bf16(v0[2], v0[3]); w.z = cvt_pk_bf16(v1[0], v1[1]); w.w = cvt_pk_bf16(v1[2], v1[3]);
                    if (FM && (kfm || tr)) {
                        const int c = (u.pn - (kfm ? k_lo : t_lo)) * BM + bj * HALF + cl, hh = c / FDH, d = c % FDH;
                        const int bb = row / FROWS, s = row % FROWS, tile = s >> 6, k = s & 63;
                        const size_t tbase = ((size_t)((bb * FNH + hh) * FTPB + tile)) * (64 * FDH);
                        if (kfm) {
                            const int kb = k >> 5, r = k & 31, mt = kb * 2 + ((r >> 2) & 1), fra = (r >> 3) * 4 + (r & 3), ks = d >> 5, fqa = (d >> 3) & 3;
                            *(u32x4*)(KF + tbase + ((mt * FKS + ks) * 64 + fqa * 16 + fra) * 8) = w;
                        } else {
                            const int dt = d >> 4, fra0 = d & 15, kb = k >> 5, fqa = (k & 31) >> 3, e8 = k & 7;
                            bf16_t* p = VT + tbase + ((dt * 2 + kb) * 64 + fqa * 16 + fra0) * 8 + e8;
                            p[0] = (bf16_t)(w.x & 0xffffu); p[8] = (bf16_t)(w.x >> 16); p[16] = (bf16_t)(w.y & 0xffffu); p[24] = (bf16_t)(w.y >> 16);
                            p[32] = (bf16_t)(w.z & 0xffffu); p[40] = (bf16_t)(w.z >> 16); p[48] = (bf16_t)(w.w & 0xffffu); p[56] = (bf16_t)(w.w >> 16);
                        }
                    } else if (!tr) { *(u32x4*)(O + (size_t)row * ldc + col_off + u.pn * BM + bj * HALF + cl) = w; }
                    else {
                        const int cv = (u.pn - t_lo) * BM + bj * HALF + cl, b = row / t_rows, s = row - b * t_rows;
                        bf16_t* p = VT + ((size_t)b * t_cols + cv) * t_rows + s;
                        p[0] = (bf16_t)(w.x & 0xffffu); p[(size_t)t_rows] = (bf16_t)(w.x >> 16); p[(size_t)2 * t_rows] = (bf16_t)(w.y & 0xffffu); p[(size_t)3 * t_rows] = (bf16_t)(w.y >> 16);
                        p[(size_t)4 * t_rows] = (bf16_t)(w.z & 0xffffu); p[(size_t)5 * t_rows] = (bf16_t)(w.z >> 16); p[(size_t)6 * t_rows] = (bf16_t)(w.w & 0xffffu); p[(size_t)7 * t_rows] = (bf16_t)(w.w >> 16);
                    }
                }
            }
    }
};
__device__ __forceinline__ float silu_mul(float g, float u) { return g * __builtin_amdgcn_rcpf(1.0f + __expf(-g)) * u; }
struct EpiSwiglu {
    bf16_t* O; int ldc; const float* rowss;
    __device__ __forceinline__ void operator()(const f32x4 (&acc)[2][2][4][2], const Unit& u, int wr, int wc, int fr, int fq) const {
        const int row0 = u.pm * BM + wr * 64 + fr, cl = wc * 32 + 8 * fq;
        float rsv[8];
#pragma unroll
        for (int i = 0; i < 8; ++i) rsv[i] = rowss[row0 + (i >> 2) * HALF + (i & 3) * 16];
        asm volatile("" ::: "memory");
#pragma unroll
        for (int ai = 0; ai < 2; ++ai)
#pragma unroll
            for (int m = 0; m < 4; ++m) {
                const int row = row0 + ai * HALF + m * 16;
                const float rsc = __builtin_amdgcn_rsqf(rsv[ai * 4 + m] * (1.0f / DM) + EPS);
                const f32x4 g0 = acc[ai][0][m][0] * rsc, g1 = acc[ai][0][m][1] * rsc, u0 = acc[ai][1][m][0] * rsc, u1 = acc[ai][1][m][1] * rsc;
                u32x4 w;
                w.x = cvt_pk_bf16(silu_mul(g0[0], u0[0]), silu_mul(g0[1], u0[1])); w.y = cvt_pk_bf16(silu_mul(g0[2], u0[2]), silu_mul(g0[3], u0[3]));
                w.z = cvt_pk_bf16(silu_mul(g1[0], u1[0]), silu_mul(g1[1], u1[1])); w.w = cvt_pk_bf16(silu_mul(g1[2], u1[2]), silu_mul(g1[3], u1[3]));
                *(u32x4*)(O + (size_t)row * ldc + u.pn * HALF + cl) = w;
            }
    }
};
template <bool F32IN> struct EpiRes {
    const float* hin_f; bf16_t* hb; float* rowss_out; float alpha;
    static constexpr int DEPTH = F32IN ? 2 : 4, NV = F32IN ? 4 : 2;
    __device__ __forceinline__ void ld(f32x4 (&hv)[4], size_t off) const {
        if (F32IN) { hv[0] = *(const f32x4*)(hin_f + off); hv[1] = *(const f32x4*)(hin_f + off + 4); hv[2] = *(const f32x4*)(hin_f + off + HALF); hv[3] = *(const f32x4*)(hin_f + off + HALF + 4); }
        else { hv[0] = __builtin_bit_cast(f32x4, *(const u32x4*)(hb + off)); hv[1] = __builtin_bit_cast(f32x4, *(const u32x4*)(hb + off + HALF)); }
    }
    __device__ __forceinline__ void operator()(const f32x4 (&acc)[2][2][4][2], const Unit& u, int wr, int wc, int fr, int fq) const {
        const int row0 = u.pm * BM + wr * 64 + fr, cl = u.pn * BM + wc * 32 + 8 * fq;
        f32x4 hv[DEPTH][4];
#pragma unroll
        for (int gi = 0; gi < DEPTH; ++gi) ld(hv[gi], (size_t)(row0 + (gi >> 2) * HALF + (gi & 3) * 16) * DM + cl);
#pragma unroll
        for (int gi = 0; gi < 8; ++gi) {
            const int ai = gi >> 2, m = gi & 3, cb = gi % DEPTH;
            asm volatile("" ::: "memory");
            const int row = row0 + ai * HALF + m * 16; const size_t off = (size_t)row * DM + cl;
            float ss = 0.f;
            u32x4 wv[2];
#pragma unroll
            for (int bj = 0; bj < 2; ++bj) {
                f32x4 o0, o1;
                if (F32IN) { o0 = hv[cb][2 * bj]; o1 = hv[cb][2 * bj + 1]; }
                else { const u32x4 q = __builtin_bit_cast(u32x4, hv[cb][bj]); o0 = (f32x4){bf_lo(q.x), bf_hi(q.x), bf_lo(q.y), bf_hi(q.y)}; o1 = (f32x4){bf_lo(q.z), bf_hi(q.z), bf_lo(q.w), bf_hi(q.w)}; }
                const f32x4 h0 = o0 + acc[ai][bj][m][0] * alpha, h1 = o1 + acc[ai][bj][m][1] * alpha;
                ss += (h0[0] * h0[0] + h0[1] * h0[1]) + (h0[2] * h0[2] + h0[3] * h0[3]) + (h1[0] * h1[0] + h1[1] * h1[1]) + (h1[2] * h1[2] + h1[3] * h1[3]);
                wv[bj].x = cvt_pk_bf16(h0[0], h0[1]); wv[bj].y = cvt_pk_bf16(h0[2], h0[3]); wv[bj].z = cvt_pk_bf16(h1[0], h1[1]); wv[bj].w = cvt_pk_bf16(h1[2], h1[3]);
            }
            if (gi + DEPTH < 8) ld(hv[cb], (size_t)(row0 + ((gi + DEPTH) >> 2) * HALF + ((gi + DEPTH) & 3) * 16) * DM + cl);
            *(u32x4*)(hb + off) = wv[0]; *(u32x4*)(hb + off + HALF) = wv[1];
            ss += __shfl_xor(ss, 16); ss += __shfl_xor(ss, 32);
            if (rowss_out && fq == 0) __hip_atomic_fetch_add(rowss_out + row, ss, __ATOMIC_RELAXED, __HIP_MEMORY_SCOPE_AGENT);
        }
    }
};

struct EpiNull {
    __device__ __forceinline__ void operator()(const f32x4 (&acc)[2][2][4][2], const Unit& u, int wr, int wc, int fr, int fq) const {
#pragma unroll
        for (int ai = 0; ai < 2; ++ai)
#pragma unroll
            for (int bj = 0; bj < 2; ++bj)
#pragma unroll
                for (int m = 0; m < 4; ++m) asm volatile("" :: "v"(acc[ai][bj][m][0]), "v"(acc[ai][bj][m][1]));
    }
};

template <class Epi, bool ALIGN_EPI = true, int AUX_A = 0>
__device__ __forceinline__ void gemm_phase(LAS unsigned char* lds, const Gemm g, const StaticOrder& S, const Epi& E) {
    int tid_l = threadIdx.x; asm volatile("" : "+v"(tid_l));
    const int tid = tid_l, wid = __builtin_amdgcn_readfirstlane(tid >> 6), lane = tid & 63, wr = wid >> 2, wc = wid & 3, fr = lane & 15, fq = lane >> 4;
    const int K = g.K, nt = K / BK;
    unsigned voffA[2], voffB[2];
#pragma unroll
    for (int i = 0; i < 2; ++i) { int R, C; stage_rc(tid * 16 + i * 8192, R, C); const int Rb = (R & ~31) + perm32(R & 31);
        voffA[i] = (unsigned)(R * g.lda + C) * 2u; voffB[i] = (unsigned)(Rb * g.ldb + C) * 2u; }
    const size_t kstep = (size_t)(BK * 2);
    const size_t hstepA = (size_t)HALF * g.lda * 2, hstepB = (size_t)HALF * g.ldb * 2;
    const size_t tstepA = 2 * hstepA, tstepB = 2 * hstepB;
    const unsigned ldsw = (unsigned)wid * 1024u;
    const int aoff = lds_byte(wr * 64 + fr, fq * 8), boff = lds_byte(wc * 32 + fr, fq * 8);
#define PG8_SA(b, h) (((b) * 2 + (h)) * HTB)
#define PG8_SB(b, h) ((4 + (b) * 2 + (h)) * HTB)
#define PG8_STAGE_X(bufoff, gbase, voff, aux) do { _Pragma("unroll") for (int _i = 0; _i < 2; ++_i) \
        __builtin_amdgcn_global_load_lds((const unsigned*)((const char*)(gbase) + (voff)[_i]), (LAS unsigned*)(lds + (bufoff) + ldsw + _i * 8192), 16, 0, aux); } while (0)
#define PG8_STAGE(bufoff, gbase, voff) PG8_STAGE_X(bufoff, gbase, voff, 0)
#define PG8_LDA(dst, b, h) do { _Pragma("unroll") for (int m = 0; m < 4; ++m) _Pragma("unroll") for (int k = 0; k < 2; ++k) dst[m][k] = *(const LAS bf16x8*)(lds + PG8_SA(b, h) + aoff + m * 2048 + k * 1024); } while (0)
#define PG8_LDB(dst, b, h) do { _Pragma("unroll") for (int n = 0; n < 2; ++n) _Pragma("unroll") for (int k = 0; k < 2; ++k) dst[n][k] = *(const LAS bf16x8*)(lds + PG8_SB(b, h) + boff + n * 2048 + k * 1024); } while (0)
#define PG8_MMA(ai, bj, At, Bt) do { __builtin_amdgcn_s_setprio(1); _Pragma("unroll") for (int m = 0; m < 4; ++m) _Pragma("unroll") for (int n = 0; n < 2; ++n) _Pragma("unroll") for (int k = 0; k < 2; ++k) \
        acc[ai][bj][m][n] = __builtin_amdgcn_mfma_f32_16x16x32_bf16(Bt[n][k], At[m][k], acc[ai][bj][m][n], 0, 0, 0); __builtin_amdgcn_s_setprio(0); } while (0)
#define PG8_WAIT_V(n) asm volatile("s_waitcnt vmcnt(" #n ")" ::: "memory")
#define PG8_WAIT_L(n) asm volatile("s_waitcnt lgkmcnt(" #n ")" ::: "memory")
#define PG8_BAR __builtin_amdgcn_s_barrier()
#define PG8_SCHED __builtin_amdgcn_sched_barrier(0)
    Unit cur, nxt; int ui = 0;
    if (!S.next(0, cur)) return;
    f32x4 acc[2][2][4][2];
#pragma unroll
    for (int a = 0; a < 2; ++a)
#pragma unroll
        for (int b = 0; b < 2; ++b)
#pragma unroll
            for (int m = 0; m < 4; ++m)
#pragma unroll
                for (int n = 0; n < 2; ++n) acc[a][b][m][n] = (f32x4){0.f, 0.f, 0.f, 0.f};
    bf16x8 At[4][2], B0[2][2], B1[2][2];
    const char* cA = (const char*)g.A + (size_t)cur.pm * tstepA + (size_t)cur.pn * g.a_pn_step; const char* cB = (const char*)g.Bt + (size_t)cur.pn * tstepB;
    PG8_STAGE(PG8_SB(0, 0), cB, voffB); PG8_STAGE(PG8_SB(0, 1), cB + hstepB, voffB); PG8_STAGE_X(PG8_SA(0, 0), cA, voffA, AUX_A); PG8_STAGE_X(PG8_SA(0, 1), cA + hstepA, voffA, AUX_A);
    if (wr == 1) PG8_BAR;
    PG8_WAIT_V(2); PG8_BAR;
    PG8_STAGE(PG8_SB(1, 0), cB + kstep, voffB); PG8_STAGE_X(PG8_SA(1, 0), cA + kstep, voffA, AUX_A); PG8_STAGE(PG8_SB(1, 1), cB + hstepB + kstep, voffB);
    PG8_WAIT_V(6); PG8_BAR;
    for (;;) {
        const bool has_next = S.next(ui + 1, nxt);
        const char* nA = has_next ? (const char*)g.A + (size_t)nxt.pm * tstepA + (size_t)nxt.pn * g.a_pn_step : cA; const char* nB = has_next ? (const char*)g.Bt + (size_t)nxt.pn * tstepB : cB;
        for (int t = 0; t < nt; t += 2) {
            const bool last = (t == nt - 2);
            const size_t kbi = (size_t)(t >> 1);
            const char* a1 = cA + kbi * g.kblkA + kstep;
            const char* a2 = last ? nA : cA + (kbi + 1) * g.kblkA; const char* b2 = last ? nB : cB + (kbi + 1) * g.kblkB;
            const char* a3 = a2 + kstep; const char* b3 = b2 + kstep;
            PG8_LDB(B0, 0, 0); PG8_LDB(B1, 0, 1); PG8_SCHED; PG8_LDA(At, 0, 0); PG8_STAGE_X(PG8_SA(1, 1), a1 + hstepA, voffA, AUX_A);
            PG8_WAIT_V(8); PG8_WAIT_L(0); PG8_BAR; PG8_MMA(0, 0, At, B0); PG8_MMA(0, 1, At, B1); PG8_BAR; PG8_SCHED;
            PG8_LDA(At, 0, 1); PG8_STAGE(PG8_SB(0, 0), b2, voffB); PG8_STAGE(PG8_SB(0, 1), b2 + hstepB, voffB); PG8_STAGE_X(PG8_SA(0, 0), a2, voffA, AUX_A);
            PG8_WAIT_V(8); PG8_WAIT_L(0); PG8_BAR; PG8_MMA(1, 0, At, B0); PG8_MMA(1, 1, At, B1); PG8_BAR; PG8_SCHED;
            PG8_LDB(B0, 1, 0); PG8_LDB(B1, 1, 1); PG8_SCHED; PG8_LDA(At, 1, 0); PG8_STAGE_X(PG8_SA(0, 1), a2 + hstepA, voffA, AUX_A);
            PG8_WAIT_V(8); PG8_WAIT_L(0); PG8_BAR; PG8_MMA(0, 0, At, B0); PG8_MMA(0, 1, At, B1); PG8_BAR; PG8_SCHED;
            PG8_LDA(At, 1, 1); PG8_STAGE(PG8_SB(1, 0), b3, voffB); PG8_STAGE(PG8_SB(1, 1), b3 + hstepB, voffB); PG8_STAGE_X(PG8_SA(1, 0), a3, voffA, AUX_A);
            PG8_WAIT_V(8); PG8_WAIT_L(0); PG8_BAR; PG8_MMA(1, 0, At, B0); PG8_MMA(1, 1, At, B1); PG8_BAR; PG8_SCHED;
        }
        if constexpr (ALIGN_EPI) { if (wr == 0) PG8_BAR; }
        E(acc, cur, wr, wc, fr, fq);
        if (!has_next) break;
#pragma unroll
        for (int a = 0; a < 2; ++a)
#pragma unroll
            for (int b = 0; b < 2; ++b)
#pragma unroll
                for (int m = 0; m < 4; ++m)
#pragma unroll
                    for (int n = 0; n < 2; ++n) acc[a][b][m][n] = (f32x4){0.f, 0.f, 0.f, 0.f};
        cur = nxt; cA = nA; cB = nB; ++ui;
        if constexpr (ALIGN_EPI) { if (wr == 1) PG8_BAR; }
    }
    PG8_WAIT_V(0);
    if constexpr (!ALIGN_EPI) { if (wr == 0) PG8_BAR; }
    PG8_BAR;
#undef PG8_SA
#undef PG8_SB
#undef PG8_STAGE
#undef PG8_STAGE_X
#undef PG8_LDA
#undef PG8_LDB
#undef PG8_MMA
#undef PG8_WAIT_V
#undef PG8_WAIT_L
#undef PG8_BAR
#undef PG8_SCHED
}
}

template <int DH, bool BIAS, int NT, bool PF, bool COAL = false, bool VDB = true>
__device__ __forceinline__ void attn_wave32(const bf16_t* __restrict__ Qp, int ldq, const bf16_t* __restrict__ Kp, int ldk, const bf16_t* __restrict__ Vp, int ldv,
                                            bf16_t* __restrict__ Op, int ldo, int ntiles, float sc, const LAS float* tab, int rel_base, int lane) {
    constexpr int KS = DH / 32, DT = DH / 16;
    asm volatile("" : "+v"(lane));
    const int fr = lane & 15, fq = lane >> 4;
    bf16x8 qf[NT][KS];
#pragma unroll
    for (int nt = 0; nt < NT; ++nt)
#pragma unroll
        for (int ks = 0; ks < KS; ++ks) qf[nt][ks] = *(const bf16x8*)(Qp + (size_t)(nt * 16 + fr) * ldq + ks * 32 + fq * 8);
    f32x4 o[DT][NT];
#pragma unroll
    for (int dt = 0; dt < DT; ++dt)
#pragma unroll
        for (int nt = 0; nt < NT; ++nt) o[dt][nt] = (f32x4){0.f, 0.f, 0.f, 0.f};
    float mrun[NT], lrun[NT];
#pragma unroll
    for (int nt = 0; nt < NT; ++nt) { mrun[nt] = -1e30f; lrun[nt] = 0.f; }
    const bf16_t* kbase = Kp + (size_t)(8 * (fr >> 2) + (fr & 3)) * ldk + fq * 8;
    const bf16_t* vbase = Vp + (size_t)fr * ldv + fq * 8;
    bf16x8 kf[4][KS], vfA[DT][2], vfB[DT][2];
#define ATT_LOADK(tt) do { _Pragma("unroll") for (int mt = 0; mt < 4; ++mt) _Pragma("unroll") for (int ks = 0; ks < KS; ++ks) \
        kf[mt][ks] = COAL ? *(const bf16x8*)(Kp + (size_t)(tt) * (64 * DH) + (mt * KS + ks) * 512 + lane * 8) \
                          : *(const bf16x8*)(kbase + (size_t)((tt) * 64 + (mt >> 1) * 32 + 4 * (mt & 1)) * ldk + ks * 32); } while (0)
#define ATT_LOADV(dst, tt) do { _Pragma("unroll") for (int dt = 0; dt < DT; ++dt) _Pragma("unroll") for (int kb = 0; kb < 2; ++kb) \
        dst[dt][kb] = COAL ? *(const bf16x8*)(Vp + (size_t)(tt) * (64 * DH) + (dt * 2 + kb) * 512 + lane * 8) \
                           : *(const bf16x8*)(vbase + (size_t)(dt * 16) * ldv + (tt) * 64 + kb * 32); } while (0)
#define ATT_BODY(t, vcur, vnext) do { \
        const int tn_ = ((t) + 1 < ntiles) ? (t) + 1 : (t); \
        if (PF && VDB) ATT_LOADV(vnext, tn_); else if (PF) ATT_LOADV(vcur, t); else ATT_LOADK(t); \
        f32x4 s[4][NT]; \
        _Pragma("unroll") for (int mt = 0; mt < 4; ++mt) _Pragma("unroll") for (int nt = 0; nt < NT; ++nt) { s[mt][nt] = (f32x4){0.f, 0.f, 0.f, 0.f}; \
            _Pragma("unroll") for (int ks = 0; ks < KS; ++ks) s[mt][nt] = __builtin_amdgcn_mfma_f32_16x16x32_bf16(kf[mt][ks], qf[nt][ks], s[mt][nt], 0, 0, 0); } \
        if (PF) ATT_LOADK(tn_); \
        bf16x8 pf[NT][2]; \
          \
        const LAS float* tb_ = tab + (rel_base - 64 * (t) + fr - 8 * fq + 63 - 39); \
        _Pragma("unroll") for (int nt = 0; nt < NT; ++nt) { \
            float mloc = -1e30f; \
            _Pragma("unroll") for (int mt = 0; mt < 4; ++mt) _Pragma("unroll") for (int j = 0; j < 4; ++j) { \
                float v = s[mt][nt][j] * sc; \
                if (BIAS) v += tb_[39 + nt * 16 - ((mt >> 1) * 32 + 4 * (mt & 1) + j)]; \
                s[mt][nt][j] = v; mloc = fmaxf(mloc, v); } \
            mloc = fmaxf(mloc, __shfl_xor(mloc, 16)); mloc = fmaxf(mloc, __shfl_xor(mloc, 32)); \
            const float mnew = fmaxf(mrun[nt], mloc), alpha = __builtin_amdgcn_exp2f(mrun[nt] - mnew); \
            mrun[nt] = mnew; \
            float ls = 0.f; \
            _Pragma("unroll") for (int mt = 0; mt < 4; ++mt) _Pragma("unroll") for (int j = 0; j < 4; ++j) { const float p = __builtin_amdgcn_exp2f(s[mt][nt][j] - mnew); s[mt][nt][j] = p; ls += p; } \
            lrun[nt] = lrun[nt] * alpha + ls; \
            _Pragma("unroll") for (int dt = 0; dt < DT; ++dt) o[dt][nt] = o[dt][nt] * alpha; \
            _Pragma("unroll") for (int kb = 0; kb < 2; ++kb) { \
                u32x4 w; w.x = cvt_pk_bf16(s[2 * kb][nt][0], s[2 * kb][nt][1]); w.y = cvt_pk_bf16(s[2 * kb][nt][2], s[2 * kb][nt][3]); \
                w.z = cvt_pk_bf16(s[2 * kb + 1][nt][0], s[2 * kb + 1][nt][1]); w.w = cvt_pk_bf16(s[2 * kb + 1][nt][2], s[2 * kb + 1][nt][3]); \
                pf[nt][kb] = __builtin_bit_cast(bf16x8, w); } } \
        if (!PF) { asm volatile("" ::: "memory"); ATT_LOADV(vcur, t); } \
        _Pragma("unroll") for (int dt = 0; dt < DT; ++dt) _Pragma("unroll") for (int nt = 0; nt < NT; ++nt) _Pragma("unroll") for (int kb = 0; kb < 2; ++kb) \
            o[dt][nt] = __builtin_amdgcn_mfma_f32_16x16x32_bf16(vcur[dt][kb], pf[nt][kb], o[dt][nt], 0, 0, 0); \
    } while (0)
    if (PF && VDB) { ATT_LOADK(0); ATT_LOADV(vfA, 0);
#pragma nounroll
        for (int t = 0; t < ntiles; t += 2) {
            ATT_BODY(t, vfA, vfB);
            if (t + 1 < ntiles) ATT_BODY(t + 1, vfB, vfA);
        }
    } else if (PF) { ATT_LOADK(0);
#pragma nounroll
        for (int t = 0; t < ntiles; ++t) ATT_BODY(t, vfA, vfB);
    } else {
#pragma nounroll
        for (int t = 0; t < ntiles; ++t) ATT_BODY(t, vfA, vfB);
    }
#undef ATT_BODY
#undef ATT_LOADK
#undef ATT_LOADV
#pragma unroll
    for (int nt = 0; nt < NT; ++nt) {
        float l = lrun[nt]; l += __shfl_xor(l, 16); l += __shfl_xor(l, 32);
        const float inv = 1.0f / l;
#pragma unroll
        for (int dt = 0; dt < DT; ++dt) {
            const f32x4 v = o[dt][nt] * inv; u32x2 w; w.x = cvt_pk_bf16(v[0], v[1]); w.y = cvt_pk_bf16(v[2], v[3]);
            *(u32x2*)(Op + (size_t)(nt * 16 + fr) * ldo + dt * 16 + 4 * fq) = w;
        }
    }
}

#define XB_TMO      128
#define XB_XCNT(j)  (256  + 64 * (j))
#define XB_XSUB(j)  (1280 + 64 * (j))
#define XB_XGEN(j)  (2304 + 64 * (j))
#define XB_TOP      3328
#define XB_TOPGEN   3392
#define XCD_BAR_WORDS 3456
#define XB_SPIN_CAP (1u << 22)
__device__ __forceinline__ unsigned xb_ld(unsigned* p)              { return __hip_atomic_load(p, __ATOMIC_RELAXED, __HIP_MEMORY_SCOPE_AGENT); }
__device__ __forceinline__ unsigned xb_add(unsigned* p, unsigned v) { return __hip_atomic_fetch_add(p, v, __ATOMIC_RELAXED, __HIP_MEMORY_SCOPE_AGENT); }
__device__ __forceinline__ unsigned xb_xcc_id() { return (unsigned)__builtin_amdgcn_s_getreg((3 << 11) | 20) & 0xFu; }
#define XB_SPIN(cond, bar) do { unsigned _sp = 0; while (cond) { __builtin_amdgcn_s_sleep(1); \
    if ((++_sp & 255u) == 0u) { if (xb_ld(&(bar)[XB_TMO])) break; if (_sp > XB_SPIN_CAP) { atomicAdd(&(bar)[XB_TMO], 1u); break; } } } } while (0)
struct XcdBarrier { unsigned* bar; unsigned x; volatile LAS unsigned* st; };
__device__ __forceinline__ XcdBarrier xcd_barrier_post(unsigned* bar, volatile LAS unsigned* st) {
    XcdBarrier b; b.bar = bar; b.x = xb_xcc_id(); b.st = st;
    if (threadIdx.x == 0) (void)xb_add(&bar[XB_XCNT(b.x)], 1u);
    return b;
}
__device__ __forceinline__ void xcd_barrier_complete(unsigned* bar, unsigned x, unsigned& nloc, unsigned& nx) {
    const unsigned G = gridDim.x * gridDim.y * gridDim.z;
    unsigned sum, cnt, mine, sp = 0u;
    for (;;) {
        sum = 0u; cnt = 0u; mine = 0u;
#pragma unroll
        for (unsigned j = 0; j < 16; ++j) { const unsigned c = xb_ld(&bar[XB_XCNT(j)]); sum += c; cnt += (c > 0u) ? 1u : 0u; mine = (j == x) ? c : mine; }
        if (sum == G) break;
        __builtin_amdgcn_s_sleep(1);
        if ((++sp & 255u) == 0u) { if (xb_ld(&bar[XB_TMO])) break; if (sp > XB_SPIN_CAP) { atomicAdd(&bar[XB_TMO], 1u); break; } }
    }
    nloc = mine > 0u ? mine : 1u; nx = cnt > 0u ? cnt : 1u;
}
__device__ __forceinline__ void xcd_barrier(const XcdBarrier& b) {
    asm volatile("s_waitcnt vmcnt(0)" ::: "memory");
    __syncthreads();
    if (threadIdx.x == 0) {
        unsigned* bar = b.bar;
        __builtin_amdgcn_s_waitcnt(0);
        unsigned nloc = b.st[0], nx = b.st[1];
        if (nloc == 0u) { xcd_barrier_complete(bar, b.x, nloc, nx); b.st[0] = nloc; b.st[1] = nx; }
        const unsigned old = xb_add(&bar[XB_XSUB(b.x)], 1u);
        const unsigned gen = old / nloc;
        if (old + 1u == (gen + 1u) * nloc) {
            __builtin_amdgcn_fence(__ATOMIC_RELEASE, "agent");
            asm volatile("s_waitcnt vmcnt(0)" ::: "memory");
            const unsigned og = xb_add(&bar[XB_TOP], 1u);
            const unsigned tg = og / nx;
            if (og + 1u == (tg + 1u) * nx) xb_add(&bar[XB_TOPGEN], 1u);
            else XB_SPIN(xb_ld(&bar[XB_TOPGEN]) == tg, bar);
            __builtin_amdgcn_fence(__ATOMIC_ACQUIRE, "agent");
            xb_add(&bar[XB_XGEN(b.x)], 1u);
            asm volatile("s_waitcnt vmcnt(0)" ::: "memory");
        } else {
            XB_SPIN(xb_ld(&bar[XB_XGEN(b.x)]) == gen, bar);
            __builtin_amdgcn_fence(__ATOMIC_ACQUIRE, "agent");
            asm volatile("s_waitcnt vmcnt(0)" ::: "memory");
        }
    }
    __syncthreads();
}

struct Params {
    const float* x; const float* mem;
    const float* ffn1_norm; const float* ffn1_wg; const float* ffn1_wu; const float* ffn1_wd;
    const float* mix_norm; const float* w_in; const float* rel_bias; const float* w_pool; const float* pool_scale; const float* w_out;
    const float* cross_norm; const float* mem_norm; const float* w_cq; const float* w_ckv; const float* w_co;
    const float* ffn2_norm; const float* ffn2_wg; const float* ffn2_wu; const float* ffn2_wd; const float* final_norm;
    float* out; unsigned char* ws;
};

__device__ __forceinline__ void p0_transpose_item(const float* __restrict__ W, int K, int N, bf16_t* __restrict__ WT, int mode, int row_off, const float* __restrict__ gain, LAS float* scr, int item, int lane) {
    const int nblk = N / 32, kb = item / nblk, nb = item - kb * nblk, k0 = 64 * kb, n0 = 32 * nb;
#pragma unroll 8
    for (int i = 0; i < 32; ++i) { const int kk = 2 * i + (lane >> 5); const float gk = gain ? gain[k0 + kk] : 1.0f; scr[kk * 33 + (lane & 31)] = W[(size_t)(k0 + kk) * N + n0 + (lane & 31)] * gk; }
    asm volatile("s_waitcnt lgkmcnt(0)" ::: "memory");
    const int c = lane & 7;
    const int d0 = (mode == 0) ? (row_off + n0) : ((n0 >> 7) * 256 + (n0 & 127) + (mode == 2 ? 128 : 0));
#pragma unroll
    for (int j = 0; j < 4; ++j) { const int n = (lane >> 3) + 8 * j; const LAS float* s = scr + (8 * c) * 33 + n;
        u32x4 o; o.x = cvt_pk_bf16(s[0 * 33], s[1 * 33]); o.y = cvt_pk_bf16(s[2 * 33], s[3 * 33]); o.z = cvt_pk_bf16(s[4 * 33], s[5 * 33]); o.w = cvt_pk_bf16(s[6 * 33], s[7 * 33]);
        *(u32x4*)(WT + (size_t)(d0 + n) * K + k0 + 8 * c) = o; }
    asm volatile("s_waitcnt lgkmcnt(0)" ::: "memory");
}

#define rowss ((float*)(P.ws + WS_ROWSS))
#define Wgu1 ((bf16_t*)(P.ws + WS_WGU1))
#define Wd1 ((bf16_t*)(P.ws + WS_WD1))
#define Win ((bf16_t*)(P.ws + WS_WIN))
#define Wp ((bf16_t*)(P.ws + WS_WP))
#define Wout ((bf16_t*)(P.ws + WS_WOUT))
#define Wcq ((bf16_t*)(P.ws + WS_WCQ))
#define Wckv ((bf16_t*)(P.ws + WS_WCKV))
#define Wco ((bf16_t*)(P.ws + WS_WCO))
#define Wgu2 ((bf16_t*)(P.ws + WS_WGU2))
#define Wd2 ((bf16_t*)(P.ws + WS_WD2))
#define HB ((bf16_t*)(P.ws + WS_HB))
#define ACT ((bf16_t*)(P.ws + WS_ACT))
#define Z ((bf16_t*)(P.ws + WS_Z))
#define VT ((bf16_t*)(P.ws + WS_VT))
#define Y ((bf16_t*)(P.ws + WS_Y))
#define CQ ((bf16_t*)(P.ws + WS_CQ))
#define CO ((bf16_t*)(P.ws + WS_CO))
#define DP ((bf16_t*)(P.ws + WS_DP))
#define MEMN ((bf16_t*)(P.ws + WS_MEMN))
#define KC ((bf16_t*)(P.ws + WS_KC))
#define VCT ((bf16_t*)(P.ws + WS_VCT))
#define KF ((bf16_t*)(P.ws + WS_KF))
constexpr int I_G = (DM / 64) * (DFF / 32), I_D = (DFF / 64) * (DM / 32), I_IN = (DM / 64) * (DIN / 32), I_P = (256 / 64) * (256 / 32), I_O = (DM / 64) * (DM / 32),
              I_CQ = (DM / 64) * (DCROSS / 32), I_CKV = (DM / 64) * (2 * DCROSS / 32), I_CO = (DCROSS / 64) * (DM / 32);
constexpr int N_EARLY = 2 * I_G + I_D + I_IN + 4 * I_P + I_CKV, NITEMS = N_EARLY + 2 * I_G + I_D + I_O + I_CQ + I_CO;
#define CONVERT_ITEM(it_, lane) do { int r = (it_); \
        if (r < I_G) { p0_transpose_item(P.ffn1_wg, DM, DFF, Wgu1, 1, 0, P.ffn1_norm, scr, r, lane); break; } r -= I_G; \
        if (r < I_G) { p0_transpose_item(P.ffn1_wu, DM, DFF, Wgu1, 2, 0, P.ffn1_norm, scr, r, lane); break; } r -= I_G; \
        if (r < I_D) { p0_transpose_item(P.ffn1_wd, DFF, DM, Wd1, 0, 0, nullptr, scr, r, lane); break; } r -= I_D; \
        if (r < I_IN) { p0_transpose_item(P.w_in, DM, DIN, Win, 0, 0, P.mix_norm, scr, r, lane); break; } r -= I_IN; \
        if (r < 4 * I_P) { const int gi = r / I_P; p0_transpose_item(P.w_pool + (size_t)gi * 65536, 256, 256, Wp, 0, gi * 256, nullptr, scr, r - gi * I_P, lane); break; } r -= 4 * I_P; \
        if (r < I_CKV) { p0_transpose_item(P.w_ckv, DM, 2 * DCROSS, Wckv, 0, 0, nullptr, scr, r, lane); break; } r -= I_CKV; \
        if (r < I_G) { p0_transpose_item(P.ffn2_wg, DM, DFF, Wgu2, 1, 0, P.ffn2_norm, scr, r, lane); break; } r -= I_G; \
        if (r < I_G) { p0_transpose_item(P.ffn2_wu, DM, DFF, Wgu2, 2, 0, P.ffn2_norm, scr, r, lane); break; } r -= I_G; \
        if (r < I_D) { p0_transpose_item(P.ffn2_wd, DFF, DM, Wd2, 0, 0, nullptr, scr, r, lane); break; } r -= I_D; \
        if (r < I_O) { p0_transpose_item(P.w_out, DM, DM, Wout, 0, 0, nullptr, scr, r, lane); break; } r -= I_O; \
        if (r < I_CQ) { p0_transpose_item(P.w_cq, DM, DCROSS, Wcq, 0, 0, P.cross_norm, scr, r, lane); break; } r -= I_CQ; \
        p0_transpose_item(P.w_co, DCROSS, DM, Wco, 0, 0, nullptr, scr, r, lane); } while (0)
__global__ void __launch_bounds__(512, 2) fwd_megakernel(Params P) {
    extern __shared__ __attribute__((aligned(16))) unsigned char lds_raw[];
    cg::grid_group grid = cg::this_grid();
    LAS unsigned char* lds = (LAS unsigned char*)lds_raw;
    const int tid = threadIdx.x, lane = tid & 63, wave = __builtin_amdgcn_readfirstlane(tid >> 6);
    const int G = gridDim.x, bx = blockIdx.x;
    const int gw = bx * 8 + wave, NGW = G * 8;
    volatile LAS unsigned* bst = (volatile LAS unsigned*)(lds + 131072 + 64);
    if (tid < 2) bst[tid] = 0u;
    __syncthreads();
    const XcdBarrier xbar = xcd_barrier_post((unsigned*)(P.ws + WS_BAR), bst);
#ifndef WGM_RES
#define WGM_RES 8
#endif
#ifndef REV_DOWN
#define REV_DOWN 1
#endif
#define RUN_GEMM_ON(EPI, gM, gN, gdesc, edesc, G_, c_) do { pg8::StaticOrder S_; S_.init((gM), (gN), (G_), (c_), ((gN) == DM) ? WGM_RES : 8); pg8::gemm_phase<EPI>(lds, (gdesc), S_, (edesc)); } while (0)
#define RUN_GEMM(EPI, gM, gN, gdesc, edesc) RUN_GEMM_ON(EPI, gM, gN, gdesc, edesc, G, bx)
#ifndef AUX_DOWN
#define AUX_DOWN 0
#endif
#define RUN_GEMM_NT(EPI, gM, gN, gdesc, edesc) do { pg8::StaticOrder S_; S_.init((gM), (gN), G, bx, ((gN) == DM) ? WGM_RES : 8, REV_DOWN); pg8::gemm_phase<EPI, true, AUX_DOWN>(lds, (gdesc), S_, (edesc)); } while (0)

    for (int rep_ = 0; rep_ < REP_P0; ++rep_) {
        LAS float* scr = (LAS float*)(lds + wave * 16384);
        for (int it = gw; it < N_EARLY; it += NGW) CONVERT_ITEM(it, lane);
        for (int i = bx * 512 + tid; i < 4 * MTOK; i += G * 512) rowss[MTOK + i] = 0.f;
        for (int m = gw; m < MTOK; m += NGW) {
            const f32x4* xr = (const f32x4*)(P.x + (size_t)m * DM) + lane; u32x2* o8 = (u32x2*)(HB + (size_t)m * DM) + lane; float s = 0.f;
#pragma unroll
            for (int j = 0; j < 8; ++j) { const f32x4 v = xr[64 * j]; s += (v[0] * v[0] + v[1] * v[1]) + (v[2] * v[2] + v[3] * v[3]); u32x2 w; w.x = cvt_pk_bf16(v[0], v[1]); w.y = cvt_pk_bf16(v[2], v[3]); o8[64 * j] = w; }
            s = wave_sum(s); if (lane == 0) rowss[m] = s;
        }
        for (int m = gw; m < BATCH * NMEM; m += NGW) {
            const f32x4* xr = (const f32x4*)(P.mem + (size_t)m * DM) + lane; const f32x4* gr = (const f32x4*)P.mem_norm + lane; u32x2* o8 = (u32x2*)(MEMN + (size_t)m * DM) + lane;
            f32x4 v[8]; float s = 0.f;
#pragma unroll
            for (int j = 0; j < 8; ++j) { v[j] = xr[64 * j]; s += (v[j][0] * v[j][0] + v[j][1] * v[j][1]) + (v[j][2] * v[j][2] + v[j][3] * v[j][3]); }
            const float rs = __builtin_amdgcn_rsqf(wave_sum(s) * (1.0f / DM) + EPS);
#pragma unroll
            for (int j = 0; j < 8; ++j) { const f32x4 gg = gr[64 * j]; const f32x4 y = v[j] * rs * gg; u32x2 w; w.x = cvt_pk_bf16(y[0], y[1]); w.y = cvt_pk_bf16(y[2], y[3]); o8[64 * j] = w; }
        }
    }
    grid.sync();
    for (int rep_ = 0; rep_ < REP_G1; ++rep_)
    RUN_GEMM(pg8::EpiSwiglu, MTOK, 2 * DFF, (pg8::Gemm{HB, Wgu1, DM, DM, DM, 0}), (pg8::EpiSwiglu{ACT, DFF, rowss}));
    for (int rep_ = 0; rep_ < REP_G1NULL; ++rep_)
    RUN_GEMM(pg8::EpiNull, MTOK, 2 * DFF, (pg8::Gemm{HB, Wgu1, DM, DM, DM, 0}), (pg8::EpiNull{}));
    for (int rep_ = 0; rep_ < REP_SYNC; ++rep_) grid.sync();
    xcd_barrier(xbar);
    for (int rep_ = 0; rep_ < REP_G2NULL; ++rep_)
    RUN_GEMM(pg8::EpiNull, MTOK, DM, (pg8::Gemm{ACT, Wd1, 128, 128, DFF, 0, (size_t)0, (size_t)DM * 256}), (pg8::EpiNull{}));
    for (int rep_ = 0; rep_ < REP_G2; ++rep_)
    RUN_GEMM(pg8::EpiRes<true>, MTOK, DM, (pg8::Gemm{ACT, Wd1, DFF, DFF, DFF, 0}), (pg8::EpiRes<true>{P.x, HB, nullptr, 0.5f}));
    RUN_GEMM_NT(pg8::EpiRes<true>, MTOK, DM, (pg8::Gemm{ACT, Wd1, DFF, DFF, DFF, 0}), (pg8::EpiRes<true>{P.x, HB, rowss + 1 * MTOK, 0.5f}));
    xcd_barrier(xbar);
    for (int rep_ = 0; rep_ < REP_G3; ++rep_)
    RUN_GEMM(pg8::EpiBf<64>, MTOK, DIN, (pg8::Gemm{HB, Win, DM, DM, DM, 0}), (pg8::EpiBf<64>{Z, DIN, 0, rowss + 1 * MTOK, nullptr, 8, 12, SEQ, DATT, VT, 4, 8, KF}));
    xcd_barrier(xbar);
    for (int rep_ = 0; rep_ < REP_ATT; ++rep_) {
        for (int task = gw; task < (MTOK / 64) * 4; task += NGW) {
            const int gi = task & 3, rt = task >> 2, sub = lane >> 5, cgi = lane & 31, w = 2 << gi;
            const int t0 = rt * 64 + sub * 32, tpos = t0 & (SEQ - 1);
            const bf16_t* up = Z + (size_t)t0 * DIN + 3 * DATT + gi * 256 + cgi * 8;
            bf16_t* dp = DP + (size_t)t0 * DPOOL + gi * 256 + cgi * 8;
            float sum[8];
#pragma unroll
            for (int e = 0; e < 8; ++e) sum[e] = 0.f;
            for (int i = 1; i < w; ++i) if (tpos - i >= 0) { const u32x4 v = *(const u32x4*)(up - (size_t)i * DIN);
                sum[0] += bf_lo(v.x); sum[1] += bf_hi(v.x); sum[2] += bf_lo(v.y); sum[3] += bf_hi(v.y); sum[4] += bf_lo(v.z); sum[5] += bf_hi(v.z); sum[6] += bf_lo(v.w); sum[7] += bf_hi(v.w); }
#pragma nounroll
            for (int r0 = 0; r0 < 32; r0 += 8) {
                u32x4 cv[8], ov[8];
#pragma unroll
                for (int j = 0; j < 8; ++j) cv[j] = *(const u32x4*)(up + (size_t)(r0 + j) * DIN);
#pragma unroll
                for (int j = 0; j < 8; ++j) { const int rr = r0 + j - w + 1; ov[j] = (tpos + rr >= 0) ? *(const u32x4*)(up + (ptrdiff_t)rr * DIN) : (u32x4){0u, 0u, 0u, 0u}; }
#pragma unroll
                for (int j = 0; j < 8; ++j) {
                    const u32x4 v = cv[j], q = ov[j];
                    const float cur[8] = {bf_lo(v.x), bf_hi(v.x), bf_lo(v.y), bf_hi(v.y), bf_lo(v.z), bf_hi(v.z), bf_lo(v.w), bf_hi(v.w)};
                    const float old[8] = {bf_lo(q.x), bf_hi(q.x), bf_lo(q.y), bf_hi(q.y), bf_lo(q.z), bf_hi(q.z), bf_lo(q.w), bf_hi(q.w)};
                    const int have = tpos + r0 + j + 1; const float inv = 1.0f / (float)(have < w ? have : w);
                    float d[8];
#pragma unroll
                    for (int e = 0; e < 8; ++e) { sum[e] += cur[e]; d[e] = sum[e] * inv - cur[e]; sum[e] -= old[e]; }
                    u32x4 o; o.x = cvt_pk_bf16(d[0], d[1]); o.y = cvt_pk_bf16(d[2], d[3]); o.z = cvt_pk_bf16(d[4], d[5]); o.w = cvt_pk_bf16(d[6], d[7]);
                    *(u32x4*)(dp + (size_t)(r0 + j) * DPOOL) = o;
                }
            }
        }
        LAS float* tab = (LAS float*)lds;
        for (int bh = bx; bh < BATCH * 16; bh += G) {
            const int b = bh >> 4, h = bh & 15;
            __syncthreads();
            for (int i = tid; i < 704; i += 512) { int rel = i - 63; rel = rel < -128 ? -128 : (rel > 128 ? 128 : rel); tab[i] = P.rel_bias[h * NREL + rel + 128] * LOG2E; }
            __syncthreads();
            const bool first = (bh == bx);
#pragma nounroll
            for (int stage = 0; stage < 2; ++stage) {
                const bool do_att = first ? ((((wave >> 2) & 1) == stage)) : (stage == 0);
                if (do_att) {
#pragma nounroll
                    for (int i = 0; i < 8; ++i) {
                        const int c = i * 4 + (wave >> 1), half = wave & 1, j0 = c < 8 ? 8 - c : 0, kstart = (c - 8 + j0) * 64;
                        const size_t qrow = (size_t)b * SEQ + c * 64 + half * 32;
                        attn_wave32<64, true, 2, true, true>(Z + qrow * DIN + h * 64, DIN, KF + ((size_t)(b * 16 + h) * SEQ + kstart) * 64, 0,
                                              VT + ((size_t)(b * 16 + h) * SEQ + kstart) * 64, 0, Y + qrow * DM + h * 64, DM, 9 - j0, 0.125f * LOG2E, tab, half * 32 + (8 - j0) * 64, lane);
                    }
                } else if (first) {
                    int ln = threadIdx.x & 63; asm volatile("" : "+v"(ln));
                    LAS float* scr2 = (LAS float*)(lds + 4096 + wave * 8448);
#define scr scr2
#pragma nounroll
                    for (int it = N_EARLY + gw; it < NITEMS; it += NGW) CONVERT_ITEM(it, ln);
#undef scr
                }
            }
        }
        __syncthreads();
    }
    xcd_barrier(xbar);
    if (G >= 128 && bx < 64) {
        RUN_GEMM_ON(pg8::EpiBf<128>, BATCH * NMEM, 2 * DCROSS, (pg8::Gemm{MEMN, Wckv, DM, DM, DM, 0}), (pg8::EpiBf<128>{KC, DCROSS, 0, nullptr, nullptr, 2, 4, NMEM, DCROSS, VCT, 0, 2, KC}), 64, bx);
    } else if (G >= 128) {
        RUN_GEMM_ON(pg8::EpiBf<0>, MTOK, DPOOL, (pg8::Gemm{DP, Wp, DPOOL, 256, 256, 512}), (pg8::EpiBf<0>{Y, DM, DATT, nullptr, P.pool_scale, 0, 0, 1, 1, nullptr, 0, 0, nullptr}), G - 64, bx - 64);
    } else {
        RUN_GEMM(pg8::EpiBf<128>, BATCH * NMEM, 2 * DCROSS, (pg8::Gemm{MEMN, Wckv, DM, DM, DM, 0}), (pg8::EpiBf<128>{KC, DCROSS, 0, nullptr, nullptr, 2, 4, NMEM, DCROSS, VCT, 0, 2, KC}));
        RUN_GEMM(pg8::EpiBf<0>, MTOK, DPOOL, (pg8::Gemm{DP, Wp, DPOOL, 256, 256, 512}), (pg8::EpiBf<0>{Y, DM, DATT, nullptr, P.pool_scale, 0, 0, 1, 1, nullptr, 0, 0, nullptr}));
    }
    xcd_barrier(xbar);
    RUN_GEMM(pg8::EpiRes<false>, MTOK, DM, (pg8::Gemm{Y, Wout, DM, DM, DM, 0}), (pg8::EpiRes<false>{nullptr, HB, rowss + 2 * MTOK, 1.0f}));
    xcd_barrier(xbar);
    RUN_GEMM(pg8::EpiBf<0>, MTOK, DCROSS, (pg8::Gemm{HB, Wcq, DM, DM, DM, 0}), (pg8::EpiBf<0>{CQ, DCROSS, 0, rowss + 2 * MTOK, nullptr, 0, 0, 1, 1, nullptr, 0, 0, nullptr}));
    xcd_barrier(xbar);
    for (int rep_ = 0; rep_ < REP_XATT; ++rep_) {
        for (int it = bx; it < BATCH * 16; it += G) {
            const int b = it >> 4, sub = it & 15;
#pragma nounroll
            for (int r = 0; r < 4; ++r) {
                const int wu = r * 8 + wave, head = wu & 3, qblk = wu >> 2;
                const size_t qrow = (size_t)b * SEQ + sub * 128 + qblk * 16;
#ifndef NO_ATT9
                attn_wave32<128, false, 1, true, true, false>(CQ + qrow * DCROSS + head * 128, DCROSS, KC + (size_t)(b * 4 + head) * NMEM * 128, 0,
                                        VCT + (size_t)(b * 4 + head) * NMEM * 128, 0, CO + qrow * DCROSS + head * 128, DCROSS, 4, 0.08838834764831845f * LOG2E, nullptr, 0, lane);
#endif
            }
        }
    }
    xcd_barrier(xbar);
    RUN_GEMM(pg8::EpiRes<false>, MTOK, DM, (pg8::Gemm{CO, Wco, DCROSS, DCROSS, DCROSS, 0}), (pg8::EpiRes<false>{nullptr, HB, rowss + 3 * MTOK, 1.0f}));
    xcd_barrier(xbar);
    RUN_GEMM(pg8::EpiSwiglu, MTOK, 2 * DFF, (pg8::Gemm{HB, Wgu2, DM, DM, DM, 0}), (pg8::EpiSwiglu{ACT, DFF, rowss + 3 * MTOK}));
    xcd_barrier(xbar);
    RUN_GEMM_NT(pg8::EpiRes<false>, MTOK, DM, (pg8::Gemm{ACT, Wd2, DFF, DFF, DFF, 0}), (pg8::EpiRes<false>{nullptr, HB, rowss + 4 * MTOK, 0.5f}));
    xcd_barrier(xbar);
    {
        const float* rs4 = rowss + 4 * MTOK;
        for (int m = gw; m < MTOK; m += NGW) {
            const u32x2* hr = (const u32x2*)(HB + (size_t)m * DM) + lane; f32x4* xr = (f32x4*)(P.out + (size_t)m * DM) + lane; const f32x4* gr = (const f32x4*)P.final_norm + lane;
            const float rs = __builtin_amdgcn_rsqf(rs4[m] * (1.0f / DM) + EPS);
#pragma unroll
            for (int j = 0; j < 8; ++j) { const u32x2 q = hr[64 * j]; const f32x4 v = (f32x4){bf_lo(q.x), bf_hi(q.x), bf_lo(q.y), bf_hi(q.y)}; xr[64 * j] = v * rs * gr[64 * j]; }
        }
    }
#undef RUN_GEMM
#undef RUN_GEMM_ON
#undef RUN_GEMM_NT
}

extern "C" void kernel_launch(void* const* d_in, const int* in_sizes, int n_in, void* d_out, int out_size, void* d_ws, size_t ws_size, hipStream_t stream) {
    static int grid_blocks = 0;
    if (grid_blocks == 0) {
        if (n_in != 22 || in_sizes[0] != MTOK * DM || out_size != MTOK * DM || ws_size < WS_END) {
            fprintf(stderr, "kernel_launch: unexpected shapes (n_in %d, in0 %d, out %d, ws %zu)\n", n_in, n_in > 0 ? in_sizes[0] : -1, out_size, ws_size); grid_blocks = -1; return; }
        int dev = 0, cus = 0, per_cu = 0;
        hipGetDevice(&dev);
        hipDeviceGetAttribute(&cus, hipDeviceAttributeMultiprocessorCount, dev);
        if (hipFuncSetAttribute((const void*)fwd_megakernel, hipFuncAttributeMaxDynamicSharedMemorySize, LDS_BYTES) != hipSuccess) { fprintf(stderr, "kernel_launch: hipFuncSetAttribute failed\n"); grid_blocks = -1; return; }
        if (hipOccupancyMaxActiveBlocksPerMultiprocessor(&per_cu, (const void*)fwd_megakernel, 512, LDS_BYTES) != hipSuccess || per_cu < 1) { fprintf(stderr, "kernel_launch: occupancy query gave %d\n", per_cu); per_cu = 1; }
        (void)hipGetLastError();
        grid_blocks = cus * per_cu;
    }
    if (grid_blocks < 0) return;
    Params p{};
    const float* const* in = (const float* const*)d_in;
    p.x = in[0]; p.mem = in[1]; p.ffn1_norm = in[2]; p.ffn1_wg = in[3]; p.ffn1_wu = in[4]; p.ffn1_wd = in[5]; p.mix_norm = in[6]; p.w_in = in[7]; p.rel_bias = in[8];
    p.w_pool = in[9]; p.pool_scale = in[10]; p.w_out = in[11]; p.cross_norm = in[12]; p.mem_norm = in[13]; p.w_cq = in[14]; p.w_ckv = in[15]; p.w_co = in[16];
    p.ffn2_norm = in[17]; p.ffn2_wg = in[18]; p.ffn2_wu = in[19]; p.ffn2_wd = in[20]; p.final_norm = in[21];
    p.out = (float*)d_out; p.ws = (unsigned char*)d_ws;
    if (hipMemsetAsync((char*)d_ws + WS_BAR, 0, WS_BAR_BYTES, stream) != hipSuccess) { fprintf(stderr, "kernel_launch: memset of the barrier words failed\n"); return; }
    void* args[] = {&p};
    hipError_t e = hipLaunchCooperativeKernel((const void*)fwd_megakernel, dim3(grid_blocks), dim3(512), args, LDS_BYTES, stream);
    if (e != hipSuccess) fprintf(stderr, "cooperative launch failed: %s (grid %d)\n", hipGetErrorString(e), grid_blocks);
}
```

```cpp
#include <hip/hip_runtime.h>
#include <hip/hip_cooperative_groups.h>
#include <cstdio>
#include <cstdint>
namespace cg = cooperative_groups;

#define LAS __attribute__((address_space(3)))
typedef unsigned short bf16_t;
typedef short bf16x8 __attribute__((ext_vector_type(8)));
typedef float f32x4 __attribute__((ext_vector_type(4)));
typedef float f32x2 __attribute__((ext_vector_type(2)));
typedef unsigned u32x4 __attribute__((ext_vector_type(4)));
typedef unsigned u32x2 __attribute__((ext_vector_type(2)));

constexpr int BATCH = 16, SEQ = 2048, DM = 2048, MTOK = BATCH * SEQ;
constexpr int DFF = 5632, DIN = 4096, DATT = 1024, DPOOL = 1024, NMEM = 256, DCROSS = 512;
constexpr int NREL = 257;
constexpr float EPS = 1e-6f;
constexpr float LOG2E = 1.4426950408889634f;

constexpr size_t MiB = 1u << 20;
constexpr size_t WS_ROWSS = 0;
constexpr size_t WS_BAR = 896 * 1024, WS_BAR_BYTES = 16384;
constexpr size_t WS_WGU1 = 1 * MiB, WS_WD1 = 45 * MiB, WS_WIN = 67 * MiB, WS_WP = 83 * MiB, WS_WOUT = 84 * MiB, WS_WCQ = 92 * MiB,
                 WS_WCKV = 94 * MiB, WS_WCO = 98 * MiB, WS_WGU2 = 100 * MiB, WS_WD2 = 144 * MiB;
constexpr size_t WS_HB = 166 * MiB;
constexpr size_t WS_ACT = 294 * MiB;
constexpr size_t WS_Z = 294 * MiB;
constexpr size_t WS_VT = 550 * MiB;
constexpr size_t WS_Y = 646 * MiB;
constexpr size_t WS_CQ = 646 * MiB, WS_CO = 678 * MiB;
constexpr size_t WS_DP = 774 * MiB;
constexpr size_t WS_MEMN = 838 * MiB;
constexpr size_t WS_KC = 854 * MiB;
constexpr size_t WS_VCT = 858 * MiB;
constexpr size_t WS_KF = 862 * MiB;
constexpr size_t WS_END = 926 * MiB;

#ifndef REP_G1NULL
#define REP_G1NULL 0
#endif
#ifndef REP_SYNC
#define REP_SYNC 0
#endif
#ifndef REP_G2
#define REP_G2 0
#endif
#ifndef REP_G2NULL
#define REP_G2NULL 0
#endif
#ifndef REP_ATTC
#define REP_ATTC 0
#endif
#ifndef REP_XATT
#define REP_XATT 1
#endif
#ifndef REP_P0
#define REP_P0 1
#endif
#ifndef REP_G1
#define REP_G1 1
#endif
#ifndef REP_ATT
#define REP_ATT 1
#endif
#ifndef REP_G3
#define REP_G3 1
#endif
constexpr int LDS_BYTES = 147456;

__device__ __forceinline__ unsigned cvt_pk_bf16(float lo, float hi) { unsigned r; asm volatile("v_cvt_pk_bf16_f32 %0, %1, %2" : "=v"(r) : "v"(lo), "v"(hi)); return r; }
__device__ __forceinline__ float bf_lo(unsigned w) { return __uint_as_float(w << 16); }
__device__ __forceinline__ float bf_hi(unsigned w) { return __uint_as_float(w & 0xffff0000u); }
__device__ __forceinline__ float wave_sum(float v) {
#pragma unroll
    for (int o = 1; o < 64; o <<= 1) v += __shfl_xor(v, o);
    return v;
}

namespace pg8 {
constexpr int BM = 256, BK = 64, HALF = 128, HTB = HALF * BK * 2, STAGE_BYTES = 8 * HTB, NXCD = 8;
__host__ __device__ __forceinline__ int lds_byte(int r, int c) { const int st = (r >> 4) * 2 + (c >> 5), rr = r & 15, cc = c & 31, ob = rr * 64 + cc * 2; return st * 1024 + (ob ^ (((ob >> 9) & 1) << 5)); }
__host__ __device__ __forceinline__ void stage_rc(int b, int& R, int& C) { const int st = b / 1024, sb = b % 1024, swz = sb ^ (((sb >> 9) & 1) << 5); R = (st >> 1) * 16 + swz / 64; C = (st & 1) * 32 + (swz % 64) / 2; }
__host__ __device__ __forceinline__ int perm32(int rho) { const int n = rho >> 4, i = rho & 15; return 8 * (i >> 2) + 4 * n + (i & 3); }

struct Unit { int pm, pn; };
struct Gemm { const bf16_t* A; const bf16_t* Bt; int lda, ldb, K, a_pn_step; size_t kblkA = 256, kblkB = 256; };

struct StaticOrder {
    int nM, nN, nwg, G, c, WGM, rev;
    __device__ void init(int M, int N, int G_, int c_, int wgm = 8, int rev_ = 0) { nM = M / BM; nN = N / BM; nwg = nM * nN; G = G_; c = c_; WGM = wgm; rev = rev_; }
    __device__ bool next(int i, Unit& u) const {
        const int nr = (nwg + G - 1) / G; if (i >= nr) return false;
        long L = (long)(rev ? nr - 1 - i : i) * G + c;
        if (L >= nwg) { if (!rev) return false; L = (long)(nr - 2 - i) * G + c; if (i + 1 >= nr) return false; }
        int wgid = (int)L; { const int q = nwg / NXCD, r = nwg % NXCD, xcd = wgid % NXCD, off = wgid / NXCD; wgid = (xcd < r ? xcd * (q + 1) : r * (q + 1) + (xcd - r) * q) + off; }
        const int nig = WGM * nN, gid = wgid / nig, fm = gid * WGM, gsz = (nM - fm) < WGM ? (nM - fm) : WGM;
        u.pm = fm + ((wgid % nig) % gsz); u.pn = (wgid % nig) / gsz; return true;
    }
};

template <int FMD> struct EpiBf {
    bf16_t* O; int ldc; int col_off; const float* rowss; const float* colscale; int t_lo, t_hi, t_rows, t_cols; bf16_t* VT; int k_lo, k_hi; bf16_t* KF;
    __device__ __forceinline__ void operator()(const f32x4 (&acc)[2][2][4][2], const Unit& u, int wr, int wc, int fr, int fq) const {
        const int row0 = u.pm * BM + wr * 64 + fr, cl = wc * 32 + 8 * fq;
        const bool tr = (u.pn >= t_lo) && (u.pn < t_hi);
        constexpr bool FM = FMD != 0;
        constexpr int FDH = FM ? FMD : 64, FKS = FDH / 32, FROWS = (FMD == 128) ? NMEM : SEQ, FNH = (FMD == 128) ? 4 : 16, FTPB = FROWS / 64;
        const bool kfm = FM && (u.pn >= k_lo) && (u.pn < k_hi);
        f32x4 cs[2][2]; float rsv[8];
#pragma unroll
        for (int bj = 0; bj < 2; ++bj)
#pragma unroll
            for (int n = 0; n < 2; ++n) cs[bj][n] = colscale ? *(const f32x4*)(colscale + u.pn * BM + bj * HALF + cl + 4 * n) : (f32x4){1.f, 1.f, 1.f, 1.f};
#pragma unroll
        for (int i = 0; i < 8; ++i) rsv[i] = rowss ? rowss[row0 + (i >> 2) * HALF + (i & 3) * 16] : 0.f;
        asm volatile("" ::: "memory");
#pragma unroll
        for (int ai = 0; ai < 2; ++ai)
#pragma unroll
            for (int m = 0; m < 4; ++m) {
                const int row = row0 + ai * HALF + m * 16;
                const float rsc = rowss ? __builtin_amdgcn_rsqf(rsv[ai * 4 + m] * (1.0f / DM) + EPS) : 1.0f;
#pragma unroll
                for (int bj = 0; bj < 2; ++bj) {
                    const f32x4 v0 = acc[ai][bj][m][0] * rsc * cs[bj][0], v1 = acc[ai][bj][m][1] * rsc * cs[bj][1];
                    u32x4 w; w.x = cvt_pk_bf16(v0[0], v0[1]); w.y = cvt_pk_bf16(v0[2], v0[3]); w.z = cvt_pk_bf16(v1[0], v1[1]); w.w = cvt_pk_bf16(v1[2], v1[3]);
                    if (FM && (kfm || tr)) {
                        const int c = (u.pn - (kfm ? k_lo : t_lo)) * BM + bj * HALF + cl, hh = c / FDH, d = c % FDH;
                        const int bb = row / FROWS, s = row % FROWS, tile = s >> 6, k = s & 63;
                        const size_t tbase = ((size_t)((bb * FNH + hh) * FTPB + tile)) * (64 * FDH);
                        if (kfm) {
                            const int kb = k >> 5, r = k & 31, mt = kb * 2 + ((r >> 2) & 1), fra = (r >> 3) * 4 + (r & 3), ks = d >> 5, fqa = (d >> 3) & 3;
                            *(u32x4*)(KF + tbase + ((mt * FKS + ks) * 64 + fqa * 16 + fra) * 8) = w;
                        } else {
                            const int dt = d >> 4, fra0 = d & 15, kb = k >> 5, fqa = (k & 31) >> 3, e8 = k & 7;
                            bf16_t* p = VT + tbase + ((dt * 2 + kb) * 64 + fqa * 16 + fra0) * 8 + e8;
                            p[0] = (bf16_t)(w.x & 0xffffu); p[8] = (bf16_t)(w.x >> 16); p[16] = (bf16_t)(w.y & 0xffffu); p[24] = (bf16_t)(w.y >> 16);
                            p[32] = (bf16_t)(w.z & 0xffffu); p[40] = (bf16_t)(w.z >> 16); p[48] = (bf16_t)(w.w & 0xffffu); p[56] = (bf16_t)(w.w >> 16);
                        }
                    } else if (!tr) { *(u32x4*)(O + (size_t)row * ldc + col_off + u.pn * BM + bj * HALF + cl) = w; }
                    else {
                        const int cv = (u.pn - t_lo) * BM + bj * HALF + cl, b = row / t_rows, s = row - b * t_rows;
                        bf16_t* p = VT + ((size_t)b * t_cols + cv) * t_rows + s;
                        p[0] = (bf16_t)(w.x & 0xffffu); p[(size_t)t_rows] = (bf16_t)(w.x >> 16); p[(size_t)2 * t_rows] = (bf16_t)(w.y & 0xffffu); p[(size_t)3 * t_rows] = (bf16_t)(w.y >> 16);
                        p[(size_t)4 * t_rows] = (bf16_t)(w.z & 0xffffu); p[(size_t)5 * t_rows] = (bf16_t)(w.z >> 16); p[(size_t)6 * t_rows] = (bf16_t)(w.w & 0xffffu); p[(size_t)7 * t_rows] = (bf16_t)(w.w >> 16);
                    }
                }
            }
    }
};
__device__ __forceinline__ float silu_mul(float g, float u) { return g * __builtin_amdgcn_rcpf(1.0f + __expf(-g)) * u; }
struct EpiSwiglu {
    bf16_t* O; int ldc; const float* rowss;
    __device__ __forceinline__ void operator()(const f32x4 (&acc)[2][2][4][2], const Unit& u, int wr, int wc, int fr, int fq) const {
        const int row0 = u.pm * BM + wr * 64 + fr, cl = wc * 32 + 8 * fq;
        float rsv[8];
#pragma unroll
        for (int i = 0; i < 8; ++i) rsv[i] = rowss[row0 + (i >> 2) * HALF + (i & 3) * 16];
        asm volatile("" ::: "memory");
#pragma unroll
        for (int ai = 0; ai < 2; ++ai)
#pragma unroll
            for (int m = 0; m < 4; ++m) {
                const int row = row0 + ai * HALF + m * 16;
                const float rsc = __builtin_amdgcn_rsqf(rsv[ai * 4 + m] * (1.0f / DM) + EPS);
                const f32x4 g0 = acc[ai][0][m][0] * rsc, g1 = acc[ai][0][m][1] * rsc, u0 = acc[ai][1][m][0] * rsc, u1 = acc[ai][1][m][1] * rsc;
                u32x4 w;
                w.x = cvt_pk_bf16(silu_mul(g0[0], u0[0]), silu_mul(g0[1], u0[1])); w.y = cvt_pk_bf16(silu_mul(g0[2], u0[2]), silu_mul(g0[3], u0[3]));
                w.z = cvt_pk_bf16(silu_mul(g1[0], u1[0]), silu_mul(g1[1], u1[1])); w.w = cvt_pk_bf16(silu_mul(g1[2], u1[2]), silu_mul(g1[3], u1[3]));
                *(u32x4*)(O + ((size_t)u.pn * MTOK + row) * HALF + cl) = w;
            }
    }
};
template <bool F32IN> struct EpiRes {
    const float* hin_f; bf16_t* hb; float* rowss_out; float alpha;
    static constexpr int DEPTH = F32IN ? 2 : 4, NV = F32IN ? 4 : 2;
    __device__ __forceinline__ void ld(f32x4 (&hv)[4], size_t off) const {
        if (F32IN) { hv[0] = *(const f32x4*)(hin_f + off); hv[1] = *(const f32x4*)(hin_f + off + 4); hv[2] = *(const f32x4*)(hin_f + off + HALF); hv[3] = *(const f32x4*)(hin_f + off + HALF + 4); }
        else { hv[0] = __builtin_bit_cast(f32x4, *(const u32x4*)(hb + off)); hv[1] = __builtin_bit_cast(f32x4, *(const u32x4*)(hb + off + HALF)); }
    }
    __device__ __forceinline__ void operator()(const f32x4 (&acc)[2][2][4][2], const Unit& u, int wr, int wc, int fr, int fq) const {
        const int row0 = u.pm * BM + wr * 64 + fr, cl = u.pn * BM + wc * 32 + 8 * fq;
        f32x4 hv[DEPTH][4];
#pragma unroll
        for (int gi = 0; gi < DEPTH; ++gi) ld(hv[gi], (size_t)(row0 + (gi >> 2) * HALF + (gi & 3) * 16) * DM + cl);
#pragma unroll
        for (int gi = 0; gi < 8; ++gi) {
            const int ai = gi >> 2, m = gi & 3, cb = gi % DEPTH;
            asm volatile("" ::: "memory");
            const int row = row0 + ai * HALF + m * 16; const size_t off = (size_t)row * DM + cl;
            float ss = 0.f;
            u32x4 wv[2];
#pragma unroll
            for (int bj = 0; bj < 2; ++bj) {
                f32x4 o0, o1;
                if (F32IN) { o0 = hv[cb][2 * bj]; o1 = hv[cb][2 * bj + 1]; }
                else { const u32x4 q = __builtin_bit_cast(u32x4, hv[cb][bj]); o0 = (f32x4){bf_lo(q.x), bf_hi(q.x), bf_lo(q.y), bf_hi(q.y)}; o1 = (f32x4){bf_lo(q.z), bf_hi(q.z), bf_lo(q.w), bf_hi(q.w)}; }
                const f32x4 h0 = o0 + acc[ai][bj][m][0] * alpha, h1 = o1 + acc[ai][bj][m][1] * alpha;
                ss += (h0[0] * h0[0] + h0[1] * h0[1]) + (h0[2] * h0[2] + h0[3] * h0[3]) + (h1[0] * h1[0] + h1[1] * h1[1]) + (h1[2] * h1[2] + h1[3] * h1[3]);
                wv[bj].x = cvt_pk_bf16(h0[0], h0[1]); wv[bj].y = cvt_pk_bf16(h0[2], h0[3]); wv[bj].z = cvt_pk_bf16(h1[0], h1[1]); wv[bj].w = cvt_pk_bf16(h1[2], h1[3]);
            }
            if (gi + DEPTH < 8) ld(hv[cb], (size_t)(row0 + ((gi + DEPTH) >> 2) * HALF + ((gi + DEPTH) & 3) * 16) * DM + cl);
            *(u32x4*)(hb + off) = wv[0]; *(u32x4*)(hb + off + HALF) = wv[1];
            ss += __shfl_xor(ss, 16); ss += __shfl_xor(ss, 32);
            if (rowss_out && fq == 0) __hip_atomic_fetch_add(rowss_out + row, ss, __ATOMIC_RELAXED, __HIP_MEMORY_SCOPE_AGENT);
        }
    }
};

struct EpiNull {
    __device__ __forceinline__ void operator()(const f32x4 (&acc)[2][2][4][2], const Unit& u, int wr, int wc, int fr, int fq) const {
#pragma unroll
        for (int ai = 0; ai < 2; ++ai)
#pragma unroll
            for (int bj = 0; bj < 2; ++bj)
#pragma unroll
                for (int m = 0; m < 4; ++m) asm volatile("" :: "v"(acc[ai][bj][m][0]), "v"(acc[ai][bj][m][1]));
    }
};

template <class Epi, bool ALIGN_EPI = true, int AUX_A = 0>
__device__ __forceinline__ void gemm_phase(LAS unsigned char* lds, const Gemm g, const StaticOrder& S, const Epi& E) {
    int tid_l = threadIdx.x; asm volatile("" : "+v"(tid_l));
    const int tid = tid_l, wid = __builtin_amdgcn_readfirstlane(tid >> 6), lane = tid & 63, wr = wid >> 2, wc = wid & 3, fr = lane & 15, fq = lane >> 4;
    const int K = g.K, nt = K / BK;
    unsigned voffA[2], voffB[2];
#pragma unroll
    for (int i = 0; i < 2; ++i) { int R, C; stage_rc(tid * 16 + i * 8192, R, C); const int Rb = (R & ~31) + perm32(R & 31);
        voffA[i] = (unsigned)(R * g.lda + C) * 2u; voffB[i] = (unsigned)(Rb * g.ldb + C) * 2u; }
    const size_t kstep = (size_t)(BK * 2);
    const size_t hstepA = (size_t)HALF * g.lda * 2, hstepB = (size_t)HALF * g.ldb * 2;
    const size_t tstepA = 2 * hstepA, tstepB = 2 * hstepB;
    const unsigned ldsw = (unsigned)wid * 1024u;
    const int aoff = lds_byte(wr * 64 + fr, fq * 8), boff = lds_byte(wc * 32 + fr, fq * 8);
#define PG8_SA(b, h) (((b) * 2 + (h)) * HTB)
#define PG8_SB(b, h) ((4 + (b) * 2 + (h)) * HTB)
#define PG8_STAGE_X(bufoff, gbase, voff, aux) do { _Pragma("unroll") for (int _i = 0; _i < 2; ++_i) \
        __builtin_amdgcn_global_load_lds((const unsigned*)((const char*)(gbase) + (voff)[_i]), (LAS unsigned*)(lds + (bufoff) + ldsw + _i * 8192), 16, 0, aux); } while (0)
#define PG8_STAGE(bufoff, gbase, voff) PG8_STAGE_X(bufoff, gbase, voff, 0)
#define PG8_LDA(dst, b, h) do { _Pragma("unroll") for (int m = 0; m < 4; ++m) _Pragma("unroll") for (int k = 0; k < 2; ++k) dst[m][k] = *(const LAS bf16x8*)(lds + PG8_SA(b, h) + aoff + m * 2048 + k * 1024); } while (0)
#define PG8_LDB(dst, b, h) do { _Pragma("unroll") for (int n = 0; n < 2; ++n) _Pragma("unroll") for (int k = 0; k < 2; ++k) dst[n][k] = *(const LAS bf16x8*)(lds + PG8_SB(b, h) + boff + n * 2048 + k * 1024); } while (0)
#define PG8_MMA(ai, bj, At, Bt) do { __builtin_amdgcn_s_setprio(1); _Pragma("unroll") for (int m = 0; m < 4; ++m) _Pragma("unroll") for (int n = 0; n < 2; ++n) _Pragma("unroll") for (int k = 0; k < 2; ++k) \
        acc[ai][bj][m][n] = __builtin_amdgcn_mfma_f32_16x16x32_bf16(Bt[n][k], At[m][k], acc[ai][bj][m][n], 0, 0, 0); __builtin_amdgcn_s_setprio(0); } while (0)
#define PG8_WAIT_V(n) asm volatile("s_waitcnt vmcnt(" #n ")" ::: "memory")
#define PG8_WAIT_L(n) asm volatile("s_waitcnt lgkmcnt(" #n ")" ::: "memory")
#define PG8_BAR __builtin_amdgcn_s_barrier()
#define PG8_SCHED __builtin_amdgcn_sched_barrier(0)
    Unit cur, nxt; int ui = 0;
    if (!S.next(0, cur)) return;
    f32x4 acc[2][2][4][2];
#pragma unroll
    for (int a = 0; a < 2; ++a)
#pragma unroll
        for (int b = 0; b < 2; ++b)
#pragma unroll
            for (int m = 0; m < 4; ++m)
#pragma unroll
                for (int n = 0; n < 2; ++n) acc[a][b][m][n] = (f32x4){0.f, 0.f, 0.f, 0.f};
    bf16x8 At[4][2], B0[2][2], B1[2][2];
    const char* cA = (const char*)g.A + (size_t)cur.pm * tstepA + (size_t)cur.pn * g.a_pn_step; const char* cB = (const char*)g.Bt + (size_t)cur.pn * tstepB;
    PG8_STAGE(PG8_SB(0, 0), cB, voffB); PG8_STAGE(PG8_SB(0, 1), cB + hstepB, voffB); PG8_STAGE_X(PG8_SA(0, 0), cA, voffA, AUX_A); PG8_STAGE_X(PG8_SA(0, 1), cA + hstepA, voffA, AUX_A);
    if (wr == 1) PG8_BAR;
    PG8_WAIT_V(2); PG8_BAR;
    PG8_STAGE(PG8_SB(1, 0), cB + kstep, voffB); PG8_STAGE_X(PG8_SA(1, 0), cA + kstep, voffA, AUX_A); PG8_STAGE(PG8_SB(1, 1), cB + hstepB + kstep, voffB);
    PG8_WAIT_V(6); PG8_BAR;
    for (;;) {
        const bool has_next = S.next(ui + 1, nxt);
        const char* nA = has_next ? (const char*)g.A + (size_t)nxt.pm * tstepA + (size_t)nxt.pn * g.a_pn_step : cA; const char* nB = has_next ? (const char*)g.Bt + (size_t)nxt.pn * tstepB : cB;
        for (int t = 0; t < nt; t += 2) {
            const bool last = (t == nt - 2);
            const size_t kbi = (size_t)(t >> 1);
            const char* a1 = cA + kbi * g.kblkA + kstep;
            const char* a2 = last ? nA : cA + (kbi + 1) * g.kblkA; const char* b2 = last ? nB : cB + (kbi + 1) * g.kblkB;
            const char* a3 = a2 + kstep; const char* b3 = b2 + kstep;
            PG8_LDB(B0, 0, 0); PG8_LDB(B1, 0, 1); PG8_SCHED; PG8_LDA(At, 0, 0); PG8_STAGE_X(PG8_SA(1, 1), a1 + hstepA, voffA, AUX_A);
            PG8_WAIT_V(8); PG8_WAIT_L(0); PG8_BAR; PG8_MMA(0, 0, At, B0); PG8_MMA(0, 1, At, B1); PG8_BAR; PG8_SCHED;
            PG8_LDA(At, 0, 1); PG8_STAGE(PG8_SB(0, 0), b2, voffB); PG8_STAGE(PG8_SB(0, 1), b2 + hstepB, voffB); PG8_STAGE_X(PG8_SA(0, 0), a2, voffA, AUX_A);
            PG8_WAIT_V(8); PG8_WAIT_L(0); PG8_BAR; PG8_MMA(1, 0, At, B0); PG8_MMA(1, 1, At, B1); PG8_BAR; PG8_SCHED;
            PG8_LDB(B0, 1, 0); PG8_LDB(B1, 1, 1); PG8_SCHED; PG8_LDA(At, 1, 0); PG8_STAGE_X(PG8_SA(0, 1), a2 + hstepA, voffA, AUX_A);
            PG8_WAIT_V(8); PG8_WAIT_L(0); PG8_BAR; PG8_MMA(0, 0, At, B0); PG8_MMA(0, 1, At, B1); PG8_BAR; PG8_SCHED;
            PG8_LDA(At, 1, 1); PG8_STAGE(PG8_SB(1, 0), b3, voffB); PG8_STAGE(PG8_SB(1, 1), b3 + hstepB, voffB); PG8_STAGE_X(PG8_SA(1, 0), a3, voffA, AUX_A);
            PG8_WAIT_V(8); PG8_WAIT_L(0); PG8_BAR; PG8_MMA(1, 0, At, B0); PG8_MMA(1, 1, At, B1); PG8_BAR; PG8_SCHED;
        }
        if constexpr (ALIGN_EPI) { if (wr == 0) PG8_BAR; }
        E(acc, cur, wr, wc, fr, fq);
        if (!has_next) break;
#pragma unroll
        for (int a = 0; a < 2; ++a)
#pragma unroll
            for (int b = 0; b < 2; ++b)
#pragma unroll
                for (int m = 0; m < 4; ++m)
#pragma unroll
                    for (int n = 0; n < 2; ++n) acc[a][b][m][n] = (f32x4){0.f, 0.f, 0.f, 0.f};
        cur = nxt; cA = nA; cB = nB; ++ui;
        if constexpr (ALIGN_EPI) { if (wr == 1) PG8_BAR; }
    }
    PG8_WAIT_V(0);
    if constexpr (!ALIGN_EPI) { if (wr == 0) PG8_BAR; }
    PG8_BAR;
#undef PG8_SA
#undef PG8_SB
#undef PG8_STAGE
#undef PG8_STAGE_X
#undef PG8_LDA
#undef PG8_LDB
#undef PG8_MMA
#undef PG8_WAIT_V
#undef PG8_WAIT_L
#undef PG8_BAR
#undef PG8_SCHED
}
}

template <int DH, bool BIAS, int NT, bool PF, bool COAL = false, bool VDB = true>
__device__ __forceinline__ void attn_wave32(const bf16_t* __restrict__ Qp, int ldq, const bf16_t* __restrict__ Kp, int ldk, const bf16_t* __restrict__ Vp, int ldv,
                                            bf16_t* __restrict__ Op, int ldo, int ntiles, float sc, const LAS float* tab, int rel_base, int lane) {
    constexpr int KS = DH / 32, DT = DH / 16;
    asm volatile("" : "+v"(lane));
    const int fr = lane & 15, fq = lane >> 4;
    bf16x8 qf[NT][KS];
#pragma unroll
    for (int nt = 0; nt < NT; ++nt)
#pragma unroll
        for (int ks = 0; ks < KS; ++ks) qf[nt][ks] = *(const bf16x8*)(Qp + (size_t)(nt * 16 + fr) * ldq + ks * 32 + fq * 8);
    f32x4 o[DT][NT];
#pragma unroll
    for (int dt = 0; dt < DT; ++dt)
#pragma unroll
        for (int nt = 0; nt < NT; ++nt) o[dt][nt] = (f32x4){0.f, 0.f, 0.f, 0.f};
    float mrun[NT], lrun[NT];
#pragma unroll
    for (int nt = 0; nt < NT; ++nt) { mrun[nt] = -1e30f; lrun[nt] = 0.f; }
    const bf16_t* kbase = Kp + (size_t)(8 * (fr >> 2) + (fr & 3)) * ldk + fq * 8;
    const bf16_t* vbase = Vp + (size_t)fr * ldv + fq * 8;
    bf16x8 kf[4][KS], vfA[DT][2], vfB[DT][2];
#define ATT_LOADK(tt) do { _Pragma("unroll") for (int mt = 0; mt < 4; ++mt) _Pragma("unroll") for (int ks = 0; ks < KS; ++ks) \
        kf[mt][ks] = COAL ? *(const bf16x8*)(Kp + (size_t)(tt) * (64 * DH) + (mt * KS + ks) * 512 + lane * 8) \
                          : *(const bf16x8*)(kbase + (size_t)((tt) * 64 + (mt >> 1) * 32 + 4 * (mt & 1)) * ldk + ks * 32); } while (0)
#define ATT_LOADV(dst, tt) do { _Pragma("unroll") for (int dt = 0; dt < DT; ++dt) _Pragma("unroll") for (int kb = 0; kb < 2; ++kb) \
        dst[dt][kb] = COAL ? *(const bf16x8*)(Vp + (size_t)(tt) * (64 * DH) + (dt * 2 + kb) * 512 + lane * 8) \
                           : *(const bf16x8*)(vbase + (size_t)(dt * 16) * ldv + (tt) * 64 + kb * 32); } while (0)
#define ATT_BODY(t, vcur, vnext) do { \
        const int tn_ = ((t) + 1 < ntiles) ? (t) + 1 : (t); \
        if (PF && VDB) ATT_LOADV(vnext, tn_); else if (PF) ATT_LOADV(vcur, t); else ATT_LOADK(t); \
        f32x4 s[4][NT]; \
        _Pragma("unroll") for (int mt = 0; mt < 4; ++mt) _Pragma("unroll") for (int nt = 0; nt < NT; ++nt) { s[mt][nt] = (f32x4){0.f, 0.f, 0.f, 0.f}; \
            _Pragma("unroll") for (int ks = 0; ks < KS; ++ks) s[mt][nt] = __builtin_amdgcn_mfma_f32_16x16x32_bf16(kf[mt][ks], qf[nt][ks], s[mt][nt], 0, 0, 0); } \
        if (PF) ATT_LOADK(tn_); \
        bf16x8 pf[NT][2]; \
          \
        const LAS float* tb_ = tab + (rel_base - 64 * (t) + fr - 8 * fq + 63 - 39); \
        _Pragma("unroll") for (int nt = 0; nt < NT; ++nt) { \
            float mloc = -1e30f; \
            _Pragma("unroll") for (int mt = 0; mt < 4; ++mt) _Pragma("unroll") for (int j = 0; j < 4; ++j) { \
                float v = s[mt][nt][j] * sc; \
                if (BIAS) v += tb_[39 + nt * 16 - ((mt >> 1) * 32 + 4 * (mt & 1) + j)]; \
                s[mt][nt][j] = v; mloc = fmaxf(mloc, v); } \
            mloc = fmaxf(mloc, __shfl_xor(mloc, 16)); mloc = fmaxf(mloc, __shfl_xor(mloc, 32)); \
            const float mnew = fmaxf(mrun[nt], mloc), alpha = __builtin_amdgcn_exp2f(mrun[nt] - mnew); \
            mrun[nt] = mnew; \
            float ls = 0.f; \
            _Pragma("unroll") for (int mt = 0; mt < 4; ++mt) _Pragma("unroll") for (int j = 0; j < 4; ++j) { const float p = __builtin_amdgcn_exp2f(s[mt][nt][j] - mnew); s[mt][nt][j] = p; ls += p; } \
            lrun[nt] = lrun[nt] * alpha + ls; \
            _Pragma("unroll") for (int dt = 0; dt < DT; ++dt) o[dt][nt] = o[dt][nt] * alpha; \
            _Pragma("unroll") for (int kb = 0; kb < 2; ++kb) { \
                u32x4 w; w.x = cvt_pk_bf16(s[2 * kb][nt][0], s[2 * kb][nt][1]); w.y = cvt_pk_bf16(s[2 * kb][nt][2], s[2 * kb][nt][3]); \
                w.z = cvt_pk_bf16(s[2 * kb + 1][nt][0], s[2 * kb + 1][nt][1]); w.w = cvt_pk_bf16(s[2 * kb + 1][nt][2], s[2 * kb + 1][nt][3]); \
                pf[nt][kb] = __builtin_bit_cast(bf16x8, w); } } \
        if (!PF) { asm volatile("" ::: "memory"); ATT_LOADV(vcur, t); } \
        _Pragma("unroll") for (int dt = 0; dt < DT; ++dt) _Pragma("unroll") for (int nt = 0; nt < NT; ++nt) _Pragma("unroll") for (int kb = 0; kb < 2; ++kb) \
            o[dt][nt] = __builtin_amdgcn_mfma_f32_16x16x32_bf16(vcur[dt][kb], pf[nt][kb], o[dt][nt], 0, 0, 0); \
    } while (0)
    if (PF && VDB) { ATT_LOADK(0); ATT_LOADV(vfA, 0);
#pragma nounroll
        for (int t = 0; t < ntiles; t += 2) {
            ATT_BODY(t, vfA, vfB);
            if (t + 1 < ntiles) ATT_BODY(t + 1, vfB, vfA);
        }
    } else if (PF) { ATT_LOADK(0);
#pragma nounroll
        for (int t = 0; t < ntiles; ++t) ATT_BODY(t, vfA, vfB);
    } else {
#pragma nounroll
        for (int t = 0; t < ntiles; ++t) ATT_BODY(t, vfA, vfB);
    }
#undef ATT_BODY
#undef ATT_LOADK
#undef ATT_LOADV
#pragma unroll
    for (int nt = 0; nt < NT; ++nt) {
        float l = lrun[nt]; l += __shfl_xor(l, 16); l += __shfl_xor(l, 32);
        const float inv = 1.0f / l;
#pragma unroll
        for (int dt = 0; dt < DT; ++dt) {
            const f32x4 v = o[dt][nt] * inv; u32x2 w; w.x = cvt_pk_bf16(v[0], v[1]); w.y = cvt_pk_bf16(v[2], v[3]);
            *(u32x2*)(Op + (size_t)(nt * 16 + fr) * ldo + dt * 16 + 4 * fq) = w;
        }
    }
}

#define XB_TMO      128
#define XB_XCNT(j)  (256  + 64 * (j))
#define XB_XSUB(j)  (1280 + 64 * (j))
#define XB_XGEN(j)  (2304 + 64 * (j))
#define XB_TOP      3328
#define XB_TOPGEN   3392
#define XCD_BAR_WORDS 3456
#define XB_SPIN_CAP (1u << 22)
__device__ __forceinline__ unsigned xb_ld(unsigned* p)              { return __hip_atomic_load(p, __ATOMIC_RELAXED, __HIP_MEMORY_SCOPE_AGENT); }
__device__ __forceinline__ unsigned xb_add(unsigned* p, unsigned v) { return __hip_atomic_fetch_add(p, v, __ATOMIC_RELAXED, __HIP_MEMORY_SCOPE_AGENT); }
__device__ __forceinline__ unsigned xb_xcc_id() { return (unsigned)__builtin_amdgcn_s_getreg((3 << 11) | 20) & 0xFu; }
#define XB_SPIN(cond, bar) do { unsigned _sp = 0; while (cond) { __builtin_amdgcn_s_sleep(1); \
    if ((++_sp & 255u) == 0u) { if (xb_ld(&(bar)[XB_TMO])) break; if (_sp > XB_SPIN_CAP) { atomicAdd(&(bar)[XB_TMO], 1u); break; } } } } while (0)
struct XcdBarrier { unsigned* bar; unsigned x; volatile LAS unsigned* st; };
__device__ __forceinline__ XcdBarrier xcd_barrier_post(unsigned* bar, volatile LAS unsigned* st) {
    XcdBarrier b; b.bar = bar; b.x = xb_xcc_id(); b.st = st;
    if (threadIdx.x == 0) (void)xb_add(&bar[XB_XCNT(b.x)], 1u);
    return b;
}
__device__ __forceinline__ void xcd_barrier_complete(unsigned* bar, unsigned x, unsigned& nloc, unsigned& nx) {
    const unsigned G = gridDim.x * gridDim.y * gridDim.z;
    unsigned sum, cnt, mine, sp = 0u;
    for (;;) {
        sum = 0u; cnt = 0u; mine = 0u;
#pragma unroll
        for (unsigned j = 0; j < 16; ++j) { const unsigned c = xb_ld(&bar[XB_XCNT(j)]); sum += c; cnt += (c > 0u) ? 1u : 0u; mine = (j == x) ? c : mine; }
        if (sum == G) break;
        __builtin_amdgcn_s_sleep(1);
        if ((++sp & 255u) == 0u) { if (xb_ld(&bar[XB_TMO])) break; if (sp > XB_SPIN_CAP) { atomicAdd(&bar[XB_TMO], 1u); break; } }
    }
    nloc = mine > 0u ? mine : 1u; nx = cnt > 0u ? cnt : 1u;
}
__device__ __forceinline__ void xcd_barrier(const XcdBarrier& b) {
    asm volatile("s_waitcnt vmcnt(0)" ::: "memory");
    __syncthreads();
    if (threadIdx.x == 0) {
        unsigned* bar = b.bar;
        __builtin_amdgcn_s_waitcnt(0);
        unsigned nloc = b.st[0], nx = b.st[1];
        if (nloc == 0u) { xcd_barrier_complete(bar, b.x, nloc, nx); b.st[0] = nloc; b.st[1] = nx; }
        const unsigned old = xb_add(&bar[XB_XSUB(b.x)], 1u);
        const unsigned gen = old / nloc;
        if (old + 1u == (gen + 1u) * nloc) {
            __builtin_amdgcn_fence(__ATOMIC_RELEASE, "agent");
            asm volatile("s_waitcnt vmcnt(0)" ::: "memory");
            const unsigned og = xb_add(&bar[XB_TOP], 1u);
            const unsigned tg = og / nx;
            if (og + 1u == (tg + 1u) * nx) xb_add(&bar[XB_TOPGEN], 1u);
            else XB_SPIN(xb_ld(&bar[XB_TOPGEN]) == tg, bar);
            __builtin_amdgcn_fence(__ATOMIC_ACQUIRE, "agent");
            xb_add(&bar[XB_XGEN(b.x)], 1u);
            asm volatile("s_waitcnt vmcnt(0)" ::: "memory");
        } else {
            XB_SPIN(xb_ld(&bar[XB_XGEN(b.x)]) == gen, bar);
            __builtin_amdgcn_fence(__ATOMIC_ACQUIRE, "agent");
            asm volatile("s_waitcnt vmcnt(0)" ::: "memory");
        }
    }
    __syncthreads();
}

struct Params {
    const float* x; const float* mem;
    const float* ffn1_norm; const float* ffn1_wg; const float* ffn1_wu; const float* ffn1_wd;
    const float* mix_norm; const float* w_in; const float* rel_bias; const float* w_pool; const float* pool_scale; const float* w_out;
    const float* cross_norm; const float* mem_norm; const float* w_cq; const float* w_ckv; const float* w_co;
    const float* ffn2_norm; const float* ffn2_wg; const float* ffn2_wu; const float* ffn2_wd; const float* final_norm;
    float* out; unsigned char* ws;
};

__device__ __forceinline__ void p0_transpose_item(const float* __restrict__ W, int K, int N, bf16_t* __restrict__ WT, int mode, int row_off, const float* __restrict__ gain, LAS float* scr, int item, int lane) {
    const int nblk = N / 32, kb = item / nblk, nb = item - kb * nblk, k0 = 64 * kb, n0 = 32 * nb;
#pragma unroll 8
    for (int i = 0; i < 32; ++i) { const int kk = 2 * i + (lane >> 5); const float gk = gain ? gain[k0 + kk] : 1.0f; scr[kk * 33 + (lane & 31)] = W[(size_t)(k0 + kk) * N + n0 + (lane & 31)] * gk; }
    asm volatile("s_waitcnt lgkmcnt(0)" ::: "memory");
    const int c = lane & 7;
    const int d0 = (mode == 0 || mode == 3) ? (row_off + n0) : ((n0 >> 7) * 256 + (n0 & 127) + (mode == 2 ? 128 : 0));
#pragma unroll
    for (int j = 0; j < 4; ++j) { const int n = (lane >> 3) + 8 * j; const LAS float* s = scr + (8 * c) * 33 + n;
        u32x4 o; o.x = cvt_pk_bf16(s[0 * 33], s[1 * 33]); o.y = cvt_pk_bf16(s[2 * 33], s[3 * 33]); o.z = cvt_pk_bf16(s[4 * 33], s[5 * 33]); o.w = cvt_pk_bf16(s[6 * 33], s[7 * 33]);
        if (mode == 3) *(u32x4*)(WT + ((size_t)(k0 >> 7) * N + (row_off + n0 + n)) * 128 + (k0 & 127) + 8 * c) = o;
        else *(u32x4*)(WT + (size_t)(d0 + n) * K + k0 + 8 * c) = o; }
    asm volatile("s_waitcnt lgkmcnt(0)" ::: "memory");
}

#define rowss ((float*)(P.ws + WS_ROWSS))
#define Wgu1 ((bf16_t*)(P.ws + WS_WGU1))
#define Wd1 ((bf16_t*)(P.ws + WS_WD1))
#define Win ((bf16_t*)(P.ws + WS_WIN))
#define Wp ((bf16_t*)(P.ws + WS_WP))
#define Wout ((bf16_t*)(P.ws + WS_WOUT))
#define Wcq ((bf16_t*)(P.ws + WS_WCQ))
#define Wckv ((bf16_t*)(P.ws + WS_WCKV))
#define Wco ((bf16_t*)(P.ws + WS_WCO))
#define Wgu2 ((bf16_t*)(P.ws + WS_WGU2))
#define Wd2 ((bf16_t*)(P.ws + WS_WD2))
#define HB ((bf16_t*)(P.ws + WS_HB))
#define ACT ((bf16_t*)(P.ws + WS_ACT))
#define Z ((bf16_t*)(P.ws + WS_Z))
#define VT ((bf16_t*)(P.ws + WS_VT))
#define Y ((bf16_t*)(P.ws + WS_Y))
#define CQ ((bf16_t*)(P.ws + WS_CQ))
#define CO ((bf16_t*)(P.ws + WS_CO))
#define DP ((bf16_t*)(P.ws + WS_DP))
#define MEMN ((bf16_t*)(P.ws + WS_MEMN))
#define KC ((bf16_t*)(P.ws + WS_KC))
#define VCT ((bf16_t*)(P.ws + WS_VCT))
#define KF ((bf16_t*)(P.ws + WS_KF))
constexpr int I_G = (DM / 64) * (DFF / 32), I_D = (DFF / 64) * (DM / 32), I_IN = (DM / 64) * (DIN / 32), I_P = (256 / 64) * (256 / 32), I_O = (DM / 64) * (DM / 32),
              I_CQ = (DM / 64) * (DCROSS / 32), I_CKV = (DM / 64) * (2 * DCROSS / 32), I_CO = (DCROSS / 64) * (DM / 32);
constexpr int N_EARLY = 2 * I_G + I_D + I_IN + 4 * I_P + I_CKV, NITEMS = N_EARLY + 2 * I_G + I_D + I_O + I_CQ + I_CO;
#define CONVERT_ITEM(it_, lane) do { int r = (it_); \
        if (r < I_G) { p0_transpose_item(P.ffn1_wg, DM, DFF, Wgu1, 1, 0, P.ffn1_norm, scr, r, lane); break; } r -= I_G; \
        if (r < I_G) { p0_transpose_item(P.ffn1_wu, DM, DFF, Wgu1, 2, 0, P.ffn1_norm, scr, r, lane); break; } r -= I_G; \
        if (r < I_D) { p0_transpose_item(P.ffn1_wd, DFF, DM, Wd1, 3, 0, nullptr, scr, r, lane); break; } r -= I_D; \
        if (r < I_IN) { p0_transpose_item(P.w_in, DM, DIN, Win, 0, 0, P.mix_norm, scr, r, lane); break; } r -= I_IN; \
        if (r < 4 * I_P) { const int gi = r / I_P; p0_transpose_item(P.w_pool + (size_t)gi * 65536, 256, 256, Wp, 0, gi * 256, nullptr, scr, r - gi * I_P, lane); break; } r -= 4 * I_P; \
        if (r < I_CKV) { p0_transpose_item(P.w_ckv, DM, 2 * DCROSS, Wckv, 0, 0, nullptr, scr, r, lane); break; } r -= I_CKV; \
        if (r < I_G) { p0_transpose_item(P.ffn2_wg, DM, DFF, Wgu2, 1, 0, P.ffn2_norm, scr, r, lane); break; } r -= I_G; \
        if (r < I_G) { p0_transpose_item(P.ffn2_wu, DM, DFF, Wgu2, 2, 0, P.ffn2_norm, scr, r, lane); break; } r -= I_G; \
        if (r < I_D) { p0_transpose_item(P.ffn2_wd, DFF, DM, Wd2, 3, 0, nullptr, scr, r, lane); break; } r -= I_D; \
        if (r < I_O) { p0_transpose_item(P.w_out, DM, DM, Wout, 0, 0, nullptr, scr, r, lane); break; } r -= I_O; \
        if (r < I_CQ) { p0_transpose_item(P.w_cq, DM, DCROSS, Wcq, 0, 0, P.cross_norm, scr, r, lane); break; } r -= I_CQ; \
        p0_transpose_item(P.w_co, DCROSS, DM, Wco, 0, 0, nullptr, scr, r, lane); } while (0)
__global__ void __launch_bounds__(512, 2) fwd_megakernel(Params P) {
    extern __shared__ __attribute__((aligned(16))) unsigned char lds_raw[];
    cg::grid_group grid = cg::this_grid();
    LAS unsigned char* lds = (LAS unsigned char*)lds_raw;
    const int tid = threadIdx.x, lane = tid & 63, wave = __builtin_amdgcn_readfirstlane(tid >> 6);
    const int G = gridDim.x, bx = blockIdx.x;
    const int gw = bx * 8 + wave, NGW = G * 8;
    volatile LAS unsigned* bst = (volatile LAS unsigned*)(lds + 131072 + 64);
    if (tid < 2) bst[tid] = 0u;
    __syncthreads();
    const XcdBarrier xbar = xcd_barrier_post((unsigned*)(P.ws + WS_BAR), bst);
#ifndef WGM_RES
#define WGM_RES 8
#endif
#ifndef REV_DOWN
#define REV_DOWN 1
#endif
#define RUN_GEMM_ON(EPI, gM, gN, gdesc, edesc, G_, c_) do { pg8::StaticOrder S_; S_.init((gM), (gN), (G_), (c_), ((gN) == DM) ? WGM_RES : 8); pg8::gemm_phase<EPI>(lds, (gdesc), S_, (edesc)); } while (0)
#define RUN_GEMM(EPI, gM, gN, gdesc, edesc) RUN_GEMM_ON(EPI, gM, gN, gdesc, edesc, G, bx)
#ifndef AUX_DOWN
#define AUX_DOWN 0
#endif
#define RUN_GEMM_NT(EPI, gM, gN, gdesc, edesc) do { pg8::StaticOrder S_; S_.init((gM), (gN), G, bx, ((gN) == DM) ? WGM_RES : 8, REV_DOWN); pg8::gemm_phase<EPI, true, AUX_DOWN>(lds, (gdesc), S_, (edesc)); } while (0)

    for (int rep_ = 0; rep_ < REP_P0; ++rep_) {
        LAS float* scr = (LAS float*)(lds + wave * 16384);
        for (int it = gw; it < N_EARLY; it += NGW) CONVERT_ITEM(it, lane);
        for (int i = bx * 512 + tid; i < 4 * MTOK; i += G * 512) rowss[MTOK + i] = 0.f;
        for (int m = gw; m < MTOK; m += NGW) {
            const f32x4* xr = (const f32x4*)(P.x + (size_t)m * DM) + lane; u32x2* o8 = (u32x2*)(HB + (size_t)m * DM) + lane; float s = 0.f;
#pragma unroll
            for (int j = 0; j < 8; ++j) { const f32x4 v = xr[64 * j]; s += (v[0] * v[0] + v[1] * v[1]) + (v[2] * v[2] + v[3] * v[3]); u32x2 w; w.x = cvt_pk_bf16(v[0], v[1]); w.y = cvt_pk_bf16(v[2], v[3]); o8[64 * j] = w; }
            s = wave_sum(s); if (lane == 0) rowss[m] = s;
        }
        for (int m = gw; m < BATCH * NMEM; m += NGW) {
            const f32x4* xr = (const f32x4*)(P.mem + (size_t)m * DM) + lane; const f32x4* gr = (const f32x4*)P.mem_norm + lane; u32x2* o8 = (u32x2*)(MEMN + (size_t)m * DM) + lane;
            f32x4 v[8]; float s = 0.f;
#pragma unroll
            for (int j = 0; j < 8; ++j) { v[j] = xr[64 * j]; s += (v[j][0] * v[j][0] + v[j][1] * v[j][1]) + (v[j][2] * v[j][2] + v[j][3] * v[j][3]); }
            const float rs = __builtin_amdgcn_rsqf(wave_sum(s) * (1.0f / DM) + EPS);
#pragma unroll
            for (int j = 0; j < 8; ++j) { const f32x4 gg = gr[64 * j]; const f32x4 y = v[j] * rs * gg; u32x2 w; w.x = cvt_pk_bf16(y[0], y[1]); w.y = cvt_pk_bf16(y[2], y[3]); o8[64 * j] = w; }
        }
    }
    grid.sync();
    for (int rep_ = 0; rep_ < REP_G1; ++rep_)
    RUN_GEMM(pg8::EpiSwiglu, MTOK, 2 * DFF, (pg8::Gemm{HB, Wgu1, DM, DM, DM, 0}), (pg8::EpiSwiglu{ACT, DFF, rowss}));
    for (int rep_ = 0; rep_ < REP_G1NULL; ++rep_)
    RUN_GEMM(pg8::EpiNull, MTOK, 2 * DFF, (pg8::Gemm{HB, Wgu1, DM, DM, DM, 0}), (pg8::EpiNull{}));
    for (int rep_ = 0; rep_ < REP_SYNC; ++rep_) grid.sync();
    xcd_barrier(xbar);
    for (int rep_ = 0; rep_ < REP_G2NULL; ++rep_)
    RUN_GEMM(pg8::EpiNull, MTOK, DM, (pg8::Gemm{ACT, Wd1, 128, 128, DFF, 0, (size_t)0, (size_t)DM * 256}), (pg8::EpiNull{}));
    for (int rep_ = 0; rep_ < REP_G2; ++rep_)
    RUN_GEMM(pg8::EpiRes<true>, MTOK, DM, (pg8::Gemm{ACT, Wd1, 128, 128, DFF, 0, (size_t)MTOK * 256, (size_t)DM * 256}), (pg8::EpiRes<true>{P.x, HB, nullptr, 0.5f}));
    RUN_GEMM_NT(pg8::EpiRes<true>, MTOK, DM, (pg8::Gemm{ACT, Wd1, 128, 128, DFF, 0, (size_t)MTOK * 256, (size_t)DM * 256}), (pg8::EpiRes<true>{P.x, HB, rowss + 1 * MTOK, 0.5f}));
    xcd_barrier(xbar);
    for (int rep_ = 0; rep_ < REP_G3; ++rep_)
    RUN_GEMM(pg8::EpiBf<64>, MTOK, DIN, (pg8::Gemm{HB, Win, DM, DM, DM, 0}), (pg8::EpiBf<64>{Z, DIN, 0, rowss + 1 * MTOK, nullptr, 8, 12, SEQ, DATT, VT, 4, 8, KF}));
    xcd_barrier(xbar);
    for (int rep_ = 0; rep_ < REP_ATT; ++rep_) {
        for (int task = gw; task < (MTOK / 64) * 4; task += NGW) {
            const int gi = task & 3, rt = task >> 2, sub = lane >> 5, cgi = lane & 31, w = 2 << gi;
            const int t0 = rt * 64 + sub * 32, tpos = t0 & (SEQ - 1);
            const bf16_t* up = Z + (size_t)t0 * DIN + 3 * DATT + gi * 256 + cgi * 8;
            bf16_t* dp = DP + (size_t)t0 * DPOOL + gi * 256 + cgi * 8;
            float sum[8];
#pragma unroll
            for (int e = 0; e < 8; ++e) sum[e] = 0.f;
            for (int i = 1; i < w; ++i) if (tpos - i >= 0) { const u32x4 v = *(const u32x4*)(up - (size_t)i * DIN);
                sum[0] += bf_lo(v.x); sum[1] += bf_hi(v.x); sum[2] += bf_lo(v.y); sum[3] += bf_hi(v.y); sum[4] += bf_lo(v.z); sum[5] += bf_hi(v.z); sum[6] += bf_lo(v.w); sum[7] += bf_hi(v.w); }
#pragma nounroll
            for (int r0 = 0; r0 < 32; r0 += 8) {
                u32x4 cv[8], ov[8];
#pragma unroll
                for (int j = 0; j < 8; ++j) cv[j] = *(const u32x4*)(up + (size_t)(r0 + j) * DIN);
#pragma unroll
                for (int j = 0; j < 8; ++j) { const int rr = r0 + j - w + 1; ov[j] = (tpos + rr >= 0) ? *(const u32x4*)(up + (ptrdiff_t)rr * DIN) : (u32x4){0u, 0u, 0u, 0u}; }
#pragma unroll
                for (int j = 0; j < 8; ++j) {
                    const u32x4 v = cv[j], q = ov[j];
                    const float cur[8] = {bf_lo(v.x), bf_hi(v.x), bf_lo(v.y), bf_hi(v.y), bf_lo(v.z), bf_hi(v.z), bf_lo(v.w), bf_hi(v.w)};
                    const float old[8] = {bf_lo(q.x), bf_hi(q.x), bf_lo(q.y), bf_hi(q.y), bf_lo(q.z), bf_hi(q.z), bf_lo(q.w), bf_hi(q.w)};
                    const int have = tpos + r0 + j + 1; const float inv = 1.0f / (float)(have < w ? have : w);
                    float d[8];
#pragma unroll
                    for (int e = 0; e < 8; ++e) { sum[e] += cur[e]; d[e] = sum[e] * inv - cur[e]; sum[e] -= old[e]; }
                    u32x4 o; o.x = cvt_pk_bf16(d[0], d[1]); o.y = cvt_pk_bf16(d[2], d[3]); o.z = cvt_pk_bf16(d[4], d[5]); o.w = cvt_pk_bf16(d[6], d[7]);
                    *(u32x4*)(dp + (size_t)(r0 + j) * DPOOL) = o;
                }
            }
        }
        LAS float* tab = (LAS float*)lds;
        for (int bh = bx; bh < BATCH * 16; bh += G) {
            const int b = bh >> 4, h = bh & 15;
            __syncthreads();
            for (int i = tid; i < 704; i += 512) { int rel = i - 63; rel = rel < -128 ? -128 : (rel > 128 ? 128 : rel); tab[i] = P.rel_bias[h * NREL + rel + 128] * LOG2E; }
            __syncthreads();
            const bool first = (bh == bx);
#pragma nounroll
            for (int stage = 0; stage < 2; ++stage) {
                const bool do_att = first ? ((((wave >> 2) & 1) == stage)) : (stage == 0);
                if (do_att) {
#pragma nounroll
                    for (int i = 0; i < 8; ++i) {
                        const int c = i * 4 + (wave >> 1), half = wave & 1, j0 = c < 8 ? 8 - c : 0, kstart = (c - 8 + j0) * 64;
                        const size_t qrow = (size_t)b * SEQ + c * 64 + half * 32;
                        attn_wave32<64, true, 2, true, true>(Z + qrow * DIN + h * 64, DIN, KF + ((size_t)(b * 16 + h) * SEQ + kstart) * 64, 0,
                                              VT + ((size_t)(b * 16 + h) * SEQ + kstart) * 64, 0, Y + qrow * DM + h * 64, DM, 9 - j0, 0.125f * LOG2E, tab, half * 32 + (8 - j0) * 64, lane);
                    }
                } else if (first) {
                    int ln = threadIdx.x & 63; asm volatile("" : "+v"(ln));
                    LAS float* scr2 = (LAS float*)(lds + 4096 + wave * 8448);
#define scr scr2
#pragma nounroll
                    for (int it = N_EARLY + gw; it < NITEMS; it += NGW) CONVERT_ITEM(it, ln);
#undef scr
                }
            }
        }
        __syncthreads();
    }
    xcd_barrier(xbar);
    if (G >= 128 && bx < 64) {
        RUN_GEMM_ON(pg8::EpiBf<128>, BATCH * NMEM, 2 * DCROSS, (pg8::Gemm{MEMN, Wckv, DM, DM, DM, 0}), (pg8::EpiBf<128>{KC, DCROSS, 0, nullptr, nullptr, 2, 4, NMEM, DCROSS, VCT, 0, 2, KC}), 64, bx);
    } else if (G >= 128) {
        RUN_GEMM_ON(pg8::EpiBf<0>, MTOK, DPOOL, (pg8::Gemm{DP, Wp, DPOOL, 256, 256, 512}), (pg8::EpiBf<0>{Y, DM, DATT, nullptr, P.pool_scale, 0, 0, 1, 1, nullptr, 0, 0, nullptr}), G - 64, bx - 64);
    } else {
        RUN_GEMM(pg8::EpiBf<128>, BATCH * NMEM, 2 * DCROSS, (pg8::Gemm{MEMN, Wckv, DM, DM, DM, 0}), (pg8::EpiBf<128>{KC, DCROSS, 0, nullptr, nullptr, 2, 4, NMEM, DCROSS, VCT, 0, 2, KC}));
        RUN_GEMM(pg8::EpiBf<0>, MTOK, DPOOL, (pg8::Gemm{DP, Wp, DPOOL, 256, 256, 512}), (pg8::EpiBf<0>{Y, DM, DATT, nullptr, P.pool_scale, 0, 0, 1, 1, nullptr, 0, 0, nullptr}));
    }
    xcd_barrier(xbar);
    RUN_GEMM(pg8::EpiRes<false>, MTOK, DM, (pg8::Gemm{Y, Wout, DM, DM, DM, 0}), (pg8::EpiRes<false>{nullptr, HB, rowss + 2 * MTOK, 1.0f}));
    xcd_barrier(xbar);
    RUN_GEMM(pg8::EpiBf<0>, MTOK, DCROSS, (pg8::Gemm{HB, Wcq, DM, DM, DM, 0}), (pg8::EpiBf<0>{CQ, DCROSS, 0, rowss + 2 * MTOK, nullptr, 0, 0, 1, 1, nullptr, 0, 0, nullptr}));
    xcd_barrier(xbar);
    for (int rep_ = 0; rep_ < REP_XATT; ++rep_) {
        for (int it = bx; it < BATCH * 16; it += G) {
            const int b = it >> 4, sub = it & 15;
#pragma nounroll
            for (int r = 0; r < 4; ++r) {
                const int wu = r * 8 + wave, head = wu & 3, qblk = wu >> 2;
                const size_t qrow = (size_t)b * SEQ + sub * 128 + qblk * 16;
#ifndef NO_ATT9
                attn_wave32<128, false, 1, true, true, false>(CQ + qrow * DCROSS + head * 128, DCROSS, KC + (size_t)(b * 4 + head) * NMEM * 128, 0,
                                        VCT + (size_t)(b * 4 + head) * NMEM * 128, 0, CO + qrow * DCROSS + head * 128, DCROSS, 4, 0.08838834764831845f * LOG2E, nullptr, 0, lane);
#endif
            }
        }
    }
    xcd_barrier(xbar);
    RUN_GEMM(pg8::EpiRes<false>, MTOK, DM, (pg8::Gemm{CO, Wco, DCROSS, DCROSS, DCROSS, 0}), (pg8::EpiRes<false>{nullptr, HB, rowss + 3 * MTOK, 1.0f}));
    xcd_barrier(xbar);
    RUN_GEMM(pg8::EpiSwiglu, MTOK, 2 * DFF, (pg8::Gemm{HB, Wgu2, DM, DM, DM, 0}), (pg8::EpiSwiglu{ACT, DFF, rowss + 3 * MTOK}));
    xcd_barrier(xbar);
    RUN_GEMM_NT(pg8::EpiRes<false>, MTOK, DM, (pg8::Gemm{ACT, Wd2, 128, 128, DFF, 0, (size_t)MTOK * 256, (size_t)DM * 256}), (pg8::EpiRes<false>{nullptr, HB, rowss + 4 * MTOK, 0.5f}));
    xcd_barrier(xbar);
    {
        const float* rs4 = rowss + 4 * MTOK;
        for (int m = gw; m < MTOK; m += NGW) {
            const u32x2* hr = (const u32x2*)(HB + (size_t)m * DM) + lane; f32x4* xr = (f32x4*)(P.out + (size_t)m * DM) + lane; const f32x4* gr = (const f32x4*)P.final_norm + lane;
            const float rs = __builtin_amdgcn_rsqf(rs4[m] * (1.0f / DM) + EPS);
#pragma unroll
            for (int j = 0; j < 8; ++j) { const u32x2 q = hr[64 * j]; const f32x4 v = (f32x4){bf_lo(q.x), bf_hi(q.x), bf_lo(q.y), bf_hi(q.y)}; xr[64 * j] = v * rs * gr[64 * j]; }
        }
    }
#undef RUN_GEMM
#undef RUN_GEMM_ON
#undef RUN_GEMM_NT
}

extern "C" void kernel_launch(void* const* d_in, const int* in_sizes, int n_in, void* d_out, int out_size, void* d_ws, size_t ws_size, hipStream_t stream) {
    static int grid_blocks = 0;
    if (grid_blocks == 0) {
        if (n_in != 22 || in_sizes[0] != MTOK * DM || out_size != MTOK * DM || ws_size < WS_END) {
            fprintf(stderr, "kernel_launch: unexpected shapes (n_in %d, in0 %d, out %d, ws %zu)\n", n_in, n_in > 0 ? in_sizes[0] : -1, out_size, ws_size); grid_blocks = -1; return; }
        int dev = 0, cus = 0, per_cu = 0;
        hipGetDevice(&dev);
        hipDeviceGetAttribute(&cus, hipDeviceAttributeMultiprocessorCount, dev);
        if (hipFuncSetAttribute((const void*)fwd_megakernel, hipFuncAttributeMaxDynamicSharedMemorySize, LDS_BYTES) != hipSuccess) { fprintf(stderr, "kernel_launch: hipFuncSetAttribute failed\n"); grid_blocks = -1; return; }
        if (hipOccupancyMaxActiveBlocksPerMultiprocessor(&per_cu, (const void*)fwd_megakernel, 512, LDS_BYTES) != hipSuccess || per_cu < 1) { fprintf(stderr, "kernel_launch: occupancy query gave %d\n", per_cu); per_cu = 1; }
        (void)hipGetLastError();
        grid_blocks = cus * per_cu;
    }
    if (grid_blocks < 0) return;
    Params p{};
    const float* const* in = (const float* const*)d_in;
    p.x = in[0]; p.mem = in[1]; p.ffn1_norm = in[2]; p.ffn1_wg = in[3]; p.ffn1_wu = in[4]; p.ffn1_wd = in[5]; p.mix_norm = in[6]; p.w_in = in[7]; p.rel_bias = in[8];
    p.w_pool = in[9]; p.pool_scale = in[10]; p.w_out = in[11]; p.cross_norm = in[12]; p.mem_norm = in[13]; p.w_cq = in[14]; p.w_ckv = in[15]; p.w_co = in[16];
    p.ffn2_norm = in[17]; p.ffn2_wg = in[18]; p.ffn2_wu = in[19]; p.ffn2_wd = in[20]; p.final_norm = in[21];
    p.out = (float*)d_out; p.ws = (unsigned char*)d_ws;
    if (hipMemsetAsync((char*)d_ws + WS_BAR, 0, WS_BAR_BYTES, stream) != hipSuccess) { fprintf(stderr, "kernel_launch: memset of the barrier words failed\n"); return; }
    void* args[] = {&p};
    hipError_t e = hipLaunchCooperativeKernel((const void*)fwd_megakernel, dim3(grid_blocks), dim3(512), args, LDS_BYTES, stream);
    if (e != hipSuccess) fprintf(stderr, "cooperative launch failed: %s (grid %d)\n", hipGetErrorString(e), grid_blocks);
}
```

```cpp
#include <hip/hip_runtime.h>
#include <hip/hip_cooperative_groups.h>
#include <cstdio>
#include <cstdint>
namespace cg = cooperative_groups;

#define LAS __attribute__((address_space(3)))
typedef unsigned short bf16_t;
typedef short bf16x8 __attribute__((ext_vector_type(8)));
typedef float f32x4 __attribute__((ext_vector_type(4)));
typedef float f32x2 __attribute__((ext_vector_type(2)));
typedef unsigned u32x4 __attribute__((ext_vector_type(4)));
typedef unsigned u32x2 __attribute__((ext_vector_type(2)));

constexpr int BATCH = 16, SEQ = 2048, DM = 2048, MTOK = BATCH * SEQ;
constexpr int DFF = 5632, DIN = 4096, DATT = 1024, DPOOL = 1024, NMEM = 256, DCROSS = 512;
constexpr int NREL = 257;
constexpr float EPS = 1e-6f;
constexpr float LOG2E = 1.4426950408889634f;

constexpr size_t MiB = 1u << 20;
constexpr size_t WS_ROWSS = 0;
constexpr size_t WS_BAR = 896 * 1024, WS_BAR_BYTES = 49152, WS_PCNT = WS_BAR + 16384;
constexpr size_t WS_WGU1 = 1 * MiB, WS_WD1 = 45 * MiB, WS_WIN = 67 * MiB, WS_WP = 83 * MiB, WS_WOUT = 84 * MiB, WS_WCQ = 92 * MiB,
                 WS_WCKV = 94 * MiB, WS_WCO = 98 * MiB, WS_WGU2 = 100 * MiB, WS_WD2 = 144 * MiB;
constexpr size_t WS_HB = 166 * MiB;
constexpr size_t WS_ACT = 294 * MiB;
constexpr size_t WS_Z = 294 * MiB;
constexpr size_t WS_VT = 550 * MiB;
constexpr size_t WS_Y = 646 * MiB;
constexpr size_t WS_CQ = 646 * MiB, WS_CO = 678 * MiB;
constexpr size_t WS_DP = 774 * MiB;
constexpr size_t WS_MEMN = 838 * MiB;
constexpr size_t WS_KC = 854 * MiB;
constexpr size_t WS_VCT = 858 * MiB;
constexpr size_t WS_KF = 862 * MiB;
constexpr size_t WS_END = 926 * MiB;

#ifndef REP_G1NULL
#define REP_G1NULL 0
#endif
#ifndef REP_SYNC
#define REP_SYNC 0
#endif
#ifndef REP_G2
#define REP_G2 0
#endif
#ifndef REP_G2NULL
#define REP_G2NULL 0
#endif
#ifndef REP_ATTC
#define REP_ATTC 0
#endif
#ifndef REP_XATT
#define REP_XATT 1
#endif
#ifndef REP_P0
#define REP_P0 1
#endif
#ifndef REP_G1
#define REP_G1 1
#endif
#ifndef REP_ATT
#define REP_ATT 1
#endif
#ifndef REP_G3
#define REP_G3 1
#endif
constexpr int LDS_BYTES = 147456;

__device__ __forceinline__ unsigned cvt_pk_bf16(float lo, float hi) { unsigned r; asm volatile("v_cvt_pk_bf16_f32 %0, %1, %2" : "=v"(r) : "v"(lo), "v"(hi)); return r; }
__device__ __forceinline__ float bf_lo(unsigned w) { return __uint_as_float(w << 16); }
__device__ __forceinline__ float bf_hi(unsigned w) { return __uint_as_float(w & 0xffff0000u); }
__device__ __forceinline__ float wave_sum(float v) {
#pragma unroll
    for (int o = 1; o < 64; o <<= 1) v += __shfl_xor(v, o);
    return v;
}

namespace pg8 {
constexpr int BM = 256, BK = 64, HALF = 128, HTB = HALF * BK * 2, STAGE_BYTES = 8 * HTB, NXCD = 8;
__host__ __device__ __forceinline__ int lds_byte(int r, int c) { const int st = (r >> 4) * 2 + (c >> 5), rr = r & 15, cc = c & 31, ob = rr * 64 + cc * 2; return st * 1024 + (ob ^ (((ob >> 9) & 1) << 5)); }
__host__ __device__ __forceinline__ void stage_rc(int b, int& R, int& C) { const int st = b / 1024, sb = b % 1024, swz = sb ^ (((sb >> 9) & 1) << 5); R = (st >> 1) * 16 + swz / 64; C = (st & 1) * 32 + (swz % 64) / 2; }
__host__ __device__ __forceinline__ int perm32(int rho) { const int n = rho >> 4, i = rho & 15; return 8 * (i >> 2) + 4 * n + (i & 3); }

struct Unit { int pm, pn; };
struct Gemm { const bf16_t* A; const bf16_t* Bt; int lda, ldb, K, a_pn_step; size_t kblkA = 256, kblkB = 256; };

struct StaticOrder {
    int nM, nN, nwg, G, c, WGM, rev;
    __device__ void init(int M, int N, int G_, int c_, int wgm = 8, int rev_ = 0) { nM = M / BM; nN = N / BM; nwg = nM * nN; G = G_; c = c_; WGM = wgm; rev = rev_; }
    __device__ bool next(int i, Unit& u) const {
        const int nr = (nwg + G - 1) / G; if (i >= nr) return false;
        long L = (long)(rev ? nr - 1 - i : i) * G + c;
        if (L >= nwg) { if (!rev) return false; L = (long)(nr - 2 - i) * G + c; if (i + 1 >= nr) return false; }
        int wgid = (int)L; { const int q = nwg / NXCD, r = nwg % NXCD, xcd = wgid % NXCD, off = wgid / NXCD; wgid = (xcd < r ? xcd * (q + 1) : r * (q + 1) + (xcd - r) * q) + off; }
        const int nig = WGM * nN, gid = wgid / nig, fm = gid * WGM, gsz = (nM - fm) < WGM ? (nM - fm) : WGM;
        u.pm = fm + ((wgid % nig) % gsz); u.pn = (wgid % nig) / gsz; return true;
    }
};

template <int FMD> struct EpiBf {
    bf16_t* O; int ldc; int col_off; const float* rowss; const float* colscale; int t_lo, t_hi, t_rows, t_cols; bf16_t* VT; int k_lo, k_hi; bf16_t* KF;
    __device__ __forceinline__ void operator()(const f32x4 (&acc)[2][2][4][2], const Unit& u, int wr, int wc, int fr, int fq) const {
        const int row0 = u.pm * BM + wr * 64 + fr, cl = wc * 32 + 8 * fq;
        const bool tr = (u.pn >= t_lo) && (u.pn < t_hi);
        constexpr bool FM = FMD != 0;
        constexpr int FDH = FM ? FMD : 64, FKS = FDH / 32, FROWS = (FMD == 128) ? NMEM : SEQ, FNH = (FMD == 128) ? 4 : 16, FTPB = FROWS / 64;
        const bool kfm = FM && (u.pn >= k_lo) && (u.pn < k_hi);
        f32x4 cs[2][2]; float rsv[8];
#pragma unroll
        for (int bj = 0; bj < 2; ++bj)
#pragma unroll
            for (int n = 0; n < 2; ++n) cs[bj][n] = colscale ? *(const f32x4*)(colscale + u.pn * BM + bj * HALF + cl + 4 * n) : (f32x4){1.f, 1.f, 1.f, 1.f};
#pragma unroll
        for (int i = 0; i < 8; ++i) rsv[i] = rowss ? rowss[row0 + (i >> 2) * HALF + (i & 3) * 16] : 0.f;
        asm volatile("" ::: "memory");
#pragma unroll
        for (int ai = 0; ai < 2; ++ai)
#pragma unroll
            for (int m = 0; m < 4; ++m) {
                const int row = row0 + ai * HALF + m * 16;
                const float rsc = rowss ? __builtin_amdgcn_rsqf(rsv[ai * 4 + m] * (1.0f / DM) + EPS) : 1.0f;
#pragma unroll
                for (int bj = 0; bj < 2; ++bj) {
                    const f32x4 v0 = acc[ai][bj][m][0] * rsc * cs[bj][0], v1 = acc[ai][bj][m][1] * rsc * cs[bj][1];
                    u32x4 w; w.x = cvt_pk_bf16(v0[0], v0[1]); w.y = cvt_pk_bf16(v0[2], v0[3]); w.z = cvt_pk_bf16(v1[0], v1[1]); w.w = cvt_pk_bf16(v1[2], v1[3]);
                    if (FM && (kfm || tr)) {
                        const int c = (u.pn - (kfm ? k_lo : t_lo)) * BM + bj * HALF + cl, hh = c / FDH, d = c % FDH;
                        const int bb = row / FROWS, s = row % FROWS, tile = s >> 6, k = s & 63;
                        const size_t tbase = ((size_t)((bb * FNH + hh) * FTPB + tile)) * (64 * FDH);
                        if (kfm) {
                            const int kb = k >> 5, r = k & 31, mt = kb * 2 + ((r >> 2) & 1), fra = (r >> 3) * 4 + (r & 3), ks = d >> 5, fqa = (d >> 3) & 3;
                            *(u32x4*)(KF + tbase + ((mt * FKS + ks) * 64 + fqa * 16 + fra) * 8) = w;
                        } else {
                            const int dt = d >> 4, fra0 = d & 15, kb = k >> 5, fqa = (k & 31) >> 3, e8 = k & 7;
                            bf16_t* p = VT + tbase + ((dt * 2 + kb) * 64 + fqa * 16 + fra0) * 8 + e8;
                            p[0] = (bf16_t)(w.x & 0xffffu); p[8] = (bf16_t)(w.x >> 16); p[16] = (bf16_t)(w.y & 0xffffu); p[24] = (bf16_t)(w.y >> 16);
                            p[32] = (bf16_t)(w.z & 0xffffu); p[40] = (bf16_t)(w.z >> 16); p[48] = (bf16_t)(w.w & 0xffffu); p[56] = (bf16_t)(w.w >> 16);
                        }
                    } else if (!tr) { *(u32x4*)(O + (size_t)row * ldc + col_off + u.pn * BM + bj * HALF + cl) = w; }
                    else {
                        const int cv = (u.pn - t_lo) * BM + bj * HALF + cl, b = row / t_rows, s = row - b * t_rows;
                        bf16_t* p = VT + ((size_t)b * t_cols + cv) * t_rows + s;
                        p[0] = (bf16_t)(w.x & 0xffffu); p[(size_t)t_rows] = (bf16_t)(w.x >> 16); p[(size_t)2 * t_rows] = (bf16_t)(w.y & 0xffffu); p[(size_t)3 * t_rows] = (bf16_t)(w.y >> 16);
                        p[(size_t)4 * t_rows] = (bf16_t)(w.z & 0xffffu); p[(size_t)5 * t_rows] = (bf16_t)(w.z >> 16); p[(size_t)6 * t_rows] = (bf16_t)(w.w & 0xffffu); p[(size_t)7 * t_rows] = (bf16_t)(w.w >> 16);
                    }
                }
            }
    }
};
__device__ __forceinline__ float silu_mul(float g, float u) { return g * __builtin_amdgcn_rcpf(1.0f + __expf(-g)) * u; }
struct EpiSwiglu {
    bf16_t* O; int ldc; const float* rowss;
    __device__ __forceinline__ void operator()(const f32x4 (&acc)[2][2][4][2], const Unit& u, int wr, int wc, int fr, int fq) const {
        const int row0 = u.pm * BM + wr * 64 + fr, cl = wc * 32 + 8 * fq;
        float rsv[8];
#pragma unroll
        for (int i = 0; i < 8; ++i) rsv[i] = rowss[row0 + (i >> 2) * HALF + (i & 3) * 16];
        asm volatile("" ::: "memory");
#pragma unroll
        for (int ai = 0; ai < 2; ++ai)
#pragma unroll
            for (int m = 0; m < 4; ++m) {
                const int row = row0 + ai * HALF + m * 16;
                const float rsc = __builtin_amdgcn_rsqf(rsv[ai * 4 + m] * (1.0f / DM) + EPS);
                const f32x4 g0 = acc[ai][0][m][0] * rsc, g1 = acc[ai][0][m][1] * rsc, u0 = acc[ai][1][m][0] * rsc, u1 = acc[ai][1][m][1] * rsc;
                u32x4 w;
                w.x = cvt_pk_bf16(silu_mul(g0[0], u0[0]), silu_mul(g0[1], u0[1])); w.y = cvt_pk_bf16(silu_mul(g0[2], u0[2]), silu_mul(g0[3], u0[3]));
                w.z = cvt_pk_bf16(silu_mul(g1[0], u1[0]), silu_mul(g1[1], u1[1])); w.w = cvt_pk_bf16(silu_mul(g1[2], u1[2]), silu_mul(g1[3], u1[3]));
                *(u32x4*)(O + ((size_t)u.pn * MTOK + row) * HALF + cl) = w;
            }
    }
};
template <bool F32IN> struct EpiRes {
    const float* hin_f; bf16_t* hb; float* rowss_out; float alpha;
    static constexpr int DEPTH = F32IN ? 2 : 4, NV = F32IN ? 4 : 2;
    __device__ __forceinline__ void ld(f32x4 (&hv)[4], size_t off) const {
        if (F32IN) { hv[0] = *(const f32x4*)(hin_f + off); hv[1] = *(const f32x4*)(hin_f + off + 4); hv[2] = *(const f32x4*)(hin_f + off + HALF); hv[3] = *(const f32x4*)(hin_f + off + HALF + 4); }
        else { hv[0] = __builtin_bit_cast(f32x4, *(const u32x4*)(hb + off)); hv[1] = __builtin_bit_cast(f32x4, *(const u32x4*)(hb + off + HALF)); }
    }
    __device__ __forceinline__ void operator()(const f32x4 (&acc)[2][2][4][2], const Unit& u, int wr, int wc, int fr, int fq) const {
        const int row0 = u.pm * BM + wr * 64 + fr, cl = u.pn * BM + wc * 32 + 8 * fq;
        f32x4 hv[DEPTH][4];
#pragma unroll
        for (int gi = 0; gi < DEPTH; ++gi) ld(hv[gi], (size_t)(row0 + (gi >> 2) * HALF + (gi & 3) * 16) * DM + cl);
#pragma unroll
        for (int gi = 0; gi < 8; ++gi) {
            const int ai = gi >> 2, m = gi & 3, cb = gi % DEPTH;
            asm volatile("" ::: "memory");
            const int row = row0 + ai * HALF + m * 16; const size_t off = (size_t)row * DM + cl;
            float ss = 0.f;
            u32x4 wv[2];
#pragma unroll
            for (int bj = 0; bj < 2; ++bj) {
                f32x4 o0, o1;
                if (F32IN) { o0 = hv[cb][2 * bj]; o1 = hv[cb][2 * bj + 1]; }
                else { const u32x4 q = __builtin_bit_cast(u32x4, hv[cb][bj]); o0 = (f32x4){bf_lo(q.x), bf_hi(q.x), bf_lo(q.y), bf_hi(q.y)}; o1 = (f32x4){bf_lo(q.z), bf_hi(q.z), bf_lo(q.w), bf_hi(q.w)}; }
                const f32x4 h0 = o0 + acc[ai][bj][m][0] * alpha, h1 = o1 + acc[ai][bj][m][1] * alpha;
                ss += (h0[0] * h0[0] + h0[1] * h0[1]) + (h0[2] * h0[2] + h0[3] * h0[3]) + (h1[0] * h1[0] + h1[1] * h1[1]) + (h1[2] * h1[2] + h1[3] * h1[3]);
                wv[bj].x = cvt_pk_bf16(h0[0], h0[1]); wv[bj].y = cvt_pk_bf16(h0[2], h0[3]); wv[bj].z = cvt_pk_bf16(h1[0], h1[1]); wv[bj].w = cvt_pk_bf16(h1[2], h1[3]);
            }
            if (gi + DEPTH < 8) ld(hv[cb], (size_t)(row0 + ((gi + DEPTH) >> 2) * HALF + ((gi + DEPTH) & 3) * 16) * DM + cl);
            *(u32x4*)(hb + off) = wv[0]; *(u32x4*)(hb + off + HALF) = wv[1];
            ss += __shfl_xor(ss, 16); ss += __shfl_xor(ss, 32);
            if (rowss_out && fq == 0) __hip_atomic_fetch_add(rowss_out + row, ss, __ATOMIC_RELAXED, __HIP_MEMORY_SCOPE_AGENT);
        }
    }
};

struct EpiResFinal {
    bf16_t* hb; float* rowss_out; float alpha; float* out; const float* gain; unsigned* cnt;
    __device__ __forceinline__ void operator()(f32x4 (&acc)[2][2][4][2], const Unit& u, int wr, int wc, int fr, int fq) const {
        const int row0 = u.pm * BM + wr * 64 + fr, cl = u.pn * BM + wc * 32 + 8 * fq;
        u32x4 hv[4][2];
#pragma unroll
        for (int gi = 0; gi < 4; ++gi) { const size_t off = (size_t)(row0 + (gi >> 2) * HALF + (gi & 3) * 16) * DM + cl; hv[gi][0] = *(const u32x4*)(hb + off); hv[gi][1] = *(const u32x4*)(hb + off + HALF); }
#pragma unroll
        for (int gi = 0; gi < 8; ++gi) {
            const int ai = gi >> 2, m = gi & 3, cb = gi & 3;
            asm volatile("" ::: "memory");
            const int row = row0 + ai * HALF + m * 16;
            float ss = 0.f;
#pragma unroll
            for (int bj = 0; bj < 2; ++bj) {
                const u32x4 q = hv[cb][bj];
                const f32x4 h0 = (f32x4){bf_lo(q.x), bf_hi(q.x), bf_lo(q.y), bf_hi(q.y)} + acc[ai][bj][m][0] * alpha, h1 = (f32x4){bf_lo(q.z), bf_hi(q.z), bf_lo(q.w), bf_hi(q.w)} + acc[ai][bj][m][1] * alpha;
                ss += (h0[0] * h0[0] + h0[1] * h0[1]) + (h0[2] * h0[2] + h0[3] * h0[3]) + (h1[0] * h1[0] + h1[1] * h1[1]) + (h1[2] * h1[2] + h1[3] * h1[3]);
                acc[ai][bj][m][0] = h0; acc[ai][bj][m][1] = h1;
            }
            if (gi + 4 < 8) { const size_t offn = (size_t)(row0 + ((gi + 4) >> 2) * HALF + ((gi + 4) & 3) * 16) * DM + cl; hv[cb][0] = *(const u32x4*)(hb + offn); hv[cb][1] = *(const u32x4*)(hb + offn + HALF); }
            ss += __shfl_xor(ss, 16); ss += __shfl_xor(ss, 32);
            if (fq == 0) __hip_atomic_fetch_add(rowss_out + row, ss, __ATOMIC_RELAXED, __HIP_MEMORY_SCOPE_AGENT);
        }
        asm volatile("s_waitcnt vmcnt(0)" ::: "memory");
        __builtin_amdgcn_s_barrier(); asm volatile("" ::: "memory");
        if (threadIdx.x == 0) {
            unsigned* c = cnt + 64 * u.pm;
            __hip_atomic_fetch_add(c, 1u, __ATOMIC_RELAXED, __HIP_MEMORY_SCOPE_AGENT);
            unsigned sp = 0;
            while (__hip_atomic_load(c, __ATOMIC_RELAXED, __HIP_MEMORY_SCOPE_AGENT) < 8u) { __builtin_amdgcn_s_sleep(1); if (++sp > (1u << 22)) break; }
            __builtin_amdgcn_fence(__ATOMIC_ACQUIRE, "agent");
            asm volatile("s_waitcnt vmcnt(0)" ::: "memory");
        }
        __builtin_amdgcn_s_barrier(); asm volatile("" ::: "memory");
        float rsv[8];
#pragma unroll
        for (int i = 0; i < 8; ++i) rsv[i] = __hip_atomic_load(rowss_out + row0 + (i >> 2) * HALF + (i & 3) * 16, __ATOMIC_RELAXED, __HIP_MEMORY_SCOPE_AGENT);
        f32x4 gv[2][2];
#pragma unroll
        for (int bj = 0; bj < 2; ++bj) { gv[bj][0] = *(const f32x4*)(gain + cl + bj * HALF); gv[bj][1] = *(const f32x4*)(gain + cl + bj * HALF + 4); }
#pragma unroll
        for (int gi = 0; gi < 8; ++gi) {
            const int ai = gi >> 2, m = gi & 3; const size_t off = (size_t)(row0 + ai * HALF + m * 16) * DM + cl;
            const float rs = __builtin_amdgcn_rsqf(rsv[gi] * (1.0f / DM) + EPS);
#pragma unroll
            for (int bj = 0; bj < 2; ++bj) { *(f32x4*)(out + off + bj * HALF) = acc[ai][bj][m][0] * rs * gv[bj][0]; *(f32x4*)(out + off + bj * HALF + 4) = acc[ai][bj][m][1] * rs * gv[bj][1]; }
        }
    }
};
struct EpiNull {
    __device__ __forceinline__ void operator()(const f32x4 (&acc)[2][2][4][2], const Unit& u, int wr, int wc, int fr, int fq) const {
#pragma unroll
        for (int ai = 0; ai < 2; ++ai)
#pragma unroll
            for (int bj = 0; bj < 2; ++bj)
#pragma unroll
                for (int m = 0; m < 4; ++m) asm volatile("" :: "v"(acc[ai][bj][m][0]), "v"(acc[ai][bj][m][1]));
    }
};

template <class Epi, bool ALIGN_EPI = true, int AUX_A = 0>
__device__ __forceinline__ void gemm_phase(LAS unsigned char* lds, const Gemm g, const StaticOrder& S, const Epi& E) {
    int tid_l = threadIdx.x; asm volatile("" : "+v"(tid_l));
    const int tid = tid_l, wid = __builtin_amdgcn_readfirstlane(tid >> 6), lane = tid & 63, wr = wid >> 2, wc = wid & 3, fr = lane & 15, fq = lane >> 4;
    const int K = g.K, nt = K / BK;
    unsigned voffA[2], voffB[2];
#pragma unroll
    for (int i = 0; i < 2; ++i) { int R, C; stage_rc(tid * 16 + i * 8192, R, C); const int Rb = (R & ~31) + perm32(R & 31);
        voffA[i] = (unsigned)(R * g.lda + C) * 2u; voffB[i] = (unsigned)(Rb * g.ldb + C) * 2u; }
    const size_t kstep = (size_t)(BK * 2);
    const size_t hstepA = (size_t)HALF * g.lda * 2, hstepB = (size_t)HALF * g.ldb * 2;
    const size_t tstepA = 2 * hstepA, tstepB = 2 * hstepB;
    const unsigned ldsw = (unsigned)wid * 1024u;
    const int aoff = lds_byte(wr * 64 + fr, fq * 8), boff = lds_byte(wc * 32 + fr, fq * 8);
#define PG8_SA(b, h) (((b) * 2 + (h)) * HTB)
#define PG8_SB(b, h) ((4 + (b) * 2 + (h)) * HTB)
#define PG8_STAGE_X(bufoff, gbase, voff, aux) do { _Pragma("unroll") for (int _i = 0; _i < 2; ++_i) \
        __builtin_amdgcn_global_load_lds((const unsigned*)((const char*)(gbase) + (voff)[_i]), (LAS unsigned*)(lds + (bufoff) + ldsw + _i * 8192), 16, 0, aux); } while (0)
#define PG8_STAGE(bufoff, gbase, voff) PG8_STAGE_X(bufoff, gbase, voff, 0)
#define PG8_LDA(dst, b, h) do { _Pragma("unroll") for (int m = 0; m < 4; ++m) _Pragma("unroll") for (int k = 0; k < 2; ++k) dst[m][k] = *(const LAS bf16x8*)(lds + PG8_SA(b, h) + aoff + m * 2048 + k * 1024); } while (0)
#define PG8_LDB(dst, b, h) do { _Pragma("unroll") for (int n = 0; n < 2; ++n) _Pragma("unroll") for (int k = 0; k < 2; ++k) dst[n][k] = *(const LAS bf16x8*)(lds + PG8_SB(b, h) + boff + n * 2048 + k * 1024); } while (0)
#define PG8_MMA(ai, bj, At, Bt) do { __builtin_amdgcn_s_setprio(1); _Pragma("unroll") for (int m = 0; m < 4; ++m) _Pragma("unroll") for (int n = 0; n < 2; ++n) _Pragma("unroll") for (int k = 0; k < 2; ++k) \
        acc[ai][bj][m][n] = __builtin_amdgcn_mfma_f32_16x16x32_bf16(Bt[n][k], At[m][k], acc[ai][bj][m][n], 0, 0, 0); __builtin_amdgcn_s_setprio(0); } while (0)
#define PG8_WAIT_V(n) asm volatile("s_waitcnt vmcnt(" #n ")" ::: "memory")
#define PG8_WAIT_L(n) asm volatile("s_waitcnt lgkmcnt(" #n ")" ::: "memory")
#define PG8_BAR __builtin_amdgcn_s_barrier()
#define PG8_SCHED __builtin_amdgcn_sched_barrier(0)
    Unit cur, nxt; int ui = 0;
    if (!S.next(0, cur)) return;
    f32x4 acc[2][2][4][2];
#pragma unroll
    for (int a = 0; a < 2; ++a)
#pragma unroll
        for (int b = 0; b < 2; ++b)
#pragma unroll
            for (int m = 0; m < 4; ++m)
#pragma unroll
                for (int n = 0; n < 2; ++n) acc[a][b][m][n] = (f32x4){0.f, 0.f, 0.f, 0.f};
    bf16x8 At[4][2], B0[2][2], B1[2][2];
    const char* cA = (const char*)g.A + (size_t)cur.pm * tstepA + (size_t)cur.pn * g.a_pn_step; const char* cB = (const char*)g.Bt + (size_t)cur.pn * tstepB;
    PG8_STAGE(PG8_SB(0, 0), cB, voffB); PG8_STAGE(PG8_SB(0, 1), cB + hstepB, voffB); PG8_STAGE_X(PG8_SA(0, 0), cA, voffA, AUX_A); PG8_STAGE_X(PG8_SA(0, 1), cA + hstepA, voffA, AUX_A);
    if (wr == 1) PG8_BAR;
    PG8_WAIT_V(2); PG8_BAR;
    PG8_STAGE(PG8_SB(1, 0), cB + kstep, voffB); PG8_STAGE_X(PG8_SA(1, 0), cA + kstep, voffA, AUX_A); PG8_STAGE(PG8_SB(1, 1), cB + hstepB + kstep, voffB);
    PG8_WAIT_V(6); PG8_BAR;
    for (;;) {
        const bool has_next = S.next(ui + 1, nxt);
        const char* nA = has_next ? (const char*)g.A + (size_t)nxt.pm * tstepA + (size_t)nxt.pn * g.a_pn_step : cA; const char* nB = has_next ? (const char*)g.Bt + (size_t)nxt.pn * tstepB : cB;
        for (int t = 0; t < nt; t += 2) {
            const bool last = (t == nt - 2);
            const size_t kbi = (size_t)(t >> 1);
            const char* a1 = cA + kbi * g.kblkA + kstep;
            const char* a2 = last ? nA : cA + (kbi + 1) * g.kblkA; const char* b2 = last ? nB : cB + (kbi + 1) * g.kblkB;
            const char* a3 = a2 + kstep; const char* b3 = b2 + kstep;
            PG8_LDB(B0, 0, 0); PG8_LDB(B1, 0, 1); PG8_SCHED; PG8_LDA(At, 0, 0); PG8_STAGE_X(PG8_SA(1, 1), a1 + hstepA, voffA, AUX_A);
            PG8_WAIT_V(8); PG8_WAIT_L(0); PG8_BAR; PG8_MMA(0, 0, At, B0); PG8_MMA(0, 1, At, B1); PG8_BAR; PG8_SCHED;
            PG8_LDA(At, 0, 1); PG8_STAGE(PG8_SB(0, 0), b2, voffB); PG8_STAGE(PG8_SB(0, 1), b2 + hstepB, voffB); PG8_STAGE_X(PG8_SA(0, 0), a2, voffA, AUX_A);
            PG8_WAIT_V(8); PG8_WAIT_L(0); PG8_BAR; PG8_MMA(1, 0, At, B0); PG8_MMA(1, 1, At, B1); PG8_BAR; PG8_SCHED;
            PG8_LDB(B0, 1, 0); PG8_LDB(B1, 1, 1); PG8_SCHED; PG8_LDA(At, 1, 0); PG8_STAGE_X(PG8_SA(0, 1), a2 + hstepA, voffA, AUX_A);
            PG8_WAIT_V(8); PG8_WAIT_L(0); PG8_BAR; PG8_MMA(0, 0, At, B0); PG8_MMA(0, 1, At, B1); PG8_BAR; PG8_SCHED;
            PG8_LDA(At, 1, 1); PG8_STAGE(PG8_SB(1, 0), b3, voffB); PG8_STAGE(PG8_SB(1, 1), b3 + hstepB, voffB); PG8_STAGE_X(PG8_SA(1, 0), a3, voffA, AUX_A);
            PG8_WAIT_V(8); PG8_WAIT_L(0); PG8_BAR; PG8_MMA(1, 0, At, B0); PG8_MMA(1, 1, At, B1); PG8_BAR; PG8_SCHED;
        }
        if constexpr (ALIGN_EPI) { if (wr == 0) PG8_BAR; }
        E(acc, cur, wr, wc, fr, fq);
        if (!has_next) break;
#pragma unroll
        for (int a = 0; a < 2; ++a)
#pragma unroll
            for (int b = 0; b < 2; ++b)
#pragma unroll
                for (int m = 0; m < 4; ++m)
#pragma unroll
                    for (int n = 0; n < 2; ++n) acc[a][b][m][n] = (f32x4){0.f, 0.f, 0.f, 0.f};
        cur = nxt; cA = nA; cB = nB; ++ui;
        if constexpr (ALIGN_EPI) { if (wr == 1) PG8_BAR; }
    }
    PG8_WAIT_V(0);
    if constexpr (!ALIGN_EPI) { if (wr == 0) PG8_BAR; }
    PG8_BAR;
#undef PG8_SA
#undef PG8_SB
#undef PG8_STAGE
#undef PG8_STAGE_X
#undef PG8_LDA
#undef PG8_LDB
#undef PG8_MMA
#undef PG8_WAIT_V
#undef PG8_WAIT_L
#undef PG8_BAR
#undef PG8_SCHED
}
}

template <int DH, bool BIAS, int NT, bool PF, bool COAL = false, bool VDB = true>
__device__ __forceinline__ void attn_wave32(const bf16_t* __restrict__ Qp, int ldq, const bf16_t* __restrict__ Kp, int ldk, const bf16_t* __restrict__ Vp, int ldv,
                                            bf16_t* __restrict__ Op, int ldo, int ntiles, float sc, const LAS float* tab, int rel_base, int lane) {
    constexpr int KS = DH / 32, DT = DH / 16;
    asm volatile("" : "+v"(lane));
    const int fr = lane & 15, fq = lane >> 4;
    bf16x8 qf[NT][KS];
#pragma unroll
    for (int nt = 0; nt < NT; ++nt)
#pragma unroll
        for (int ks = 0; ks < KS; ++ks) qf[nt][ks] = *(const bf16x8*)(Qp + (size_t)(nt * 16 + fr) * ldq + ks * 32 + fq * 8);
    f32x4 o[DT][NT];
#pragma unroll
    for (int dt = 0; dt < DT; ++dt)
#pragma unroll
        for (int nt = 0; nt < NT; ++nt) o[dt][nt] = (f32x4){0.f, 0.f, 0.f, 0.f};
    float mrun[NT], lrun[NT];
#pragma unroll
    for (int nt = 0; nt < NT; ++nt) { mrun[nt] = -1e30f; lrun[nt] = 0.f; }
    const bf16_t* kbase = Kp + (size_t)(8 * (fr >> 2) + (fr & 3)) * ldk + fq * 8;
    const bf16_t* vbase = Vp + (size_t)fr * ldv + fq * 8;
    bf16x8 kf[4][KS], vfA[DT][2], vfB[DT][2];
#define ATT_LOADK(tt) do { _Pragma("unroll") for (int mt = 0; mt < 4; ++mt) _Pragma("unroll") for (int ks = 0; ks < KS; ++ks) \
        kf[mt][ks] = COAL ? *(const bf16x8*)(Kp + (size_t)(tt) * (64 * DH) + (mt * KS + ks) * 512 + lane * 8) \
                          : *(const bf16x8*)(kbase + (size_t)((tt) * 64 + (mt >> 1) * 32 + 4 * (mt & 1)) * ldk + ks * 32); } while (0)
#define ATT_LOADV(dst, tt) do { _Pragma("unroll") for (int dt = 0; dt < DT; ++dt) _Pragma("unroll") for (int kb = 0; kb < 2; ++kb) \
        dst[dt][kb] = COAL ? *(const bf16x8*)(Vp + (size_t)(tt) * (64 * DH) + (dt * 2 + kb) * 512 + lane * 8) \
                           : *(const bf16x8*)(vbase + (size_t)(dt * 16) * ldv + (tt) * 64 + kb * 32); } while (0)
#define ATT_BODY(t, vcur, vnext) do { \
        const int tn_ = ((t) + 1 < ntiles) ? (t) + 1 : (t); \
        if (PF && VDB) ATT_LOADV(vnext, tn_); else if (PF) ATT_LOADV(vcur, t); else ATT_LOADK(t); \
        f32x4 s[4][NT]; \
        _Pragma("unroll") for (int mt = 0; mt < 4; ++mt) _Pragma("unroll") for (int nt = 0; nt < NT; ++nt) { s[mt][nt] = (f32x4){0.f, 0.f, 0.f, 0.f}; \
            _Pragma("unroll") for (int ks = 0; ks < KS; ++ks) s[mt][nt] = __builtin_amdgcn_mfma_f32_16x16x32_bf16(kf[mt][ks], qf[nt][ks], s[mt][nt], 0, 0, 0); } \
        if (PF) ATT_LOADK(tn_); \
        bf16x8 pf[NT][2]; \
          \
        const LAS float* tb_ = tab + (rel_base - 64 * (t) + fr - 8 * fq + 63 - 39); \
        _Pragma("unroll") for (int nt = 0; nt < NT; ++nt) { \
            float mloc = -1e30f; \
            _Pragma("unroll") for (int mt = 0; mt < 4; ++mt) _Pragma("unroll") for (int j = 0; j < 4; ++j) { \
                float v = s[mt][nt][j] * sc; \
                if (BIAS) v += tb_[39 + nt * 16 - ((mt >> 1) * 32 + 4 * (mt & 1) + j)]; \
                s[mt][nt][j] = v; mloc = fmaxf(mloc, v); } \
            mloc = fmaxf(mloc, __shfl_xor(mloc, 16)); mloc = fmaxf(mloc, __shfl_xor(mloc, 32)); \
            const float mnew = fmaxf(mrun[nt], mloc), alpha = __builtin_amdgcn_exp2f(mrun[nt] - mnew); \
            mrun[nt] = mnew; \
            float ls = 0.f; \
            _Pragma("unroll") for (int mt = 0; mt < 4; ++mt) _Pragma("unroll") for (int j = 0; j < 4; ++j) { const float p = __builtin_amdgcn_exp2f(s[mt][nt][j] - mnew); s[mt][nt][j] = p; ls += p; } \
            lrun[nt] = lrun[nt] * alpha + ls; \
            _Pragma("unroll") for (int dt = 0; dt < DT; ++dt) o[dt][nt] = o[dt][nt] * alpha; \
            _Pragma("unroll") for (int kb = 0; kb < 2; ++kb) { \
                u32x4 w; w.x = cvt_pk_bf16(s[2 * kb][nt][0], s[2 * kb][nt][1]); w.y = cvt_pk_bf16(s[2 * kb][nt][2], s[2 * kb][nt][3]); \
                w.z = cvt_pk_bf16(s[2 * kb + 1][nt][0], s[2 * kb + 1][nt][1]); w.w = cvt_pk_bf16(s[2 * kb + 1][nt][2], s[2 * kb + 1][nt][3]); \
                pf[nt][kb] = __builtin_bit_cast(bf16x8, w); } } \
        if (!PF) { asm volatile("" ::: "memory"); ATT_LOADV(vcur, t); } \
        _Pragma("unroll") for (int dt = 0; dt < DT; ++dt) _Pragma("unroll") for (int nt = 0; nt < NT; ++nt) _Pragma("unroll") for (int kb = 0; kb < 2; ++kb) \
            o[dt][nt] = __builtin_amdgcn_mfma_f32_16x16x32_bf16(vcur[dt][kb], pf[nt][kb], o[dt][nt], 0, 0, 0); \
    } while (0)
    if (PF && VDB) { ATT_LOADK(0); ATT_LOADV(vfA, 0);
#pragma nounroll
        for (int t = 0; t < ntiles; t += 2) {
            ATT_BODY(t, vfA, vfB);
            if (t + 1 < ntiles) ATT_BODY(t + 1, vfB, vfA);
        }
    } else if (PF) { ATT_LOADK(0);
#pragma nounroll
        for (int t = 0; t < ntiles; ++t) ATT_BODY(t, vfA, vfB);
    } else {
#pragma nounroll
        for (int t = 0; t < ntiles; ++t) ATT_BODY(t, vfA, vfB);
    }
#undef ATT_BODY
#undef ATT_LOADK
#undef ATT_LOADV
#pragma unroll
    for (int nt = 0; nt < NT; ++nt) {
        float l = lrun[nt]; l += __shfl_xor(l, 16); l += __shfl_xor(l, 32);
        const float inv = 1.0f / l;
#pragma unroll
        for (int dt = 0; dt < DT; ++dt) {
            const f32x4 v = o[dt][nt] * inv; u32x2 w; w.x = cvt_pk_bf16(v[0], v[1]); w.y = cvt_pk_bf16(v[2], v[3]);
            *(u32x2*)(Op + (size_t)(nt * 16 + fr) * ldo + dt * 16 + 4 * fq) = w;
        }
    }
}

#define XB_TMO      128
#define XB_XCNT(j)  (256  + 64 * (j))
#define XB_XSUB(j)  (1280 + 64 * (j))
#define XB_XGEN(j)  (2304 + 64 * (j))
#define XB_TOP      3328
#define XB_TOPGEN   3392
#define XCD_BAR_WORDS 3456
#define XB_SPIN_CAP (1u << 22)
__device__ __forceinline__ unsigned xb_ld(unsigned* p)              { return __hip_atomic_load(p, __ATOMIC_RELAXED, __HIP_MEMORY_SCOPE_AGENT); }
__device__ __forceinline__ unsigned xb_add(unsigned* p, unsigned v) { return __hip_atomic_fetch_add(p, v, __ATOMIC_RELAXED, __HIP_MEMORY_SCOPE_AGENT); }
__device__ __forceinline__ unsigned xb_xcc_id() { return (unsigned)__builtin_amdgcn_s_getreg((3 << 11) | 20) & 0xFu; }
#define XB_SPIN(cond, bar) do { unsigned _sp = 0; while (cond) { __builtin_amdgcn_s_sleep(1); \
    if ((++_sp & 255u) == 0u) { if (xb_ld(&(bar)[XB_TMO])) break; if (_sp > XB_SPIN_CAP) { atomicAdd(&(bar)[XB_TMO], 1u); break; } } } } while (0)
struct XcdBarrier { unsigned* bar; unsigned x; volatile LAS unsigned* st; };
__device__ __forceinline__ XcdBarrier xcd_barrier_post(unsigned* bar, volatile LAS unsigned* st) {
    XcdBarrier b; b.bar = bar; b.x = xb_xcc_id(); b.st = st;
    if (threadIdx.x == 0) (void)xb_add(&bar[XB_XCNT(b.x)], 1u);
    return b;
}
__device__ __forceinline__ void xcd_barrier_complete(unsigned* bar, unsigned x, unsigned& nloc, unsigned& nx) {
    const unsigned G = gridDim.x * gridDim.y * gridDim.z;
    unsigned sum, cnt, mine, sp = 0u;
    for (;;) {
        sum = 0u; cnt = 0u; mine = 0u;
#pragma unroll
        for (unsigned j = 0; j < 16; ++j) { const unsigned c = xb_ld(&bar[XB_XCNT(j)]); sum += c; cnt += (c > 0u) ? 1u : 0u; mine = (j == x) ? c : mine; }
        if (sum == G) break;
        __builtin_amdgcn_s_sleep(1);
        if ((++sp & 255u) == 0u) { if (xb_ld(&bar[XB_TMO])) break; if (sp > XB_SPIN_CAP) { atomicAdd(&bar[XB_TMO], 1u); break; } }
    }
    nloc = mine > 0u ? mine : 1u; nx = cnt > 0u ? cnt : 1u;
}
__device__ __forceinline__ void xcd_barrier(const XcdBarrier& b) {
    asm volatile("s_waitcnt vmcnt(0)" ::: "memory");
    __syncthreads();
    if (threadIdx.x == 0) {
        unsigned* bar = b.bar;
        __builtin_amdgcn_s_waitcnt(0);
        unsigned nloc = b.st[0], nx = b.st[1];
        if (nloc == 0u) { xcd_barrier_complete(bar, b.x, nloc, nx); b.st[0] = nloc; b.st[1] = nx; }
        const unsigned old = xb_add(&bar[XB_XSUB(b.x)], 1u);
        const unsigned gen = old / nloc;
        if (old + 1u == (gen + 1u) * nloc) {
            __builtin_amdgcn_fence(__ATOMIC_RELEASE, "agent");
            asm volatile("s_waitcnt vmcnt(0)" ::: "memory");
            const unsigned og = xb_add(&bar[XB_TOP], 1u);
            const unsigned tg = og / nx;
            if (og + 1u == (tg + 1u) * nx) xb_add(&bar[XB_TOPGEN], 1u);
            else XB_SPIN(xb_ld(&bar[XB_TOPGEN]) == tg, bar);
            __builtin_amdgcn_fence(__ATOMIC_ACQUIRE, "agent");
            xb_add(&bar[XB_XGEN(b.x)], 1u);
            asm volatile("s_waitcnt vmcnt(0)" ::: "memory");
        } else {
            XB_SPIN(xb_ld(&bar[XB_XGEN(b.x)]) == gen, bar);
            __builtin_amdgcn_fence(__ATOMIC_ACQUIRE, "agent");
            asm volatile("s_waitcnt vmcnt(0)" ::: "memory");
        }
    }
    __syncthreads();
}

struct Params {
    const float* x; const float* mem;
    const float* ffn1_norm; const float* ffn1_wg; const float* ffn1_wu; const float* ffn1_wd;
    const float* mix_norm; const float* w_in; const float* rel_bias; const float* w_pool; const float* pool_scale; const float* w_out;
    const float* cross_norm; const float* mem_norm; const float* w_cq; const float* w_ckv; const float* w_co;
    const float* ffn2_norm; const float* ffn2_wg; const float* ffn2_wu; const float* ffn2_wd; const float* final_norm;
    float* out; unsigned char* ws;
};

__device__ __forceinline__ void p0_transpose_item(const float* __restrict__ W, int K, int N, bf16_t* __restrict__ WT, int mode, int row_off, const float* __restrict__ gain, LAS float* scr, int item, int lane) {
    const int nblk = N / 32, kb = item / nblk, nb = item - kb * nblk, k0 = 64 * kb, n0 = 32 * nb;
#pragma unroll 8
    for (int i = 0; i < 32; ++i) { const int kk = 2 * i + (lane >> 5); const float gk = gain ? gain[k0 + kk] : 1.0f; scr[kk * 33 + (lane & 31)] = W[(size_t)(k0 + kk) * N + n0 + (lane & 31)] * gk; }
    asm volatile("s_waitcnt lgkmcnt(0)" ::: "memory");
    const int c = lane & 7;
    const int d0 = (mode == 0 || mode == 3) ? (row_off + n0) : ((n0 >> 7) * 256 + (n0 & 127) + (mode == 2 ? 128 : 0));
#pragma unroll
    for (int j = 0; j < 4; ++j) { const int n = (lane >> 3) + 8 * j; const LAS float* s = scr + (8 * c) * 33 + n;
        u32x4 o; o.x = cvt_pk_bf16(s[0 * 33], s[1 * 33]); o.y = cvt_pk_bf16(s[2 * 33], s[3 * 33]); o.z = cvt_pk_bf16(s[4 * 33], s[5 * 33]); o.w = cvt_pk_bf16(s[6 * 33], s[7 * 33]);
        if (mode == 3) *(u32x4*)(WT + ((size_t)(k0 >> 7) * N + (row_off + n0 + n)) * 128 + (k0 & 127) + 8 * c) = o;
        else *(u32x4*)(WT + (size_t)(d0 + n) * K + k0 + 8 * c) = o; }
    asm volatile("s_waitcnt lgkmcnt(0)" ::: "memory");
}

#define rowss ((float*)(P.ws + WS_ROWSS))
#define Wgu1 ((bf16_t*)(P.ws + WS_WGU1))
#define Wd1 ((bf16_t*)(P.ws + WS_WD1))
#define Win ((bf16_t*)(P.ws + WS_WIN))
#define Wp ((bf16_t*)(P.ws + WS_WP))
#define Wout ((bf16_t*)(P.ws + WS_WOUT))
#define Wcq ((bf16_t*)(P.ws + WS_WCQ))
#define Wckv ((bf16_t*)(P.ws + WS_WCKV))
#define Wco ((bf16_t*)(P.ws + WS_WCO))
#define Wgu2 ((bf16_t*)(P.ws + WS_WGU2))
#define Wd2 ((bf16_t*)(P.ws + WS_WD2))
#define HB ((bf16_t*)(P.ws + WS_HB))
#define ACT ((bf16_t*)(P.ws + WS_ACT))
#define Z ((bf16_t*)(P.ws + WS_Z))
#define VT ((bf16_t*)(P.ws + WS_VT))
#define Y ((bf16_t*)(P.ws + WS_Y))
#define CQ ((bf16_t*)(P.ws + WS_CQ))
#define CO ((bf16_t*)(P.ws + WS_CO))
#define DP ((bf16_t*)(P.ws + WS_DP))
#define MEMN ((bf16_t*)(P.ws + WS_MEMN))
#define KC ((bf16_t*)(P.ws + WS_KC))
#define VCT ((bf16_t*)(P.ws + WS_VCT))
#define KF ((bf16_t*)(P.ws + WS_KF))
constexpr int I_G = (DM / 64) * (DFF / 32), I_D = (DFF / 64) * (DM / 32), I_IN = (DM / 64) * (DIN / 32), I_P = (256 / 64) * (256 / 32), I_O = (DM / 64) * (DM / 32),
              I_CQ = (DM / 64) * (DCROSS / 32), I_CKV = (DM / 64) * (2 * DCROSS / 32), I_CO = (DCROSS / 64) * (DM / 32);
constexpr int N_EARLY = 2 * I_G + I_D + I_IN + 4 * I_P + I_CKV, NITEMS = N_EARLY + 2 * I_G + I_D + I_O + I_CQ + I_CO;
#define CONVERT_ITEM(it_, lane) do { int r = (it_); \
        if (r < I_G) { p0_transpose_item(P.ffn1_wg, DM, DFF, Wgu1, 1, 0, P.ffn1_norm, scr, r, lane); break; } r -= I_G; \
        if (r < I_G) { p0_transpose_item(P.ffn1_wu, DM, DFF, Wgu1, 2, 0, P.ffn1_norm, scr, r, lane); break; } r -= I_G; \
        if (r < I_D) { p0_transpose_item(P.ffn1_wd, DFF, DM, Wd1, 3, 0, nullptr, scr, r, lane); break; } r -= I_D; \
        if (r < I_IN) { p0_transpose_item(P.w_in, DM, DIN, Win, 0, 0, P.mix_norm, scr, r, lane); break; } r -= I_IN; \
        if (r < 4 * I_P) { const int gi = r / I_P; p0_transpose_item(P.w_pool + (size_t)gi * 65536, 256, 256, Wp, 0, gi * 256, nullptr, scr, r - gi * I_P, lane); break; } r -= 4 * I_P; \
        if (r < I_CKV) { p0_transpose_item(P.w_ckv, DM, 2 * DCROSS, Wckv, 0, 0, nullptr, scr, r, lane); break; } r -= I_CKV; \
        if (r < I_G) { p0_transpose_item(P.ffn2_wg, DM, DFF, Wgu2, 1, 0, P.ffn2_norm, scr, r, lane); break; } r -= I_G; \
        if (r < I_G) { p0_transpose_item(P.ffn2_wu, DM, DFF, Wgu2, 2, 0, P.ffn2_norm, scr, r, lane); break; } r -= I_G; \
        if (r < I_D) { p0_transpose_item(P.ffn2_wd, DFF, DM, Wd2, 3, 0, nullptr, scr, r, lane); break; } r -= I_D; \
        if (r < I_O) { p0_transpose_item(P.w_out, DM, DM, Wout, 0, 0, nullptr, scr, r, lane); break; } r -= I_O; \
        if (r < I_CQ) { p0_transpose_item(P.w_cq, DM, DCROSS, Wcq, 0, 0, P.cross_norm, scr, r, lane); break; } r -= I_CQ; \
        p0_transpose_item(P.w_co, DCROSS, DM, Wco, 0, 0, nullptr, scr, r, lane); } while (0)
__global__ void __launch_bounds__(512, 2) fwd_megakernel(Params P) {
    extern __shared__ __attribute__((aligned(16))) unsigned char lds_raw[];
    cg::grid_group grid = cg::this_grid();
    LAS unsigned char* lds = (LAS unsigned char*)lds_raw;
    const int tid = threadIdx.x, lane = tid & 63, wave = __builtin_amdgcn_readfirstlane(tid >> 6);
    const int G = gridDim.x, bx = blockIdx.x;
    const int gw = bx * 8 + wave, NGW = G * 8;
    volatile LAS unsigned* bst = (volatile LAS unsigned*)(lds + 131072 + 64);
    if (tid < 2) bst[tid] = 0u;
    __syncthreads();
    const XcdBarrier xbar = xcd_barrier_post((unsigned*)(P.ws + WS_BAR), bst);
#ifndef WGM_RES
#define WGM_RES 8
#endif
#ifndef REV_DOWN
#define REV_DOWN 1
#endif
#define RUN_GEMM_ON(EPI, gM, gN, gdesc, edesc, G_, c_) do { pg8::StaticOrder S_; S_.init((gM), (gN), (G_), (c_), ((gN) == DM) ? WGM_RES : 8); pg8::gemm_phase<EPI>(lds, (gdesc), S_, (edesc)); } while (0)
#define RUN_GEMM(EPI, gM, gN, gdesc, edesc) RUN_GEMM_ON(EPI, gM, gN, gdesc, edesc, G, bx)
#ifndef AUX_DOWN
#define AUX_DOWN 0
#endif
#define RUN_GEMM_NT(EPI, gM, gN, gdesc, edesc) do { pg8::StaticOrder S_; S_.init((gM), (gN), G, bx, ((gN) == DM) ? WGM_RES : 8, REV_DOWN); pg8::gemm_phase<EPI, true, AUX_DOWN>(lds, (gdesc), S_, (edesc)); } while (0)

    for (int rep_ = 0; rep_ < REP_P0; ++rep_) {
        LAS float* scr = (LAS float*)(lds + wave * 16384);
        for (int it = gw; it < N_EARLY; it += NGW) CONVERT_ITEM(it, lane);
        for (int i = bx * 512 + tid; i < 4 * MTOK; i += G * 512) rowss[MTOK + i] = 0.f;
        for (int m = gw; m < MTOK; m += NGW) {
            const f32x4* xr = (const f32x4*)(P.x + (size_t)m * DM) + lane; u32x2* o8 = (u32x2*)(HB + (size_t)m * DM) + lane; float s = 0.f;
#pragma unroll
            for (int j = 0; j < 8; ++j) { const f32x4 v = xr[64 * j]; s += (v[0] * v[0] + v[1] * v[1]) + (v[2] * v[2] + v[3] * v[3]); u32x2 w; w.x = cvt_pk_bf16(v[0], v[1]); w.y = cvt_pk_bf16(v[2], v[3]); o8[64 * j] = w; }
            s = wave_sum(s); if (lane == 0) rowss[m] = s;
        }
        for (int m = gw; m < BATCH * NMEM; m += NGW) {
            const f32x4* xr = (const f32x4*)(P.mem + (size_t)m * DM) + lane; const f32x4* gr = (const f32x4*)P.mem_norm + lane; u32x2* o8 = (u32x2*)(MEMN + (size_t)m * DM) + lane;
            f32x4 v[8]; float s = 0.f;
#pragma unroll
            for (int j = 0; j < 8; ++j) { v[j] = xr[64 * j]; s += (v[j][0] * v[j][0] + v[j][1] * v[j][1]) + (v[j][2] * v[j][2] + v[j][3] * v[j][3]); }
            const float rs = __builtin_amdgcn_rsqf(wave_sum(s) * (1.0f / DM) + EPS);
#pragma unroll
            for (int j = 0; j < 8; ++j) { const f32x4 gg = gr[64 * j]; const f32x4 y = v[j] * rs * gg; u32x2 w; w.x = cvt_pk_bf16(y[0], y[1]); w.y = cvt_pk_bf16(y[2], y[3]); o8[64 * j] = w; }
        }
    }
    grid.sync();
    for (int rep_ = 0; rep_ < REP_G1; ++rep_)
    RUN_GEMM(pg8::EpiSwiglu, MTOK, 2 * DFF, (pg8::Gemm{HB, Wgu1, DM, DM, DM, 0}), (pg8::EpiSwiglu{ACT, DFF, rowss}));
    for (int rep_ = 0; rep_ < REP_G1NULL; ++rep_)
    RUN_GEMM(pg8::EpiNull, MTOK, 2 * DFF, (pg8::Gemm{HB, Wgu1, DM, DM, DM, 0}), (pg8::EpiNull{}));
    for (int rep_ = 0; rep_ < REP_SYNC; ++rep_) grid.sync();
    xcd_barrier(xbar);
    for (int rep_ = 0; rep_ < REP_G2NULL; ++rep_)
    RUN_GEMM(pg8::EpiNull, MTOK, DM, (pg8::Gemm{ACT, Wd1, 128, 128, DFF, 0, (size_t)0, (size_t)DM * 256}), (pg8::EpiNull{}));
    for (int rep_ = 0; rep_ < REP_G2; ++rep_)
    RUN_GEMM(pg8::EpiRes<true>, MTOK, DM, (pg8::Gemm{ACT, Wd1, 128, 128, DFF, 0, (size_t)MTOK * 256, (size_t)DM * 256}), (pg8::EpiRes<true>{P.x, HB, nullptr, 0.5f}));
    RUN_GEMM_NT(pg8::EpiRes<true>, MTOK, DM, (pg8::Gemm{ACT, Wd1, 128, 128, DFF, 0, (size_t)MTOK * 256, (size_t)DM * 256}), (pg8::EpiRes<true>{P.x, HB, rowss + 1 * MTOK, 0.5f}));
    xcd_barrier(xbar);
    for (int rep_ = 0; rep_ < REP_G3; ++rep_)
    RUN_GEMM(pg8::EpiBf<64>, MTOK, DIN, (pg8::Gemm{HB, Win, DM, DM, DM, 0}), (pg8::EpiBf<64>{Z, DIN, 0, rowss + 1 * MTOK, nullptr, 8, 12, SEQ, DATT, VT, 4, 8, KF}));
    xcd_barrier(xbar);
    for (int rep_ = 0; rep_ < REP_ATT; ++rep_) {
        for (int task = gw; task < (MTOK / 64) * 4; task += NGW) {
            const int gi = task & 3, rt = task >> 2, sub = lane >> 5, cgi = lane & 31, w = 2 << gi;
            const int t0 = rt * 64 + sub * 32, tpos = t0 & (SEQ - 1);
            const bf16_t* up = Z + (size_t)t0 * DIN + 3 * DATT + gi * 256 + cgi * 8;
            bf16_t* dp = DP + (size_t)t0 * DPOOL + gi * 256 + cgi * 8;
            float sum[8];
#pragma unroll
            for (int e = 0; e < 8; ++e) sum[e] = 0.f;
            for (int i = 1; i < w; ++i) if (tpos - i >= 0) { const u32x4 v = *(const u32x4*)(up - (size_t)i * DIN);
                sum[0] += bf_lo(v.x); sum[1] += bf_hi(v.x); sum[2] += bf_lo(v.y); sum[3] += bf_hi(v.y); sum[4] += bf_lo(v.z); sum[5] += bf_hi(v.z); sum[6] += bf_lo(v.w); sum[7] += bf_hi(v.w); }
#pragma nounroll
            for (int r0 = 0; r0 < 32; r0 += 8) {
                u32x4 cv[8], ov[8];
#pragma unroll
                for (int j = 0; j < 8; ++j) cv[j] = *(const u32x4*)(up + (size_t)(r0 + j) * DIN);
#pragma unroll
                for (int j = 0; j < 8; ++j) { const int rr = r0 + j - w + 1; ov[j] = (tpos + rr >= 0) ? *(const u32x4*)(up + (ptrdiff_t)rr * DIN) : (u32x4){0u, 0u, 0u, 0u}; }
#pragma unroll
                for (int j = 0; j < 8; ++j) {
                    const u32x4 v = cv[j], q = ov[j];
                    const float cur[8] = {bf_lo(v.x), bf_hi(v.x), bf_lo(v.y), bf_hi(v.y), bf_lo(v.z), bf_hi(v.z), bf_lo(v.w), bf_hi(v.w)};
                    const float old[8] = {bf_lo(q.x), bf_hi(q.x), bf_lo(q.y), bf_hi(q.y), bf_lo(q.z), bf_hi(q.z), bf_lo(q.w), bf_hi(q.w)};
                    const int have = tpos + r0 + j + 1; const float inv = 1.0f / (float)(have < w ? have : w);
                    float d[8];
#pragma unroll
                    for (int e = 0; e < 8; ++e) { sum[e] += cur[e]; d[e] = sum[e] * inv - cur[e]; sum[e] -= old[e]; }
                    u32x4 o; o.x = cvt_pk_bf16(d[0], d[1]); o.y = cvt_pk_bf16(d[2], d[3]); o.z = cvt_pk_bf16(d[4], d[5]); o.w = cvt_pk_bf16(d[6], d[7]);
                    *(u32x4*)(dp + (size_t)(r0 + j) * DPOOL) = o;
                }
            }
        }
        LAS float* tab = (LAS float*)lds;
        for (int bh = bx; bh < BATCH * 16; bh += G) {
            const int b = bh >> 4, h = bh & 15;
            __syncthreads();
            for (int i = tid; i < 704; i += 512) { int rel = i - 63; rel = rel < -128 ? -128 : (rel > 128 ? 128 : rel); tab[i] = P.rel_bias[h * NREL + rel + 128] * LOG2E; }
            __syncthreads();
            const bool first = (bh == bx);
#pragma nounroll
            for (int stage = 0; stage < 2; ++stage) {
                const bool do_att = first ? ((((wave >> 2) & 1) == stage)) : (stage == 0);
                if (do_att) {
#pragma nounroll
                    for (int i = 0; i < 8; ++i) {
                        const int c = i * 4 + (wave >> 1), half = wave & 1, j0 = c < 8 ? 8 - c : 0, kstart = (c - 8 + j0) * 64;
                        const size_t qrow = (size_t)b * SEQ + c * 64 + half * 32;
                        attn_wave32<64, true, 2, true, true>(Z + qrow * DIN + h * 64, DIN, KF + ((size_t)(b * 16 + h) * SEQ + kstart) * 64, 0,
                                              VT + ((size_t)(b * 16 + h) * SEQ + kstart) * 64, 0, Y + qrow * DM + h * 64, DM, 9 - j0, 0.125f * LOG2E, tab, half * 32 + (8 - j0) * 64, lane);
                    }
                } else if (first) {
                    int ln = threadIdx.x & 63; asm volatile("" : "+v"(ln));
                    LAS float* scr2 = (LAS float*)(lds + 4096 + wave * 8448);
#define scr scr2
#pragma nounroll
                    for (int it = N_EARLY + gw; it < NITEMS; it += NGW) CONVERT_ITEM(it, ln);
#undef scr
                }
            }
        }
        __syncthreads();
    }
    xcd_barrier(xbar);
    if (G >= 128 && bx < 64) {
        RUN_GEMM_ON(pg8::EpiBf<128>, BATCH * NMEM, 2 * DCROSS, (pg8::Gemm{MEMN, Wckv, DM, DM, DM, 0}), (pg8::EpiBf<128>{KC, DCROSS, 0, nullptr, nullptr, 2, 4, NMEM, DCROSS, VCT, 0, 2, KC}), 64, bx);
    } else if (G >= 128) {
        RUN_GEMM_ON(pg8::EpiBf<0>, MTOK, DPOOL, (pg8::Gemm{DP, Wp, DPOOL, 256, 256, 512}), (pg8::EpiBf<0>{Y, DM, DATT, nullptr, P.pool_scale, 0, 0, 1, 1, nullptr, 0, 0, nullptr}), G - 64, bx - 64);
    } else {
        RUN_GEMM(pg8::EpiBf<128>, BATCH * NMEM, 2 * DCROSS, (pg8::Gemm{MEMN, Wckv, DM, DM, DM, 0}), (pg8::EpiBf<128>{KC, DCROSS, 0, nullptr, nullptr, 2, 4, NMEM, DCROSS, VCT, 0, 2, KC}));
        RUN_GEMM(pg8::EpiBf<0>, MTOK, DPOOL, (pg8::Gemm{DP, Wp, DPOOL, 256, 256, 512}), (pg8::EpiBf<0>{Y, DM, DATT, nullptr, P.pool_scale, 0, 0, 1, 1, nullptr, 0, 0, nullptr}));
    }
    xcd_barrier(xbar);
    RUN_GEMM(pg8::EpiRes<false>, MTOK, DM, (pg8::Gemm{Y, Wout, DM, DM, DM, 0}), (pg8::EpiRes<false>{nullptr, HB, rowss + 2 * MTOK, 1.0f}));
    xcd_barrier(xbar);
    RUN_GEMM(pg8::EpiBf<0>, MTOK, DCROSS, (pg8::Gemm{HB, Wcq, DM, DM, DM, 0}), (pg8::EpiBf<0>{CQ, DCROSS, 0, rowss + 2 * MTOK, nullptr, 0, 0, 1, 1, nullptr, 0, 0, nullptr}));
    xcd_barrier(xbar);
    for (int rep_ = 0; rep_ < REP_XATT; ++rep_) {
        for (int it = bx; it < BATCH * 16; it += G) {
            const int b = it >> 4, sub = it & 15;
#pragma nounroll
            for (int r = 0; r < 4; ++r) {
                const int wu = r * 8 + wave, head = wu & 3, qblk = wu >> 2;
                const size_t qrow = (size_t)b * SEQ + sub * 128 + qblk * 16;
#ifndef NO_ATT9
                attn_wave32<128, false, 1, true, true, false>(CQ + qrow * DCROSS + head * 128, DCROSS, KC + (size_t)(b * 4 + head) * NMEM * 128, 0,
                                        VCT + (size_t)(b * 4 + head) * NMEM * 128, 0, CO + qrow * DCROSS + head * 128, DCROSS, 4, 0.08838834764831845f * LOG2E, nullptr, 0, lane);
#endif
            }
        }
    }
    xcd_barrier(xbar);
    RUN_GEMM(pg8::EpiRes<false>, MTOK, DM, (pg8::Gemm{CO, Wco, DCROSS, DCROSS, DCROSS, 0}), (pg8::EpiRes<false>{nullptr, HB, rowss + 3 * MTOK, 1.0f}));
    xcd_barrier(xbar);
    RUN_GEMM(pg8::EpiSwiglu, MTOK, 2 * DFF, (pg8::Gemm{HB, Wgu2, DM, DM, DM, 0}), (pg8::EpiSwiglu{ACT, DFF, rowss + 3 * MTOK}));
    xcd_barrier(xbar);
    if (G == 256) {
        pg8::StaticOrder S_; S_.init(MTOK, DM, G, bx, 4, 0);
        pg8::gemm_phase<pg8::EpiResFinal, true, AUX_DOWN>(lds, (pg8::Gemm{ACT, Wd2, 128, 128, DFF, 0, (size_t)MTOK * 256, (size_t)DM * 256}), S_,
                                                          (pg8::EpiResFinal{HB, rowss + 4 * MTOK, 0.5f, P.out, P.final_norm, (unsigned*)(P.ws + WS_PCNT)}));
    } else {
        RUN_GEMM_NT(pg8::EpiRes<false>, MTOK, DM, (pg8::Gemm{ACT, Wd2, 128, 128, DFF, 0, (size_t)MTOK * 256, (size_t)DM * 256}), (pg8::EpiRes<false>{nullptr, HB, rowss + 4 * MTOK, 0.5f}));
        xcd_barrier(xbar);
        {
            const float* rs4 = rowss + 4 * MTOK;
            for (int m = gw; m < MTOK; m += NGW) {
                const u32x2* hr = (const u32x2*)(HB + (size_t)m * DM) + lane; f32x4* xr = (f32x4*)(P.out + (size_t)m * DM) + lane; const f32x4* gr = (const f32x4*)P.final_norm + lane;
                const float rs = __builtin_amdgcn_rsqf(rs4[m] * (1.0f / DM) + EPS);
    #pragma unroll
                for (int j = 0; j < 8; ++j) { const u32x2 q = hr[64 * j]; const f32x4 v = (f32x4){bf_lo(q.x), bf_hi(q.x), bf_lo(q.y), bf_hi(q.y)}; xr[64 * j] = v * rs * gr[64 * j]; }
            }
        }
    }
#undef RUN_GEMM
#undef RUN_GEMM_ON
#undef RUN_GEMM_NT
}

extern "C" void kernel_launch(void* const* d_in, const int* in_sizes, int n_in, void* d_out, int out_size, void* d_ws, size_t ws_size, hipStream_t stream) {
    static int grid_blocks = 0;
    if (grid_blocks == 0) {
        if (n_in != 22 || in_sizes[0] != MTOK * DM || out_size != MTOK * DM || ws_size < WS_END) {
            fprintf(stderr, "kernel_launch: unexpected shapes (n_in %d, in0 %d, out %d, ws %zu)\n", n_in, n_in > 0 ? in_sizes[0] : -1, out_size, ws_size); grid_blocks = -1; return; }
        int dev = 0, cus = 0, per_cu = 0;
        hipGetDevice(&dev);
        hipDeviceGetAttribute(&cus, hipDeviceAttributeMultiprocessorCount, dev);
        if (hipFuncSetAttribute((const void*)fwd_megakernel, hipFuncAttributeMaxDynamicSharedMemorySize, LDS_BYTES) != hipSuccess) { fprintf(stderr, "kernel_launch: hipFuncSetAttribute failed\n"); grid_blocks = -1; return; }
        if (hipOccupancyMaxActiveBlocksPerMultiprocessor(&per_cu, (const void*)fwd_megakernel, 512, LDS_BYTES) != hipSuccess || per_cu < 1) { fprintf(stderr, "kernel_launch: occupancy query gave %d\n", per_cu); per_cu = 1; }
        (void)hipGetLastError();
        grid_blocks = cus * per_cu;
    }
    if (grid_blocks < 0) return;
    Params p{};
    const float* const* in = (const float* const*)d_in;
    p.x = in[0]; p.mem = in[1]; p.ffn1_norm = in[2]; p.ffn1_wg = in[3]; p.ffn1_wu = in[4]; p.ffn1_wd = in[5]; p.mix_norm = in[6]; p.w_in = in[7]; p.rel_bias = in[8];
    p.w_pool = in[9]; p.pool_scale = in[10]; p.w_out = in[11]; p.cross_norm = in[12]; p.mem_norm = in[13]; p.w_cq = in[14]; p.w_ckv = in[15]; p.w_co = in[16];
    p.ffn2_norm = in[17]; p.ffn2_wg = in[18]; p.ffn2_wu = in[19]; p.ffn2_wd = in[20]; p.final_norm = in[21];
    p.out = (float*)d_out; p.ws = (unsigned char*)d_ws;
    if (hipMemsetAsync((char*)d_ws + WS_BAR, 0, WS_BAR_BYTES, stream) != hipSuccess) { fprintf(stderr, "kernel_launch: memset of the barrier words failed\n"); return; }
    void* args[] = {&p};
    hipError_t e = hipLaunchCooperativeKernel((const void*)fwd_megakernel, dim3(grid_blocks), dim3(512), args, LDS_BYTES, stream);
    if (e != hipSuccess) fprintf(stderr, "cooperative launch failed: %s (grid %d)\n", hipGetErrorString(e), grid_blocks);
}
```

```cpp
#include <hip/hip_runtime.h>
#include <hip/hip_cooperative_groups.h>
#include <cstdio>
#include <cstdint>
namespace cg = cooperative_groups;

#define LAS __attribute__((address_space(3)))
typedef unsigned short bf16_t;
typedef short bf16x8 __attribute__((ext_vector_type(8)));
typedef float f32x4 __attribute__((ext_vector_type(4)));
typedef float f32x2 __attribute__((ext_vector_type(2)));
typedef unsigned u32x4 __attribute__((ext_vector_type(4)));
typedef unsigned u32x2 __attribute__((ext_vector_type(2)));

constexpr int BATCH = 16, SEQ = 2048, DM = 2048, MTOK = BATCH * SEQ;
constexpr int DFF = 5632, DIN = 4096, DATT = 1024, DPOOL = 1024, NMEM = 256, DCROSS = 512;
constexpr int NREL = 257;
constexpr float EPS = 1e-6f;
constexpr float LOG2E = 1.4426950408889634f;

constexpr size_t MiB = 1u << 20;
constexpr size_t WS_ROWSS = 0;
constexpr size_t WS_BAR = 896 * 1024, WS_BAR_BYTES = 49152, WS_PCNT = WS_BAR + 16384;
constexpr size_t WS_WGU1 = 1 * MiB, WS_WD1 = 45 * MiB, WS_WIN = 67 * MiB, WS_WP = 83 * MiB, WS_WOUT = 84 * MiB, WS_WCQ = 92 * MiB,
                 WS_WCKV = 94 * MiB, WS_WCO = 98 * MiB, WS_WGU2 = 100 * MiB, WS_WD2 = 144 * MiB;
constexpr size_t WS_HB = 166 * MiB;
constexpr size_t WS_ACT = 294 * MiB;
constexpr size_t WS_Z = 294 * MiB;
constexpr size_t WS_VT = 550 * MiB;
constexpr size_t WS_Y = 646 * MiB;
constexpr size_t WS_CQ = 646 * MiB, WS_CO = 678 * MiB;
constexpr size_t WS_DP = 774 * MiB;
constexpr size_t WS_MEMN = 838 * MiB;
constexpr size_t WS_KC = 854 * MiB;
constexpr size_t WS_VCT = 858 * MiB;
constexpr size_t WS_KF = 862 * MiB;
constexpr size_t WS_END = 926 * MiB;

#ifndef REP_G1NULL
#define REP_G1NULL 0
#endif
#ifndef REP_SYNC
#define REP_SYNC 0
#endif
#ifndef REP_G2
#define REP_G2 0
#endif
#ifndef REP_G2NULL
#define REP_G2NULL 0
#endif
#ifndef REP_ATTC
#define REP_ATTC 0
#endif
#ifndef REP_XATT
#define REP_XATT 1
#endif
#ifndef REP_P0
#define REP_P0 1
#endif
#ifndef REP_G1
#define REP_G1 1
#endif
#ifndef REP_ATT
#define REP_ATT 1
#endif
#ifndef REP_G3
#define REP_G3 1
#endif
constexpr int LDS_BYTES = 147456;

__device__ __forceinline__ unsigned cvt_pk_bf16(float lo, float hi) { unsigned r; asm volatile("v_cvt_pk_bf16_f32 %0, %1, %2" : "=v"(r) : "v"(lo), "v"(hi)); return r; }
__device__ __forceinline__ float bf_lo(unsigned w) { return __uint_as_float(w << 16); }
__device__ __forceinline__ float bf_hi(unsigned w) { return __uint_as_float(w & 0xffff0000u); }
__device__ __forceinline__ float wave_sum(float v) {
#pragma unroll
    for (int o = 1; o < 64; o <<= 1) v += __shfl_xor(v, o);
    return v;
}

namespace pg8 {
constexpr int BM = 256, BK = 64, HALF = 128, HTB = HALF * BK * 2, STAGE_BYTES = 8 * HTB, NXCD = 8;
__host__ __device__ __forceinline__ int lds_byte(int r, int c) { const int st = (r >> 4) * 2 + (c >> 5), rr = r & 15, cc = c & 31, ob = rr * 64 + cc * 2; return st * 1024 + (ob ^ (((ob >> 9) & 1) << 5)); }
__host__ __device__ __forceinline__ void stage_rc(int b, int& R, int& C) { const int st = b / 1024, sb = b % 1024, swz = sb ^ (((sb >> 9) & 1) << 5); R = (st >> 1) * 16 + swz / 64; C = (st & 1) * 32 + (swz % 64) / 2; }
__host__ __device__ __forceinline__ int perm32(int rho) { const int n = rho >> 4, i = rho & 15; return 8 * (i >> 2) + 4 * n + (i & 3); }

struct Unit { int pm, pn; };
struct Gemm { const bf16_t* A; const bf16_t* Bt; int lda, ldb, K, a_pn_step; size_t kblkA = 256, kblkB = 256; };

struct StaticOrder {
    int nM, nN, nwg, G, c, WGM, rev;
    __device__ void init(int M, int N, int G_, int c_, int wgm = 8, int rev_ = 0) { nM = M / BM; nN = N / BM; nwg = nM * nN; G = G_; c = c_; WGM = wgm; rev = rev_; }
    __device__ bool next(int i, Unit& u) const {
        const int nr = (nwg + G - 1) / G; if (i >= nr) return false;
        long L = (long)(rev ? nr - 1 - i : i) * G + c;
        if (L >= nwg) { if (!rev) return false; L = (long)(nr - 2 - i) * G + c; if (i + 1 >= nr) return false; }
        int wgid = (int)L; { const int q = nwg / NXCD, r = nwg % NXCD, xcd = wgid % NXCD, off = wgid / NXCD; wgid = (xcd < r ? xcd * (q + 1) : r * (q + 1) + (xcd - r) * q) + off; }
        const int nig = WGM * nN, gid = wgid / nig, fm = gid * WGM, gsz = (nM - fm) < WGM ? (nM - fm) : WGM;
        u.pm = fm + ((wgid % nig) % gsz); u.pn = (wgid % nig) / gsz; return true;
    }
};

template <int FMD> struct EpiBf {
    bf16_t* O; int ldc; int col_off; const float* rowss; const float* colscale; int t_lo, t_hi, t_rows, t_cols; bf16_t* VT; int k_lo, k_hi; bf16_t* KF;
    __device__ __forceinline__ void operator()(const f32x4 (&acc)[2][2][4][2], const Unit& u, int wr, int wc, int fr, int fq) const {
        const int row0 = u.pm * BM + wr * 64 + fr, cl = wc * 32 + 8 * fq;
        const bool tr = (u.pn >= t_lo) && (u.pn < t_hi);
        constexpr bool FM = FMD != 0;
        constexpr int FDH = FM ? FMD : 64, FKS = FDH / 32, FROWS = (FMD == 128) ? NMEM : SEQ, FNH = (FMD == 128) ? 4 : 16, FTPB = FROWS / 64;
        const bool kfm = FM && (u.pn >= k_lo) && (u.pn < k_hi);
        f32x4 cs[2][2]; float rsv[8];
#pragma unroll
        for (int bj = 0; bj < 2; ++bj)
#pragma unroll
            for (int n = 0; n < 2; ++n) cs[bj][n] = colscale ? *(const f32x4*)(colscale + u.pn * BM + bj * HALF + cl + 4 * n) : (f32x4){1.f, 1.f, 1.f, 1.f};
#pragma unroll
        for (int i = 0; i < 8; ++i) rsv[i] = rowss ? rowss[row0 + (i >> 2) * HALF + (i & 3) * 16] : 0.f;
        asm volatile("" ::: "memory");
#pragma unroll
        for (int ai = 0; ai < 2; ++ai)
#pragma unroll
            for (int m = 0; m < 4; ++m) {
                const int row = row0 + ai * HALF + m * 16;
                const float rsc = rowss ? __builtin_amdgcn_rsqf(rsv[ai * 4 + m] * (1.0f / DM) + EPS) : 1.0f;
#pragma unroll
                for (int bj = 0; bj < 2; ++bj) {
                    const f32x4 v0 = acc[ai][bj][m][0] * rsc * cs[bj][0], v1 = acc[ai][bj][m][1] * rsc * cs[bj][1];
                    u32x4 w; w.x = cvt_pk_bf16(v0[0], v0[1]); w.y = cvt_pk_bf16(v0[2], v0[3]); w.z = cvt_pk_bf16(v1[0], v1[1]); w.w = cvt_pk_bf16(v1[2], v1[3]);
                    if (FM && (kfm || tr)) {
                        const int c = (u.pn - (kfm ? k_lo : t_lo)) * BM + bj * HALF + cl, hh = c / FDH, d = c % FDH;
                        const int bb = row / FROWS, s = row % FROWS, tile = s >> 6, k = s & 63;
                        const size_t tbase = ((size_t)((bb * FNH + hh) * FTPB + tile)) * (64 * FDH);
                        if (kfm) {
                            const int kb = k >> 5, r = k & 31, mt = kb * 2 + ((r >> 2) & 1), fra = (r >> 3) * 4 + (r & 3), ks = d >> 5, fqa = (d >> 3) & 3;
                            *(u32x4*)(KF + tbase + ((mt * FKS + ks) * 64 + fqa * 16 + fra) * 8) = w;
                        } else {
                            const int dt = d >> 4, fra0 = d & 15, kb = k >> 5, fqa = (k & 31) >> 3, e8 = k & 7;
                            bf16_t* p = VT + tbase + ((dt * 2 + kb) * 64 + fqa * 16 + fra0) * 8 + e8;
                            p[0] = (bf16_t)(w.x & 0xffffu); p[8] = (bf16_t)(w.x >> 16); p[16] = (bf16_t)(w.y & 0xffffu); p[24] = (bf16_t)(w.y >> 16);
                            p[32] = (bf16_t)(w.z & 0xffffu); p[40] = (bf16_t)(w.z >> 16); p[48] = (bf16_t)(w.w & 0xffffu); p[56] = (bf16_t)(w.w >> 16);
                        }
                    } else if (!tr) { *(u32x4*)(O + (size_t)row * ldc + col_off + u.pn * BM + bj * HALF + cl) = w; }
                    else {
                        const int cv = (u.pn - t_lo) * BM + bj * HALF + cl, b = row / t_rows, s = row - b * t_rows;
                        bf16_t* p = VT + ((size_t)b * t_cols + cv) * t_rows + s;
                        p[0] = (bf16_t)(w.x & 0xffffu); p[(size_t)t_rows] = (bf16_t)(w.x >> 16); p[(size_t)2 * t_rows] = (bf16_t)(w.y & 0xffffu); p[(size_t)3 * t_rows] = (bf16_t)(w.y >> 16);
                        p[(size_t)4 * t_rows] = (bf16_t)(w.z & 0xffffu); p[(size_t)5 * t_rows] = (bf16_t)(w.z >> 16); p[(size_t)6 * t_rows] = (bf16_t)(w.w & 0xffffu); p[(size_t)7 * t_rows] = (bf16_t)(w.w >> 16);
                    }
                }
            }
    }
};
__device__ __forceinline__ float silu_mul(float g, float u) { return g * __builtin_amdgcn_rcpf(1.0f + __expf(-g)) * u; }
struct EpiSwiglu {
    bf16_t* O; int ldc; const float* rowss;
    __device__ __forceinline__ void operator()(const f32x4 (&acc)[2][2][4][2], const Unit& u, int wr, int wc, int fr, int fq) const {
        const int row0 = u.pm * BM + wr * 64 + fr, cl = wc * 32 + 8 * fq;
        float rsv[8];
#pragma unroll
        for (int i = 0; i < 8; ++i) rsv[i] = rowss[row0 + (i >> 2) * HALF + (i & 3) * 16];
        asm volatile("" ::: "memory");
#pragma unroll
        for (int ai = 0; ai < 2; ++ai)
#pragma unroll
            for (int m = 0; m < 4; ++m) {
                const int row = row0 + ai * HALF + m * 16;
                const float rsc = __builtin_amdgcn_rsqf(rsv[ai * 4 + m] * (1.0f / DM) + EPS);
                const f32x4 g0 = acc[ai][0][m][0] * rsc, g1 = acc[ai][0][m][1] * rsc, u0 = acc[ai][1][m][0] * rsc, u1 = acc[ai][1][m][1] * rsc;
                u32x4 w;
                w.x = cvt_pk_bf16(silu_mul(g0[0], u0[0]), silu_mul(g0[1], u0[1])); w.y = cvt_pk_bf16(silu_mul(g0[2], u0[2]), silu_mul(g0[3], u0[3]));
                w.z = cvt_pk_bf16(silu_mul(g1[0], u1[0]), silu_mul(g1[1], u1[1])); w.w = cvt_pk_bf16(silu_mul(g1[2], u1[2]), silu_mul(g1[3], u1[3]));
                *(u32x4*)(O + ((size_t)u.pn * MTOK + row) * HALF + cl) = w;
            }
    }
};
template <bool F32IN> struct EpiRes {
    const float* hin_f; bf16_t* hb; float* rowss_out; float alpha;
    static constexpr int DEPTH = F32IN ? 2 : 4, NV = F32IN ? 4 : 2;
    __device__ __forceinline__ void ld(f32x4 (&hv)[4], size_t off) const {
        if (F32IN) { hv[0] = *(const f32x4*)(hin_f + off); hv[1] = *(const f32x4*)(hin_f + off + 4); hv[2] = *(const f32x4*)(hin_f + off + HALF); hv[3] = *(const f32x4*)(hin_f + off + HALF + 4); }
        else { hv[0] = __builtin_bit_cast(f32x4, *(const u32x4*)(hb + off)); hv[1] = __builtin_bit_cast(f32x4, *(const u32x4*)(hb + off + HALF)); }
    }
    __device__ __forceinline__ void operator()(const f32x4 (&acc)[2][2][4][2], const Unit& u, int wr, int wc, int fr, int fq) const {
        const int row0 = u.pm * BM + wr * 64 + fr, cl = u.pn * BM + wc * 32 + 8 * fq;
        f32x4 hv[DEPTH][4];
#pragma unroll
        for (int gi = 0; gi < DEPTH; ++gi) ld(hv[gi], (size_t)(row0 + (gi >> 2) * HALF + (gi & 3) * 16) * DM + cl);
#pragma unroll
        for (int gi = 0; gi < 8; ++gi) {
            const int ai = gi >> 2, m = gi & 3, cb = gi % DEPTH;
            asm volatile("" ::: "memory");
            const int row = row0 + ai * HALF + m * 16; const size_t off = (size_t)row * DM + cl;
            float ss = 0.f;
            u32x4 wv[2];
#pragma unroll
            for (int bj = 0; bj < 2; ++bj) {
                f32x4 o0, o1;
                if (F32IN) { o0 = hv[cb][2 * bj]; o1 = hv[cb][2 * bj + 1]; }
                else { const u32x4 q = __builtin_bit_cast(u32x4, hv[cb][bj]); o0 = (f32x4){bf_lo(q.x), bf_hi(q.x), bf_lo(q.y), bf_hi(q.y)}; o1 = (f32x4){bf_lo(q.z), bf_hi(q.z), bf_lo(q.w), bf_hi(q.w)}; }
                const f32x4 h0 = o0 + acc[ai][bj][m][0] * alpha, h1 = o1 + acc[ai][bj][m][1] * alpha;
                ss += (h0[0] * h0[0] + h0[1] * h0[1]) + (h0[2] * h0[2] + h0[3] * h0[3]) + (h1[0] * h1[0] + h1[1] * h1[1]) + (h1[2] * h1[2] + h1[3] * h1[3]);
                wv[bj].x = cvt_pk_bf16(h0[0], h0[1]); wv[bj].y = cvt_pk_bf16(h0[2], h0[3]); wv[bj].z = cvt_pk_bf16(h1[0], h1[1]); wv[bj].w = cvt_pk_bf16(h1[2], h1[3]);
            }
            if (gi + DEPTH < 8) ld(hv[cb], (size_t)(row0 + ((gi + DEPTH) >> 2) * HALF + ((gi + DEPTH) & 3) * 16) * DM + cl);
            *(u32x4*)(hb + off) = wv[0]; *(u32x4*)(hb + off + HALF) = wv[1];
            ss += __shfl_xor(ss, 16); ss += __shfl_xor(ss, 32);
            if (rowss_out && fq == 0) __hip_atomic_fetch_add(rowss_out + row, ss, __ATOMIC_RELAXED, __HIP_MEMORY_SCOPE_AGENT);
        }
    }
};

struct EpiResFinal {
    bf16_t* hb; float* rowss_out; float alpha; float* out; const float* gain; unsigned* cnt;
    __device__ __forceinline__ void operator()(f32x4 (&acc)[2][2][4][2], const Unit& u, int wr, int wc, int fr, int fq) const {
        const int row0 = u.pm * BM + wr * 64 + fr, cl = u.pn * BM + wc * 32 + 8 * fq;
        u32x4 hv[4][2];
#pragma unroll
        for (int gi = 0; gi < 4; ++gi) { const size_t off = (size_t)(row0 + (gi >> 2) * HALF + (gi & 3) * 16) * DM + cl; hv[gi][0] = *(const u32x4*)(hb + off); hv[gi][1] = *(const u32x4*)(hb + off + HALF); }
#pragma unroll
        for (int gi = 0; gi < 8; ++gi) {
            const int ai = gi >> 2, m = gi & 3, cb = gi & 3;
            asm volatile("" ::: "memory");
            const int row = row0 + ai * HALF + m * 16;
            float ss = 0.f;
#pragma unroll
            for (int bj = 0; bj < 2; ++bj) {
                const u32x4 q = hv[cb][bj];
                const f32x4 h0 = (f32x4){bf_lo(q.x), bf_hi(q.x), bf_lo(q.y), bf_hi(q.y)} + acc[ai][bj][m][0] * alpha, h1 = (f32x4){bf_lo(q.z), bf_hi(q.z), bf_lo(q.w), bf_hi(q.w)} + acc[ai][bj][m][1] * alpha;
                ss += (h0[0] * h0[0] + h0[1] * h0[1]) + (h0[2] * h0[2] + h0[3] * h0[3]) + (h1[0] * h1[0] + h1[1] * h1[1]) + (h1[2] * h1[2] + h1[3] * h1[3]);
                acc[ai][bj][m][0] = h0; acc[ai][bj][m][1] = h1;
            }
            if (gi + 4 < 8) { const size_t offn = (size_t)(row0 + ((gi + 4) >> 2) * HALF + ((gi + 4) & 3) * 16) * DM + cl; hv[cb][0] = *(const u32x4*)(hb + offn); hv[cb][1] = *(const u32x4*)(hb + offn + HALF); }
            ss += __shfl_xor(ss, 16); ss += __shfl_xor(ss, 32);
            if (fq == 0) __hip_atomic_fetch_add(rowss_out + row, ss, __ATOMIC_RELAXED, __HIP_MEMORY_SCOPE_AGENT);
        }
        asm volatile("s_waitcnt vmcnt(0)" ::: "memory");
        __builtin_amdgcn_s_barrier(); asm volatile("" ::: "memory");
        if (threadIdx.x == 0) {
            unsigned* c = cnt + 64 * u.pm;
            __hip_atomic_fetch_add(c, 1u, __ATOMIC_RELAXED, __HIP_MEMORY_SCOPE_AGENT);
            unsigned sp = 0;
            while (__hip_atomic_load(c, __ATOMIC_RELAXED, __HIP_MEMORY_SCOPE_AGENT) < 8u) { __builtin_amdgcn_s_sleep(1); if (++sp > (1u << 22)) break; }
            __builtin_amdgcn_fence(__ATOMIC_ACQUIRE, "agent");
            asm volatile("s_waitcnt vmcnt(0)" ::: "memory");
        }
        __builtin_amdgcn_s_barrier(); asm volatile("" ::: "memory");
        float rsv[8];
#pragma unroll
        for (int i = 0; i < 8; ++i) rsv[i] = __hip_atomic_load(rowss_out + row0 + (i >> 2) * HALF + (i & 3) * 16, __ATOMIC_RELAXED, __HIP_MEMORY_SCOPE_AGENT);
        f32x4 gv[2][2];
#pragma unroll
        for (int bj = 0; bj < 2; ++bj) { gv[bj][0] = *(const f32x4*)(gain + cl + bj * HALF); gv[bj][1] = *(const f32x4*)(gain + cl + bj * HALF + 4); }
#pragma unroll
        for (int gi = 0; gi < 8; ++gi) {
            const int ai = gi >> 2, m = gi & 3; const size_t off = (size_t)(row0 + ai * HALF + m * 16) * DM + cl;
            const float rs = __builtin_amdgcn_rsqf(rsv[gi] * (1.0f / DM) + EPS);
#pragma unroll
            for (int bj = 0; bj < 2; ++bj) { *(f32x4*)(out + off + bj * HALF) = acc[ai][bj][m][0] * rs * gv[bj][0]; *(f32x4*)(out + off + bj * HALF + 4) = acc[ai][bj][m][1] * rs * gv[bj][1]; }
        }
    }
};
struct EpiNull {
    __device__ __forceinline__ void operator()(const f32x4 (&acc)[2][2][4][2], const Unit& u, int wr, int wc, int fr, int fq) const {
#pragma unroll
        for (int ai = 0; ai < 2; ++ai)
#pragma unroll
            for (int bj = 0; bj < 2; ++bj)
#pragma unroll
                for (int m = 0; m < 4; ++m) asm volatile("" :: "v"(acc[ai][bj][m][0]), "v"(acc[ai][bj][m][1]));
    }
};

template <class Epi, bool ALIGN_EPI = true, int AUX_A = 0>
__device__ __forceinline__ void gemm_phase(LAS unsigned char* lds, const Gemm g, const StaticOrder& S, const Epi& E) {
    int tid_l = threadIdx.x; asm volatile("" : "+v"(tid_l));
    const int tid = tid_l, wid = __builtin_amdgcn_readfirstlane(tid >> 6), lane = tid & 63, wr = wid >> 2, wc = wid & 3, fr = lane & 15, fq = lane >> 4;
    const int K = g.K, nt = K / BK;
    unsigned voffA[2], voffB[2];
#pragma unroll
    for (int i = 0; i < 2; ++i) { int R, C; stage_rc(tid * 16 + i * 8192, R, C); const int Rb = (R & ~31) + perm32(R & 31);
        voffA[i] = (unsigned)(R * g.lda + C) * 2u; voffB[i] = (unsigned)(Rb * g.ldb + C) * 2u; }
    const size_t kstep = (size_t)(BK * 2);
    const size_t hstepA = (size_t)HALF * g.lda * 2, hstepB = (size_t)HALF * g.ldb * 2;
    const size_t tstepA = 2 * hstepA, tstepB = 2 * hstepB;
    const unsigned ldsw = (unsigned)wid * 1024u;
    const int aoff = lds_byte(wr * 64 + fr, fq * 8), boff = lds_byte(wc * 32 + fr, fq * 8);
#define PG8_SA(b, h) (((b) * 2 + (h)) * HTB)
#define PG8_SB(b, h) ((4 + (b) * 2 + (h)) * HTB)
#define PG8_STAGE_X(bufoff, gbase, voff, aux) do { _Pragma("unroll") for (int _i = 0; _i < 2; ++_i) \
        __builtin_amdgcn_global_load_lds((const unsigned*)((const char*)(gbase) + (voff)[_i]), (LAS unsigned*)(lds + (bufoff) + ldsw + _i * 8192), 16, 0, aux); } while (0)
#define PG8_STAGE(bufoff, gbase, voff) PG8_STAGE_X(bufoff, gbase, voff, 0)
#define PG8_LDA(dst, b, h) do { _Pragma("unroll") for (int m = 0; m < 4; ++m) _Pragma("unroll") for (int k = 0; k < 2; ++k) dst[m][k] = *(const LAS bf16x8*)(lds + PG8_SA(b, h) + aoff + m * 2048 + k * 1024); } while (0)
#define PG8_LDB(dst, b, h) do { _Pragma("unroll") for (int n = 0; n < 2; ++n) _Pragma("unroll") for (int k = 0; k < 2; ++k) dst[n][k] = *(const LAS bf16x8*)(lds + PG8_SB(b, h) + boff + n * 2048 + k * 1024); } while (0)
#define PG8_MMA(ai, bj, At, Bt) do { __builtin_amdgcn_s_setprio(1); _Pragma("unroll") for (int m = 0; m < 4; ++m) _Pragma("unroll") for (int n = 0; n < 2; ++n) _Pragma("unroll") for (int k = 0; k < 2; ++k) \
        acc[ai][bj][m][n] = __builtin_amdgcn_mfma_f32_16x16x32_bf16(Bt[n][k], At[m][k], acc[ai][bj][m][n], 0, 0, 0); __builtin_amdgcn_s_setprio(0); } while (0)
#define PG8_WAIT_V(n) asm volatile("s_waitcnt vmcnt(" #n ")" ::: "memory")
#define PG8_WAIT_L(n) asm volatile("s_waitcnt lgkmcnt(" #n ")" ::: "memory")
#define PG8_BAR __builtin_amdgcn_s_barrier()
#define PG8_SCHED __builtin_amdgcn_sched_barrier(0)
    Unit cur, nxt; int ui = 0;
    if (!S.next(0, cur)) return;
    f32x4 acc[2][2][4][2];
#pragma unroll
    for (int a = 0; a < 2; ++a)
#pragma unroll
        for (int b = 0; b < 2; ++b)
#pragma unroll
            for (int m = 0; m < 4; ++m)
#pragma unroll
                for (int n = 0; n < 2; ++n) acc[a][b][m][n] = (f32x4){0.f, 0.f, 0.f, 0.f};
    bf16x8 At[4][2], B0[2][2], B1[2][2];
    const char* cA = (const char*)g.A + (size_t)cur.pm * tstepA + (size_t)cur.pn * g.a_pn_step; const char* cB = (const char*)g.Bt + (size_t)cur.pn * tstepB;
    PG8_STAGE(PG8_SB(0, 0), cB, voffB); PG8_STAGE(PG8_SB(0, 1), cB + hstepB, voffB); PG8_STAGE_X(PG8_SA(0, 0), cA, voffA, AUX_A); PG8_STAGE_X(PG8_SA(0, 1), cA + hstepA, voffA, AUX_A);
    if (wr == 1) PG8_BAR;
    PG8_WAIT_V(2); PG8_BAR;
    PG8_STAGE(PG8_SB(1, 0), cB + kstep, voffB); PG8_STAGE_X(PG8_SA(1, 0), cA + kstep, voffA, AUX_A); PG8_STAGE(PG8_SB(1, 1), cB + hstepB + kstep, voffB);
    PG8_WAIT_V(6); PG8_BAR;
    for (;;) {
        const bool has_next = S.next(ui + 1, nxt);
        const char* nA = has_next ? (const char*)g.A + (size_t)nxt.pm * tstepA + (size_t)nxt.pn * g.a_pn_step : cA; const char* nB = has_next ? (const char*)g.Bt + (size_t)nxt.pn * tstepB : cB;
        for (int t = 0; t < nt; t += 2) {
            const bool last = (t == nt - 2);
            const size_t kbi = (size_t)(t >> 1);
            const char* a1 = cA + kbi * g.kblkA + kstep;
            const char* a2 = last ? nA : cA + (kbi + 1) * g.kblkA; const char* b2 = last ? nB : cB + (kbi + 1) * g.kblkB;
            const char* a3 = a2 + kstep; const char* b3 = b2 + kstep;
            PG8_LDB(B0, 0, 0); PG8_LDB(B1, 0, 1); PG8_SCHED; PG8_LDA(At, 0, 0); PG8_STAGE_X(PG8_SA(1, 1), a1 + hstepA, voffA, AUX_A);
            PG8_WAIT_V(8); PG8_WAIT_L(0); PG8_BAR; PG8_MMA(0, 0, At, B0); PG8_MMA(0, 1, At, B1); PG8_BAR; PG8_SCHED;
            PG8_LDA(At, 0, 1); PG8_STAGE(PG8_SB(0, 0), b2, voffB); PG8_STAGE(PG8_SB(0, 1), b2 + hstepB, voffB); PG8_STAGE_X(PG8_SA(0, 0), a2, voffA, AUX_A);
            PG8_WAIT_V(8); PG8_WAIT_L(0); PG8_BAR; PG8_MMA(1, 0, At, B0); PG8_MMA(1, 1, At, B1); PG8_BAR; PG8_SCHED;
            PG8_LDB(B0, 1, 0); PG8_LDB(B1, 1, 1); PG8_SCHED; PG8_LDA(At, 1, 0); PG8_STAGE_X(PG8_SA(0, 1), a2 + hstepA, voffA, AUX_A);
            PG8_WAIT_V(8); PG8_WAIT_L(0); PG8_BAR; PG8_MMA(0, 0, At, B0); PG8_MMA(0, 1, At, B1); PG8_BAR; PG8_SCHED;
            PG8_LDA(At, 1, 1); PG8_STAGE(PG8_SB(1, 0), b3, voffB); PG8_STAGE(PG8_SB(1, 1), b3 + hstepB, voffB); PG8_STAGE_X(PG8_SA(1, 0), a3, voffA, AUX_A);
            PG8_WAIT_V(8); PG8_WAIT_L(0); PG8_BAR; PG8_MMA(1, 0, At, B0); PG8_MMA(1, 1, At, B1); PG8_BAR; PG8_SCHED;
        }
        if constexpr (ALIGN_EPI) { if (wr == 0) PG8_BAR; }
        E(acc, cur, wr, wc, fr, fq);
        if (!has_next) break;
#pragma unroll
        for (int a = 0; a < 2; ++a)
#pragma unroll
            for (int b = 0; b < 2; ++b)
#pragma unroll
                for (int m = 0; m < 4; ++m)
#pragma unroll
                    for (int n = 0; n < 2; ++n) acc[a][b][m][n] = (f32x4){0.f, 0.f, 0.f, 0.f};
        cur = nxt; cA = nA; cB = nB; ++ui;
        if constexpr (ALIGN_EPI) { if (wr == 1) PG8_BAR; }
    }
    PG8_WAIT_V(0);
    if constexpr (!ALIGN_EPI) { if (wr == 0) PG8_BAR; }
    PG8_BAR;
#undef PG8_SA
#undef PG8_SB
#undef PG8_STAGE
#undef PG8_STAGE_X
#undef PG8_LDA
#undef PG8_LDB
#undef PG8_MMA
#undef PG8_WAIT_V
#undef PG8_WAIT_L
#undef PG8_BAR
#undef PG8_SCHED
}
}

template <int DH, bool BIAS, int NT, bool PF, bool COAL = false, bool VDB = true>
__device__ __forceinline__ void attn_wave32(const bf16_t* __restrict__ Qp, int ldq, const bf16_t* __restrict__ Kp, int ldk, const bf16_t* __restrict__ Vp, int ldv,
                                            bf16_t* __restrict__ Op, int ldo, int ntiles, float sc, const LAS float* tab, int rel_base, int lane) {
    constexpr int KS = DH / 32, DT = DH / 16;
    asm volatile("" : "+v"(lane));
    const int fr = lane & 15, fq = lane >> 4;
    bf16x8 qf[NT][KS];
#pragma unroll
    for (int nt = 0; nt < NT; ++nt)
#pragma unroll
        for (int ks = 0; ks < KS; ++ks) qf[nt][ks] = *(const bf16x8*)(Qp + (size_t)(nt * 16 + fr) * ldq + ks * 32 + fq * 8);
    f32x4 o[DT][NT];
#pragma unroll
    for (int dt = 0; dt < DT; ++dt)
#pragma unroll
        for (int nt = 0; nt < NT; ++nt) o[dt][nt] = (f32x4){0.f, 0.f, 0.f, 0.f};
    float mrun[NT], lrun[NT];
#pragma unroll
    for (int nt = 0; nt < NT; ++nt) { mrun[nt] = -1e30f; lrun[nt] = 0.f; }
    const bf16_t* kbase = Kp + (size_t)(8 * (fr >> 2) + (fr & 3)) * ldk + fq * 8;
    const bf16_t* vbase = Vp + (size_t)fr * ldv + fq * 8;
    bf16x8 kf[4][KS], vfA[DT][2], vfB[DT][2];
#define ATT_LOADK(tt) do { _Pragma("unroll") for (int mt = 0; mt < 4; ++mt) _Pragma("unroll") for (int ks = 0; ks < KS; ++ks) \
        kf[mt][ks] = COAL ? *(const bf16x8*)(Kp + (size_t)(tt) * (64 * DH) + (mt * KS + ks) * 512 + lane * 8) \
                          : *(const bf16x8*)(kbase + (size_t)((tt) * 64 + (mt >> 1) * 32 + 4 * (mt & 1)) * ldk + ks * 32); } while (0)
#define ATT_LOADV(dst, tt) do { _Pragma("unroll") for (int dt = 0; dt < DT; ++dt) _Pragma("unroll") for (int kb = 0; kb < 2; ++kb) \
        dst[dt][kb] = COAL ? *(const bf16x8*)(Vp + (size_t)(tt) * (64 * DH) + (dt * 2 + kb) * 512 + lane * 8) \
                           : *(const bf16x8*)(vbase + (size_t)(dt * 16) * ldv + (tt) * 64 + kb * 32); } while (0)
#define ATT_BODY(t, vcur, vnext) do { \
        const int tn_ = ((t) + 1 < ntiles) ? (t) + 1 : (t); \
        if (PF && VDB) ATT_LOADV(vnext, tn_); else if (PF) ATT_LOADV(vcur, t); else ATT_LOADK(t); \
        f32x4 s[4][NT]; \
        _Pragma("unroll") for (int mt = 0; mt < 4; ++mt) _Pragma("unroll") for (int nt = 0; nt < NT; ++nt) { s[mt][nt] = (f32x4){0.f, 0.f, 0.f, 0.f}; \
            _Pragma("unroll") for (int ks = 0; ks < KS; ++ks) s[mt][nt] = __builtin_amdgcn_mfma_f32_16x16x32_bf16(kf[mt][ks], qf[nt][ks], s[mt][nt], 0, 0, 0); } \
        if (PF) ATT_LOADK(tn_); \
        bf16x8 pf[NT][2]; \
          \
        const LAS float* tb_ = tab + (rel_base - 64 * (t) + fr - 8 * fq + 63 - 39); \
        _Pragma("unroll") for (int nt = 0; nt < NT; ++nt) { \
            float mloc = -1e30f; \
            _Pragma("unroll") for (int mt = 0; mt < 4; ++mt) _Pragma("unroll") for (int j = 0; j < 4; ++j) { \
                float v = s[mt][nt][j] * sc; \
                if (BIAS) v += tb_[39 + nt * 16 - ((mt >> 1) * 32 + 4 * (mt & 1) + j)]; \
                s[mt][nt][j] = v; mloc = fmaxf(mloc, v); } \
            mloc = fmaxf(mloc, __shfl_xor(mloc, 16)); mloc = fmaxf(mloc, __shfl_xor(mloc, 32)); \
            const float mnew = fmaxf(mrun[nt], mloc), alpha = __builtin_amdgcn_exp2f(mrun[nt] - mnew); \
            mrun[nt] = mnew; \
            float ls = 0.f; \
            _Pragma("unroll") for (int mt = 0; mt < 4; ++mt) _Pragma("unroll") for (int j = 0; j < 4; ++j) { const float p = __builtin_amdgcn_exp2f(s[mt][nt][j] - mnew); s[mt][nt][j] = p; ls += p; } \
            lrun[nt] = lrun[nt] * alpha + ls; \
            _Pragma("unroll") for (int dt = 0; dt < DT; ++dt) o[dt][nt] = o[dt][nt] * alpha; \
            _Pragma("unroll") for (int kb = 0; kb < 2; ++kb) { \
                u32x4 w; w.x = cvt_pk_bf16(s[2 * kb][nt][0], s[2 * kb][nt][1]); w.y = cvt_pk_bf16(s[2 * kb][nt][2], s[2 * kb][nt][3]); \
                w.z = cvt_pk_bf16(s[2 * kb + 1][nt][0], s[2 * kb + 1][nt][1]); w.w = cvt_pk_bf16(s[2 * kb + 1][nt][2], s[2 * kb + 1][nt][3]); \
                pf[nt][kb] = __builtin_bit_cast(bf16x8, w); } } \
        if (!PF) { asm volatile("" ::: "memory"); ATT_LOADV(vcur, t); } \
        _Pragma("unroll") for (int dt = 0; dt < DT; ++dt) _Pragma("unroll") for (int nt = 0; nt < NT; ++nt) _Pragma("unroll") for (int kb = 0; kb < 2; ++kb) \
            o[dt][nt] = __builtin_amdgcn_mfma_f32_16x16x32_bf16(vcur[dt][kb], pf[nt][kb], o[dt][nt], 0, 0, 0); \
    } while (0)
    if (PF && VDB) { ATT_LOADK(0); ATT_LOADV(vfA, 0);
#pragma nounroll
        for (int t = 0; t < ntiles; t += 2) {
            ATT_BODY(t, vfA, vfB);
            if (t + 1 < ntiles) ATT_BODY(t + 1, vfB, vfA);
        }
    } else if (PF) { ATT_LOADK(0);
#pragma nounroll
        for (int t = 0; t < ntiles; ++t) ATT_BODY(t, vfA, vfB);
    } else {
#pragma nounroll
        for (int t = 0; t < ntiles; ++t) ATT_BODY(t, vfA, vfB);
    }
#undef ATT_BODY
#undef ATT_LOADK
#undef ATT_LOADV
#pragma unroll
    for (int nt = 0; nt < NT; ++nt) {
        float l = lrun[nt]; l += __shfl_xor(l, 16); l += __shfl_xor(l, 32);
        const float inv = 1.0f / l;
#pragma unroll
        for (int dt = 0; dt < DT; ++dt) {
            const f32x4 v = o[dt][nt] * inv; u32x2 w; w.x = cvt_pk_bf16(v[0], v[1]); w.y = cvt_pk_bf16(v[2], v[3]);
            *(u32x2*)(Op + (size_t)(nt * 16 + fr) * ldo + dt * 16 + 4 * fq) = w;
        }
    }
}

#define XB_TMO      128
#define XB_XCNT(j)  (256  + 64 * (j))
#define XB_XSUB(j)  (1280 + 64 * (j))
#define XB_XGEN(j)  (2304 + 64 * (j))
#define XB_TOP      3328
#define XB_TOPGEN   3392
#define XCD_BAR_WORDS 3456
#define XB_SPIN_CAP (1u << 22)
__device__ __forceinline__ unsigned xb_ld(unsigned* p)              { return __hip_atomic_load(p, __ATOMIC_RELAXED, __HIP_MEMORY_SCOPE_AGENT); }
__device__ __forceinline__ unsigned xb_add(unsigned* p, unsigned v) { return __hip_atomic_fetch_add(p, v, __ATOMIC_RELAXED, __HIP_MEMORY_SCOPE_AGENT); }
__device__ __forceinline__ unsigned xb_xcc_id() { return (unsigned)__builtin_amdgcn_s_getreg((3 << 11) | 20) & 0xFu; }
#define XB_SPIN(cond, bar) do { unsigned _sp = 0; while (cond) { __builtin_amdgcn_s_sleep(1); \
    if ((++_sp & 255u) == 0u) { if (xb_ld(&(bar)[XB_TMO])) break; if (_sp > XB_SPIN_CAP) { atomicAdd(&(bar)[XB_TMO], 1u); break; } } } } while (0)
struct XcdBarrier { unsigned* bar; unsigned x; volatile LAS unsigned* st; };
__device__ __forceinline__ XcdBarrier xcd_barrier_post(unsigned* bar, volatile LAS unsigned* st) {
    XcdBarrier b; b.bar = bar; b.x = xb_xcc_id(); b.st = st;
    if (threadIdx.x == 0) (void)xb_add(&bar[XB_XCNT(b.x)], 1u);
    return b;
}
__device__ __forceinline__ void xcd_barrier_complete(unsigned* bar, unsigned x, unsigned& nloc, unsigned& nx) {
    const unsigned G = gridDim.x * gridDim.y * gridDim.z;
    unsigned sum, cnt, mine, sp = 0u;
    for (;;) {
        sum = 0u; cnt = 0u; mine = 0u;
#pragma unroll
        for (unsigned j = 0; j < 16; ++j) { const unsigned c = xb_ld(&bar[XB_XCNT(j)]); sum += c; cnt += (c > 0u) ? 1u : 0u; mine = (j == x) ? c : mine; }
        if (sum == G) break;
        __builtin_amdgcn_s_sleep(1);
        if ((++sp & 255u) == 0u) { if (xb_ld(&bar[XB_TMO])) break; if (sp > XB_SPIN_CAP) { atomicAdd(&bar[XB_TMO], 1u); break; } }
    }
    nloc = mine > 0u ? mine : 1u; nx = cnt > 0u ? cnt : 1u;
}
__device__ __forceinline__ void xcd_barrier(const XcdBarrier& b) {
    asm volatile("s_waitcnt vmcnt(0)" ::: "memory");
    __syncthreads();
    if (threadIdx.x == 0) {
        unsigned* bar = b.bar;
        __builtin_amdgcn_s_waitcnt(0);
        unsigned nloc = b.st[0], nx = b.st[1];
        if (nloc == 0u) { xcd_barrier_complete(bar, b.x, nloc, nx); b.st[0] = nloc; b.st[1] = nx; }
        const unsigned old = xb_add(&bar[XB_XSUB(b.x)], 1u);
        const unsigned gen = old / nloc;
        if (old + 1u == (gen + 1u) * nloc) {
            __builtin_amdgcn_fence(__ATOMIC_RELEASE, "agent");
            asm volatile("s_waitcnt vmcnt(0)" ::: "memory");
            const unsigned og = xb_add(&bar[XB_TOP], 1u);
            const unsigned tg = og / nx;
            if (og + 1u == (tg + 1u) * nx) xb_add(&bar[XB_TOPGEN], 1u);
            else XB_SPIN(xb_ld(&bar[XB_TOPGEN]) == tg, bar);
            __builtin_amdgcn_fence(__ATOMIC_ACQUIRE, "agent");
            xb_add(&bar[XB_XGEN(b.x)], 1u);
            asm volatile("s_waitcnt vmcnt(0)" ::: "memory");
        } else {
            XB_SPIN(xb_ld(&bar[XB_XGEN(b.x)]) == gen, bar);
            __builtin_amdgcn_fence(__ATOMIC_ACQUIRE, "agent");
            asm volatile("s_waitcnt vmcnt(0)" ::: "memory");
        }
    }
    __syncthreads();
}

struct Params {
    const float* x; const float* mem;
    const float* ffn1_norm; const float* ffn1_wg; const float* ffn1_wu; const float* ffn1_wd;
    const float* mix_norm; const float* w_in; const float* rel_bias; const float* w_pool; const float* pool_scale; const float* w_out;
    const float* cross_norm; const float* mem_norm; const float* w_cq; const float* w_ckv; const float* w_co;
    const float* ffn2_norm; const float* ffn2_wg; const float* ffn2_wu; const float* ffn2_wd; const float* final_norm;
    float* out; unsigned char* ws;
};

__device__ __forceinline__ void p0_transpose_item(const float* __restrict__ W, int K, int N, bf16_t* __restrict__ WT, int mode, int row_off, const float* __restrict__ gain, LAS float* scr, int item, int lane) {
    const int nblk = N / 32, kb = item / nblk, nb = item - kb * nblk, k0 = 64 * kb, n0 = 32 * nb;
    {
        const int kr = lane >> 3, n4 = (lane & 7) * 4;
        f32x4 v[8]; float gk[8];
#pragma unroll
        for (int i = 0; i < 8; ++i) { v[i] = *(const f32x4*)(W + (size_t)(k0 + 8 * i + kr) * N + n0 + n4); gk[i] = gain ? gain[k0 + 8 * i + kr] : 1.0f; }
#pragma unroll
        for (int i = 0; i < 8; ++i) { LAS float* d = scr + (8 * i + kr) * 33 + n4; d[0] = v[i][0] * gk[i]; d[1] = v[i][1] * gk[i]; d[2] = v[i][2] * gk[i]; d[3] = v[i][3] * gk[i]; }
    }
    asm volatile("s_waitcnt lgkmcnt(0)" ::: "memory");
    const int c = lane & 7;
    const int d0 = (mode == 0 || mode == 3) ? (row_off + n0) : ((n0 >> 7) * 256 + (n0 & 127) + (mode == 2 ? 128 : 0));
#pragma unroll
    for (int j = 0; j < 4; ++j) { const int n = (lane >> 3) + 8 * j; const LAS float* s = scr + (8 * c) * 33 + n;
        u32x4 o; o.x = cvt_pk_bf16(s[0 * 33], s[1 * 33]); o.y = cvt_pk_bf16(s[2 * 33], s[3 * 33]); o.z = cvt_pk_bf16(s[4 * 33], s[5 * 33]); o.w = cvt_pk_bf16(s[6 * 33], s[7 * 33]);
        if (mode == 3) *(u32x4*)(WT + ((size_t)(k0 >> 7) * N + (row_off + n0 + n)) * 128 + (k0 & 127) + 8 * c) = o;
        else *(u32x4*)(WT + (size_t)(d0 + n) * K + k0 + 8 * c) = o; }
    asm volatile("s_waitcnt lgkmcnt(0)" ::: "memory");
}

#define rowss ((float*)(P.ws + WS_ROWSS))
#define Wgu1 ((bf16_t*)(P.ws + WS_WGU1))
#define Wd1 ((bf16_t*)(P.ws + WS_WD1))
#define Win ((bf16_t*)(P.ws + WS_WIN))
#define Wp ((bf16_t*)(P.ws + WS_WP))
#define Wout ((bf16_t*)(P.ws + WS_WOUT))
#define Wcq ((bf16_t*)(P.ws + WS_WCQ))
#define Wckv ((bf16_t*)(P.ws + WS_WCKV))
#define Wco ((bf16_t*)(P.ws + WS_WCO))
#define Wgu2 ((bf16_t*)(P.ws + WS_WGU2))
#define Wd2 ((bf16_t*)(P.ws + WS_WD2))
#define HB ((bf16_t*)(P.ws + WS_HB))
#define ACT ((bf16_t*)(P.ws + WS_ACT))
#define Z ((bf16_t*)(P.ws + WS_Z))
#define VT ((bf16_t*)(P.ws + WS_VT))
#define Y ((bf16_t*)(P.ws + WS_Y))
#define CQ ((bf16_t*)(P.ws + WS_CQ))
#define CO ((bf16_t*)(P.ws + WS_CO))
#define DP ((bf16_t*)(P.ws + WS_DP))
#define MEMN ((bf16_t*)(P.ws + WS_MEMN))
#define KC ((bf16_t*)(P.ws + WS_KC))
#define VCT ((bf16_t*)(P.ws + WS_VCT))
#define KF ((bf16_t*)(P.ws + WS_KF))
constexpr int I_G = (DM / 64) * (DFF / 32), I_D = (DFF / 64) * (DM / 32), I_IN = (DM / 64) * (DIN / 32), I_P = (256 / 64) * (256 / 32), I_O = (DM / 64) * (DM / 32),
              I_CQ = (DM / 64) * (DCROSS / 32), I_CKV = (DM / 64) * (2 * DCROSS / 32), I_CO = (DCROSS / 64) * (DM / 32);
constexpr int N_EARLY = 2 * I_G + I_D + I_IN + 4 * I_P + I_CKV, NITEMS = N_EARLY + 2 * I_G + I_D + I_O + I_CQ + I_CO;
#define CONVERT_ITEM(it_, lane) do { int r = (it_); \
        if (r < I_G) { p0_transpose_item(P.ffn1_wg, DM, DFF, Wgu1, 1, 0, P.ffn1_norm, scr, r, lane); break; } r -= I_G; \
        if (r < I_G) { p0_transpose_item(P.ffn1_wu, DM, DFF, Wgu1, 2, 0, P.ffn1_norm, scr, r, lane); break; } r -= I_G; \
        if (r < I_D) { p0_transpose_item(P.ffn1_wd, DFF, DM, Wd1, 3, 0, nullptr, scr, r, lane); break; } r -= I_D; \
        if (r < I_IN) { p0_transpose_item(P.w_in, DM, DIN, Win, 0, 0, P.mix_norm, scr, r, lane); break; } r -= I_IN; \
        if (r < 4 * I_P) { const int gi = r / I_P; p0_transpose_item(P.w_pool + (size_t)gi * 65536, 256, 256, Wp, 0, gi * 256, nullptr, scr, r - gi * I_P, lane); break; } r -= 4 * I_P; \
        if (r < I_CKV) { p0_transpose_item(P.w_ckv, DM, 2 * DCROSS, Wckv, 0, 0, nullptr, scr, r, lane); break; } r -= I_CKV; \
        if (r < I_G) { p0_transpose_item(P.ffn2_wg, DM, DFF, Wgu2, 1, 0, P.ffn2_norm, scr, r, lane); break; } r -= I_G; \
        if (r < I_G) { p0_transpose_item(P.ffn2_wu, DM, DFF, Wgu2, 2, 0, P.ffn2_norm, scr, r, lane); break; } r -= I_G; \
        if (r < I_D) { p0_transpose_item(P.ffn2_wd, DFF, DM, Wd2, 3, 0, nullptr, scr, r, lane); break; } r -= I_D; \
        if (r < I_O) { p0_transpose_item(P.w_out, DM, DM, Wout, 0, 0, nullptr, scr, r, lane); break; } r -= I_O; \
        if (r < I_CQ) { p0_transpose_item(P.w_cq, DM, DCROSS, Wcq, 0, 0, P.cross_norm, scr, r, lane); break; } r -= I_CQ; \
        p0_transpose_item(P.w_co, DCROSS, DM, Wco, 0, 0, nullptr, scr, r, lane); } while (0)
__global__ void __launch_bounds__(512, 2) fwd_megakernel(Params P) {
    extern __shared__ __attribute__((aligned(16))) unsigned char lds_raw[];
    cg::grid_group grid = cg::this_grid();
    LAS unsigned char* lds = (LAS unsigned char*)lds_raw;
    const int tid = threadIdx.x, lane = tid & 63, wave = __builtin_amdgcn_readfirstlane(tid >> 6);
    const int G = gridDim.x, bx = blockIdx.x;
    const int gw = bx * 8 + wave, NGW = G * 8;
    volatile LAS unsigned* bst = (volatile LAS unsigned*)(lds + 131072 + 64);
    if (tid < 2) bst[tid] = 0u;
    __syncthreads();
    const XcdBarrier xbar = xcd_barrier_post((unsigned*)(P.ws + WS_BAR), bst);
#ifndef WGM_RES
#define WGM_RES 8
#endif
#ifndef REV_DOWN
#define REV_DOWN 1
#endif
#define RUN_GEMM_ON(EPI, gM, gN, gdesc, edesc, G_, c_) do { pg8::StaticOrder S_; S_.init((gM), (gN), (G_), (c_), ((gN) == DM) ? WGM_RES : 8); pg8::gemm_phase<EPI>(lds, (gdesc), S_, (edesc)); } while (0)
#define RUN_GEMM(EPI, gM, gN, gdesc, edesc) RUN_GEMM_ON(EPI, gM, gN, gdesc, edesc, G, bx)
#ifndef AUX_DOWN
#define AUX_DOWN 0
#endif
#define RUN_GEMM_NT(EPI, gM, gN, gdesc, edesc) do { pg8::StaticOrder S_; S_.init((gM), (gN), G, bx, ((gN) == DM) ? WGM_RES : 8, REV_DOWN); pg8::gemm_phase<EPI, true, AUX_DOWN>(lds, (gdesc), S_, (edesc)); } while (0)

    for (int rep_ = 0; rep_ < REP_P0; ++rep_) {
        LAS float* scr = (LAS float*)(lds + wave * 16384);
        for (int it = gw; it < N_EARLY; it += NGW) CONVERT_ITEM(it, lane);
        for (int i = bx * 512 + tid; i < 4 * MTOK; i += G * 512) rowss[MTOK + i] = 0.f;
        for (int m = gw; m < MTOK; m += NGW) {
            const f32x4* xr = (const f32x4*)(P.x + (size_t)m * DM) + lane; u32x2* o8 = (u32x2*)(HB + (size_t)m * DM) + lane; float s = 0.f;
#pragma unroll
            for (int j = 0; j < 8; ++j) { const f32x4 v = xr[64 * j]; s += (v[0] * v[0] + v[1] * v[1]) + (v[2] * v[2] + v[3] * v[3]); u32x2 w; w.x = cvt_pk_bf16(v[0], v[1]); w.y = cvt_pk_bf16(v[2], v[3]); o8[64 * j] = w; }
            s = wave_sum(s); if (lane == 0) rowss[m] = s;
        }
        for (int m = gw; m < BATCH * NMEM; m += NGW) {
            const f32x4* xr = (const f32x4*)(P.mem + (size_t)m * DM) + lane; const f32x4* gr = (const f32x4*)P.mem_norm + lane; u32x2* o8 = (u32x2*)(MEMN + (size_t)m * DM) + lane;
            f32x4 v[8]; float s = 0.f;
#pragma unroll
            for (int j = 0; j < 8; ++j) { v[j] = xr[64 * j]; s += (v[j][0] * v[j][0] + v[j][1] * v[j][1]) + (v[j][2] * v[j][2] + v[j][3] * v[j][3]); }
            const float rs = __builtin_amdgcn_rsqf(wave_sum(s) * (1.0f / DM) + EPS);
#pragma unroll
            for (int j = 0; j < 8; ++j) { const f32x4 gg = gr[64 * j]; const f32x4 y = v[j] * rs * gg; u32x2 w; w.x = cvt_pk_bf16(y[0], y[1]); w.y = cvt_pk_bf16(y[2], y[3]); o8[64 * j] = w; }
        }
    }
    grid.sync();
    for (int rep_ = 0; rep_ < REP_G1; ++rep_)
    RUN_GEMM(pg8::EpiSwiglu, MTOK, 2 * DFF, (pg8::Gemm{HB, Wgu1, DM, DM, DM, 0}), (pg8::EpiSwiglu{ACT, DFF, rowss}));
    for (int rep_ = 0; rep_ < REP_G1NULL; ++rep_)
    RUN_GEMM(pg8::EpiNull, MTOK, 2 * DFF, (pg8::Gemm{HB, Wgu1, DM, DM, DM, 0}), (pg8::EpiNull{}));
    for (int rep_ = 0; rep_ < REP_SYNC; ++rep_) grid.sync();
    xcd_barrier(xbar);
    for (int rep_ = 0; rep_ < REP_G2NULL; ++rep_)
    RUN_GEMM(pg8::EpiNull, MTOK, DM, (pg8::Gemm{ACT, Wd1, 128, 128, DFF, 0, (size_t)0, (size_t)DM * 256}), (pg8::EpiNull{}));
    for (int rep_ = 0; rep_ < REP_G2; ++rep_)
    RUN_GEMM(pg8::EpiRes<true>, MTOK, DM, (pg8::Gemm{ACT, Wd1, 128, 128, DFF, 0, (size_t)MTOK * 256, (size_t)DM * 256}), (pg8::EpiRes<true>{P.x, HB, nullptr, 0.5f}));
    RUN_GEMM_NT(pg8::EpiRes<true>, MTOK, DM, (pg8::Gemm{ACT, Wd1, 128, 128, DFF, 0, (size_t)MTOK * 256, (size_t)DM * 256}), (pg8::EpiRes<true>{P.x, HB, rowss + 1 * MTOK, 0.5f}));
    xcd_barrier(xbar);
    for (int rep_ = 0; rep_ < REP_G3; ++rep_)
    RUN_GEMM(pg8::EpiBf<64>, MTOK, DIN, (pg8::Gemm{HB, Win, DM, DM, DM, 0}), (pg8::EpiBf<64>{Z, DIN, 0, rowss + 1 * MTOK, nullptr, 8, 12, SEQ, DATT, VT, 4, 8, KF}));
    xcd_barrier(xbar);
    for (int rep_ = 0; rep_ < REP_ATT; ++rep_) {
        for (int task = gw; task < (MTOK / 64) * 4; task += NGW) {
            const int gi = task & 3, rt = task >> 2, sub = lane >> 5, cgi = lane & 31, w = 2 << gi;
            const int t0 = rt * 64 + sub * 32, tpos = t0 & (SEQ - 1);
            const bf16_t* up = Z + (size_t)t0 * DIN + 3 * DATT + gi * 256 + cgi * 8;
            bf16_t* dp = DP + (size_t)t0 * DPOOL + gi * 256 + cgi * 8;
            float sum[8];
#pragma unroll
            for (int e = 0; e < 8; ++e) sum[e] = 0.f;
            for (int i = 1; i < w; ++i) if (tpos - i >= 0) { const u32x4 v = *(const u32x4*)(up - (size_t)i * DIN);
                sum[0] += bf_lo(v.x); sum[1] += bf_hi(v.x); sum[2] += bf_lo(v.y); sum[3] += bf_hi(v.y); sum[4] += bf_lo(v.z); sum[5] += bf_hi(v.z); sum[6] += bf_lo(v.w); sum[7] += bf_hi(v.w); }
#pragma nounroll
            for (int r0 = 0; r0 < 32; r0 += 8) {
                u32x4 cv[8], ov[8];
#pragma unroll
                for (int j = 0; j < 8; ++j) cv[j] = *(const u32x4*)(up + (size_t)(r0 + j) * DIN);
#pragma unroll
                for (int j = 0; j < 8; ++j) { const int rr = r0 + j - w + 1; ov[j] = (tpos + rr >= 0) ? *(const u32x4*)(up + (ptrdiff_t)rr * DIN) : (u32x4){0u, 0u, 0u, 0u}; }
#pragma unroll
                for (int j = 0; j < 8; ++j) {
                    const u32x4 v = cv[j], q = ov[j];
                    const float cur[8] = {bf_lo(v.x), bf_hi(v.x), bf_lo(v.y), bf_hi(v.y), bf_lo(v.z), bf_hi(v.z), bf_lo(v.w), bf_hi(v.w)};
                    const float old[8] = {bf_lo(q.x), bf_hi(q.x), bf_lo(q.y), bf_hi(q.y), bf_lo(q.z), bf_hi(q.z), bf_lo(q.w), bf_hi(q.w)};
                    const int have = tpos + r0 + j + 1; const float inv = 1.0f / (float)(have < w ? have : w);
                    float d[8];
#pragma unroll
                    for (int e = 0; e < 8; ++e) { sum[e] += cur[e]; d[e] = sum[e] * inv - cur[e]; sum[e] -= old[e]; }
                    u32x4 o; o.x = cvt_pk_bf16(d[0], d[1]); o.y = cvt_pk_bf16(d[2], d[3]); o.z = cvt_pk_bf16(d[4], d[5]); o.w = cvt_pk_bf16(d[6], d[7]);
                    *(u32x4*)(dp + (size_t)(r0 + j) * DPOOL) = o;
                }
            }
        }
        LAS float* tab = (LAS float*)lds;
        for (int bh = bx; bh < BATCH * 16; bh += G) {
            const int b = bh >> 4, h = bh & 15;
            __syncthreads();
            for (int i = tid; i < 704; i += 512) { int rel = i - 63; rel = rel < -128 ? -128 : (rel > 128 ? 128 : rel); tab[i] = P.rel_bias[h * NREL + rel + 128] * LOG2E; }
            __syncthreads();
            const bool first = (bh == bx);
#pragma nounroll
            for (int stage = 0; stage < 2; ++stage) {
                const bool do_att = first ? ((((wave >> 2) & 1) == stage)) : (stage == 0);
                if (do_att) {
#pragma nounroll
                    for (int i = 0; i < 8; ++i) {
                        const int c = i * 4 + (wave >> 1), half = wave & 1, j0 = c < 8 ? 8 - c : 0, kstart = (c - 8 + j0) * 64;
                        const size_t qrow = (size_t)b * SEQ + c * 64 + half * 32;
                        attn_wave32<64, true, 2, true, true>(Z + qrow * DIN + h * 64, DIN, KF + ((size_t)(b * 16 + h) * SEQ + kstart) * 64, 0,
                                              VT + ((size_t)(b * 16 + h) * SEQ + kstart) * 64, 0, Y + qrow * DM + h * 64, DM, 9 - j0, 0.125f * LOG2E, tab, half * 32 + (8 - j0) * 64, lane);
                    }
                } else if (first) {
                    int ln = threadIdx.x & 63; asm volatile("" : "+v"(ln));
                    LAS float* scr2 = (LAS float*)(lds + 4096 + wave * 8448);
#define scr scr2
#pragma nounroll
                    for (int it = N_EARLY + gw; it < NITEMS; it += NGW) CONVERT_ITEM(it, ln);
#undef scr
                }
            }
        }
        __syncthreads();
    }
    xcd_barrier(xbar);
    if (G >= 128 && bx < 64) {
        RUN_GEMM_ON(pg8::EpiBf<128>, BATCH * NMEM, 2 * DCROSS, (pg8::Gemm{MEMN, Wckv, DM, DM, DM, 0}), (pg8::EpiBf<128>{KC, DCROSS, 0, nullptr, nullptr, 2, 4, NMEM, DCROSS, VCT, 0, 2, KC}), 64, bx);
    } else if (G >= 128) {
        RUN_GEMM_ON(pg8::EpiBf<0>, MTOK, DPOOL, (pg8::Gemm{DP, Wp, DPOOL, 256, 256, 512}), (pg8::EpiBf<0>{Y, DM, DATT, nullptr, P.pool_scale, 0, 0, 1, 1, nullptr, 0, 0, nullptr}), G - 64, bx - 64);
    } else {
        RUN_GEMM(pg8::EpiBf<128>, BATCH * NMEM, 2 * DCROSS, (pg8::Gemm{MEMN, Wckv, DM, DM, DM, 0}), (pg8::EpiBf<128>{KC, DCROSS, 0, nullptr, nullptr, 2, 4, NMEM, DCROSS, VCT, 0, 2, KC}));
        RUN_GEMM(pg8::EpiBf<0>, MTOK, DPOOL, (pg8::Gemm{DP, Wp, DPOOL, 256, 256, 512}), (pg8::EpiBf<0>{Y, DM, DATT, nullptr, P.pool_scale, 0, 0, 1, 1, nullptr, 0, 0, nullptr}));
    }
    xcd_barrier(xbar);
    RUN_GEMM(pg8::EpiRes<false>, MTOK, DM, (pg8::Gemm{Y, Wout, DM, DM, DM, 0}), (pg8::EpiRes<false>{nullptr, HB, rowss + 2 * MTOK, 1.0f}));
    xcd_barrier(xbar);
    RUN_GEMM(pg8::EpiBf<0>, MTOK, DCROSS, (pg8::Gemm{HB, Wcq, DM, DM, DM, 0}), (pg8::EpiBf<0>{CQ, DCROSS, 0, rowss + 2 * MTOK, nullptr, 0, 0, 1, 1, nullptr, 0, 0, nullptr}));
    xcd_barrier(xbar);
    for (int rep_ = 0; rep_ < REP_XATT; ++rep_) {
        for (int it = bx; it < BATCH * 16; it += G) {
            const int b = it >> 4, sub = it & 15;
#pragma nounroll
            for (int r = 0; r < 4; ++r) {
                const int wu = r * 8 + wave, head = wu & 3, qblk = wu >> 2;
                const size_t qrow = (size_t)b * SEQ + sub * 128 + qblk * 16;
#ifndef NO_ATT9
                attn_wave32<128, false, 1, true, true, false>(CQ + qrow * DCROSS + head * 128, DCROSS, KC + (size_t)(b * 4 + head) * NMEM * 128, 0,
                                        VCT + (size_t)(b * 4 + head) * NMEM * 128, 0, CO + qrow * DCROSS + head * 128, DCROSS, 4, 0.08838834764831845f * LOG2E, nullptr, 0, lane);
#endif
            }
        }
    }
    xcd_barrier(xbar);
    RUN_GEMM(pg8::EpiRes<false>, MTOK, DM, (pg8::Gemm{CO, Wco, DCROSS, DCROSS, DCROSS, 0}), (pg8::EpiRes<false>{nullptr, HB, rowss + 3 * MTOK, 1.0f}));
    xcd_barrier(xbar);
    RUN_GEMM(pg8::EpiSwiglu, MTOK, 2 * DFF, (pg8::Gemm{HB, Wgu2, DM, DM, DM, 0}), (pg8::EpiSwiglu{ACT, DFF, rowss + 3 * MTOK}));
    xcd_barrier(xbar);
    if (G == 256) {
        pg8::StaticOrder S_; S_.init(MTOK, DM, G, bx, 4, 0);
        pg8::gemm_phase<pg8::EpiResFinal, true, AUX_DOWN>(lds, (pg8::Gemm{ACT, Wd2, 128, 128, DFF, 0, (size_t)MTOK * 256, (size_t)DM * 256}), S_,
                                                          (pg8::EpiResFinal{HB, rowss + 4 * MTOK, 0.5f, P.out, P.final_norm, (unsigned*)(P.ws + WS_PCNT)}));
    } else {
        RUN_GEMM_NT(pg8::EpiRes<false>, MTOK, DM, (pg8::Gemm{ACT, Wd2, 128, 128, DFF, 0, (size_t)MTOK * 256, (size_t)DM * 256}), (pg8::EpiRes<false>{nullptr, HB, rowss + 4 * MTOK, 0.5f}));
        xcd_barrier(xbar);
        {
            const float* rs4 = rowss + 4 * MTOK;
            for (int m = gw; m < MTOK; m += NGW) {
                const u32x2* hr = (const u32x2*)(HB + (size_t)m * DM) + lane; f32x4* xr = (f32x4*)(P.out + (size_t)m * DM) + lane; const f32x4* gr = (const f32x4*)P.final_norm + lane;
                const float rs = __builtin_amdgcn_rsqf(rs4[m] * (1.0f / DM) + EPS);
    #pragma unroll
                for (int j = 0; j < 8; ++j) { const u32x2 q = hr[64 * j]; const f32x4 v = (f32x4){bf_lo(q.x), bf_hi(q.x), bf_lo(q.y), bf_hi(q.y)}; xr[64 * j] = v * rs * gr[64 * j]; }
            }
        }
    }
#undef RUN_GEMM
#undef RUN_GEMM_ON
#undef RUN_GEMM_NT
}

extern "C" void kernel_launch(void* const* d_in, const int* in_sizes, int n_in, void* d_out, int out_size, void* d_ws, size_t ws_size, hipStream_t stream) {
    static int grid_blocks = 0;
    if (grid_blocks == 0) {
        if (n_in != 22 || in_sizes[0] != MTOK * DM || out_size != MTOK * DM || ws_size < WS_END) {
            fprintf(stderr, "kernel_launch: unexpected shapes (n_in %d, in0 %d, out %d, ws %zu)\n", n_in, n_in > 0 ? in_sizes[0] : -1, out_size, ws_size); grid_blocks = -1; return; }
        int dev = 0, cus = 0, per_cu = 0;
        hipGetDevice(&dev);
        hipDeviceGetAttribute(&cus, hipDeviceAttributeMultiprocessorCount, dev);
        if (hipFuncSetAttribute((const void*)fwd_megakernel, hipFuncAttributeMaxDynamicSharedMemorySize, LDS_BYTES) != hipSuccess) { fprintf(stderr, "kernel_launch: hipFuncSetAttribute failed\n"); grid_blocks = -1; return; }
        if (hipOccupancyMaxActiveBlocksPerMultiprocessor(&per_cu, (const void*)fwd_megakernel, 512, LDS_BYTES) != hipSuccess || per_cu < 1) { fprintf(stderr, "kernel_launch: occupancy query gave %d\n", per_cu); per_cu = 1; }
        (void)hipGetLastError();
        grid_blocks = cus * per_cu;
    }
    if (grid_blocks < 0) return;
    Params p{};
    const float* const* in = (const float* const*)d_in;
    p.x = in[0]; p.mem = in[1]; p.ffn1_norm = in[2]; p.ffn1_wg = in[3]; p.ffn1_wu = in[4]; p.ffn1_wd = in[5]; p.mix_norm = in[6]; p.w_in = in[7]; p.rel_bias = in[8];
    p.w_pool = in[9]; p.pool_scale = in[10]; p.w_out = in[11]; p.cross_norm = in[12]; p.mem_norm = in[13]; p.w_cq = in[14]; p.w_ckv = in[15]; p.w_co = in[16];
    p.ffn2_norm = in[17]; p.ffn2_wg = in[18]; p.ffn2_wu = in[19]; p.ffn2_wd = in[20]; p.final_norm = in[21];
    p.out = (float*)d_out; p.ws = (unsigned char*)d_ws;
    if (hipMemsetAsync((char*)d_ws + WS_BAR, 0, WS_BAR_BYTES, stream) != hipSuccess) { fprintf(stderr, "kernel_launch: memset of the barrier words failed\n"); return; }
    void* args[] = {&p};
    hipError_t e = hipLaunchCooperativeKernel((const void*)fwd_megakernel, dim3(grid_blocks), dim3(512), args, LDS_BYTES, stream);
    if (e != hipSuccess) fprintf(stderr, "cooperative launch failed: %s (grid %d)\n", hipGetErrorString(e), grid_blocks);
}
```

```cpp
#include <hip/hip_runtime.h>
#include <hip/hip_cooperative_groups.h>
#include <cstdio>
#include <cstdint>
namespace cg = cooperative_groups;

#define LAS __attribute__((address_space(3)))
typedef unsigned short bf16_t;
typedef short bf16x8 __attribute__((ext_vector_type(8)));
typedef float f32x4 __attribute__((ext_vector_type(4)));
typedef float f32x2 __attribute__((ext_vector_type(2)));
typedef unsigned u32x4 __attribute__((ext_vector_type(4)));
typedef unsigned u32x2 __attribute__((ext_vector_type(2)));

constexpr int BATCH = 16, SEQ = 2048, DM = 2048, MTOK = BATCH * SEQ;
constexpr int DFF = 5632, DIN = 4096, DATT = 1024, DPOOL = 1024, NMEM = 256, DCROSS = 512;
constexpr int NREL = 257;
constexpr float EPS = 1e-6f;
constexpr float LOG2E = 1.4426950408889634f;

constexpr size_t MiB = 1u << 20;
constexpr size_t WS_ROWSS = 0;
constexpr size_t WS_BAR = 896 * 1024, WS_BAR_BYTES = 49152, WS_PCNT = WS_BAR + 16384;
constexpr size_t WS_WGU1 = 1 * MiB, WS_WD1 = 45 * MiB, WS_WIN = 67 * MiB, WS_WP = 83 * MiB, WS_WOUT = 84 * MiB, WS_WCQ = 92 * MiB,
                 WS_WCKV = 94 * MiB, WS_WCO = 98 * MiB, WS_WGU2 = 100 * MiB, WS_WD2 = 144 * MiB;
constexpr size_t WS_HB = 166 * MiB;
constexpr size_t WS_ACT = 294 * MiB;
constexpr size_t WS_Z = 294 * MiB;
constexpr size_t WS_VT = 550 * MiB;
constexpr size_t WS_Y = 646 * MiB;
constexpr size_t WS_CQ = 646 * MiB, WS_CO = 678 * MiB;
constexpr size_t WS_DP = 774 * MiB;
constexpr size_t WS_MEMN = 838 * MiB;
constexpr size_t WS_KC = 854 * MiB;
constexpr size_t WS_VCT = 858 * MiB;
constexpr size_t WS_KF = 862 * MiB;
constexpr size_t WS_END = 926 * MiB;

#ifndef REP_G1NULL
#define REP_G1NULL 0
#endif
#ifndef REP_SYNC
#define REP_SYNC 0
#endif
#ifndef REP_G2
#define REP_G2 0
#endif
#ifndef REP_G2NULL
#define REP_G2NULL 0
#endif
#ifndef REP_ATTC
#define REP_ATTC 0
#endif
#ifndef REP_XATT
#define REP_XATT 1
#endif
#ifndef REP_P0
#define REP_P0 1
#endif
#ifndef REP_G1
#define REP_G1 1
#endif
#ifndef REP_ATT
#define REP_ATT 1
#endif
#ifndef REP_G3
#define REP_G3 1
#endif
constexpr int LDS_BYTES = 147456;

__device__ __forceinline__ unsigned cvt_pk_bf16(float lo, float hi) { unsigned r; asm volatile("v_cvt_pk_bf16_f32 %0, %1, %2" : "=v"(r) : "v"(lo), "v"(hi)); return r; }
__device__ __forceinline__ float bf_lo(unsigned w) { return __uint_as_float(w << 16); }
__device__ __forceinline__ float bf_hi(unsigned w) { return __uint_as_float(w & 0xffff0000u); }
__device__ __forceinline__ float wave_sum(float v) {
#pragma unroll
    for (int o = 1; o < 64; o <<= 1) v += __shfl_xor(v, o);
    return v;
}

namespace pg8 {
constexpr int BM = 256, BK = 64, HALF = 128, HTB = HALF * BK * 2, STAGE_BYTES = 8 * HTB, NXCD = 8;
__host__ __device__ __forceinline__ int lds_byte(int r, int c) { const int st = (r >> 4) * 2 + (c >> 5), rr = r & 15, cc = c & 31, ob = rr * 64 + cc * 2; return st * 1024 + (ob ^ (((ob >> 9) & 1) << 5)); }
__host__ __device__ __forceinline__ void stage_rc(int b, int& R, int& C) { const int st = b / 1024, sb = b % 1024, swz = sb ^ (((sb >> 9) & 1) << 5); R = (st >> 1) * 16 + swz / 64; C = (st & 1) * 32 + (swz % 64) / 2; }
__host__ __device__ __forceinline__ int perm32(int rho) { const int n = rho >> 4, i = rho & 15; return 8 * (i >> 2) + 4 * n + (i & 3); }

struct Unit { int pm, pn; };
struct Gemm { const bf16_t* A; const bf16_t* Bt; int lda, ldb, K, a_pn_step; size_t kblkA = 256, kblkB = 256; };

struct StaticOrder {
    int nM, nN, nwg, G, c, WGM, rev;
    __device__ void init(int M, int N, int G_, int c_, int wgm = 8, int rev_ = 0) { nM = M / BM; nN = N / BM; nwg = nM * nN; G = G_; c = c_; WGM = wgm; rev = rev_; }
    __device__ bool next(int i, Unit& u) const {
        const int nr = (nwg + G - 1) / G; if (i >= nr) return false;
        long L = (long)(rev ? nr - 1 - i : i) * G + c;
        if (L >= nwg) { if (!rev) return false; L = (long)(nr - 2 - i) * G + c; if (i + 1 >= nr) return false; }
        int wgid = (int)L; { const int q = nwg / NXCD, r = nwg % NXCD, xcd = wgid % NXCD, off = wgid / NXCD; wgid = (xcd < r ? xcd * (q + 1) : r * (q + 1) + (xcd - r) * q) + off; }
        const int nig = WGM * nN, gid = wgid / nig, fm = gid * WGM, gsz = (nM - fm) < WGM ? (nM - fm) : WGM;
        u.pm = fm + ((wgid % nig) % gsz); u.pn = (wgid % nig) / gsz; return true;
    }
};

template <int FMD> struct EpiBf {
    bf16_t* O; int ldc; int col_off; const float* rowss; const float* colscale; int t_lo, t_hi, t_rows, t_cols; bf16_t* VT; int k_lo, k_hi; bf16_t* KF;
    __device__ __forceinline__ void operator()(const f32x4 (&acc)[2][2][4][2], const Unit& u, int wr, int wc, int fr, int fq) const {
        const int row0 = u.pm * BM + wr * 64 + fr, cl = wc * 32 + 8 * fq;
        const bool tr = (u.pn >= t_lo) && (u.pn < t_hi);
        constexpr bool FM = FMD != 0;
        constexpr int FDH = FM ? FMD : 64, FKS = FDH / 32, FROWS = (FMD == 128) ? NMEM : SEQ, FNH = (FMD == 128) ? 4 : 16, FTPB = FROWS / 64;
        const bool kfm = FM && (u.pn >= k_lo) && (u.pn < k_hi);
        f32x4 cs[2][2]; float rsv[8];
#pragma unroll
        for (int bj = 0; bj < 2; ++bj)
#pragma unroll
            for (int n = 0; n < 2; ++n) cs[bj][n] = colscale ? *(const f32x4*)(colscale + u.pn * BM + bj * HALF + cl + 4 * n) : (f32x4){1.f, 1.f, 1.f, 1.f};
#pragma unroll
        for (int i = 0; i < 8; ++i) rsv[i] = rowss ? rowss[row0 + (i >> 2) * HALF + (i & 3) * 16] : 0.f;
        asm volatile("" ::: "memory");
#pragma unroll
        for (int ai = 0; ai < 2; ++ai)
#pragma unroll
            for (int m = 0; m < 4; ++m) {
                const int row = row0 + ai * HALF + m * 16;
                const float rsc = rowss ? __builtin_amdgcn_rsqf(rsv[ai * 4 + m] * (1.0f / DM) + EPS) : 1.0f;
#pragma unroll
                for (int bj = 0; bj < 2; ++bj) {
                    const f32x4 v0 = acc[ai][bj][m][0] * rsc * cs[bj][0], v1 = acc[ai][bj][m][1] * rsc * cs[bj][1];
                    u32x4 w; w.x = cvt_pk_bf16(v0[0], v0[1]); w.y = cvt_pk_bf16(v0[2], v0[3]); w.z = cvt_pk_bf16(v1[0], v1[1]); w.w = cvt_pk_bf16(v1[2], v1[3]);
                    if (FM && (kfm || tr)) {
                        const int c = (u.pn - (kfm ? k_lo : t_lo)) * BM + bj * HALF + cl, hh = c / FDH, d = c % FDH;
                        const int bb = row / FROWS, s = row % FROWS, tile = s >> 6, k = s & 63;
                        const size_t tbase = ((size_t)((bb * FNH + hh) * FTPB + tile)) * (64 * FDH);
                        if (kfm) {
                            const int kb = k >> 5, r = k & 31, mt = kb * 2 + ((r >> 2) & 1), fra = (r >> 3) * 4 + (r & 3), ks = d >> 5, fqa = (d >> 3) & 3;
                            *(u32x4*)(KF + tbase + ((mt * FKS + ks) * 64 + fqa * 16 + fra) * 8) = w;
                        } else {
                            const int dt = d >> 4, fra0 = d & 15, kb = k >> 5, fqa = (k & 31) >> 3, e8 = k & 7;
                            bf16_t* p = VT + tbase + ((dt * 2 + kb) * 64 + fqa * 16 + fra0) * 8 + e8;
                            p[0] = (bf16_t)(w.x & 0xffffu); p[8] = (bf16_t)(w.x >> 16); p[16] = (bf16_t)(w.y & 0xffffu); p[24] = (bf16_t)(w.y >> 16);
                            p[32] = (bf16_t)(w.z & 0xffffu); p[40] = (bf16_t)(w.z >> 16); p[48] = (bf16_t)(w.w & 0xffffu); p[56] = (bf16_t)(w.w >> 16);
                        }
                    } else if (!tr) { *(u32x4*)(O + (size_t)row * ldc + col_off + u.pn * BM + bj * HALF + cl) = w; }
                    else {
                        const int cv = (u.pn - t_lo) * BM + bj * HALF + cl, b = row / t_rows, s = row - b * t_rows;
                        bf16_t* p = VT + ((size_t)b * t_cols + cv) * t_rows + s;
                        p[0] = (bf16_t)(w.x & 0xffffu); p[(size_t)t_rows] = (bf16_t)(w.x >> 16); p[(size_t)2 * t_rows] = (bf16_t)(w.y & 0xffffu); p[(size_t)3 * t_rows] = (bf16_t)(w.y >> 16);
                        p[(size_t)4 * t_rows] = (bf16_t)(w.z & 0xffffu); p[(size_t)5 * t_rows] = (bf16_t)(w.z >> 16); p[(size_t)6 * t_rows] = (bf16_t)(w.w & 0xffffu); p[(size_t)7 * t_rows] = (bf16_t)(w.w >> 16);
                    }
                }
            }
    }
};
__device__ __forceinline__ float silu_mul(float g, float u) { return g * __builtin_amdgcn_rcpf(1.0f + __expf(-g)) * u; }
struct EpiSwiglu {
    bf16_t* O; int ldc; const float* rowss;
    __device__ __forceinline__ void operator()(const f32x4 (&acc)[2][2][4][2], const Unit& u, int wr, int wc, int fr, int fq) const {
        const int row0 = u.pm * BM + wr * 64 + fr, cl = wc * 32 + 8 * fq;
        float rsv[8];
#pragma unroll
        for (int i = 0; i < 8; ++i) rsv[i] = rowss[row0 + (i >> 2) * HALF + (i & 3) * 16];
        asm volatile("" ::: "memory");
#pragma unroll
        for (int ai = 0; ai < 2; ++ai)
#pragma unroll
            for (int m = 0; m < 4; ++m) {
                const int row = row0 + ai * HALF + m * 16;
                const float rsc = __builtin_amdgcn_rsqf(rsv[ai * 4 + m] * (1.0f / DM) + EPS);
                const f32x4 g0 = acc[ai][0][m][0] * rsc, g1 = acc[ai][0][m][1] * rsc, u0 = acc[ai][1][m][0] * rsc, u1 = acc[ai][1][m][1] * rsc;
                u32x4 w;
                w.x = cvt_pk_bf16(silu_mul(g0[0], u0[0]), silu_mul(g0[1], u0[1])); w.y = cvt_pk_bf16(silu_mul(g0[2], u0[2]), silu_mul(g0[3], u0[3]));
                w.z = cvt_pk_bf16(silu_mul(g1[0], u1[0]), silu_mul(g1[1], u1[1])); w.w = cvt_pk_bf16(silu_mul(g1[2], u1[2]), silu_mul(g1[3], u1[3]));
                *(u32x4*)(O + ((size_t)u.pn * MTOK + row) * HALF + cl) = w;
            }
    }
};
template <bool F32IN> struct EpiRes {
    const float* hin_f; bf16_t* hb; float* rowss_out; float alpha;
    static constexpr int DEPTH = F32IN ? 2 : 4, NV = F32IN ? 4 : 2;
    __device__ __forceinline__ void ld(f32x4 (&hv)[4], size_t off) const {
        if (F32IN) { hv[0] = *(const f32x4*)(hin_f + off); hv[1] = *(const f32x4*)(hin_f + off + 4); hv[2] = *(const f32x4*)(hin_f + off + HALF); hv[3] = *(const f32x4*)(hin_f + off + HALF + 4); }
        else { hv[0] = __builtin_bit_cast(f32x4, *(const u32x4*)(hb + off)); hv[1] = __builtin_bit_cast(f32x4, *(const u32x4*)(hb + off + HALF)); }
    }
    __device__ __forceinline__ void operator()(const f32x4 (&acc)[2][2][4][2], const Unit& u, int wr, int wc, int fr, int fq) const {
        const int row0 = u.pm * BM + wr * 64 + fr, cl = u.pn * BM + wc * 32 + 8 * fq;
        f32x4 hv[DEPTH][4];
#pragma unroll
        for (int gi = 0; gi < DEPTH; ++gi) ld(hv[gi], (size_t)(row0 + (gi >> 2) * HALF + (gi & 3) * 16) * DM + cl);
#pragma unroll
        for (int gi = 0; gi < 8; ++gi) {
            const int ai = gi >> 2, m = gi & 3, cb = gi % DEPTH;
            asm volatile("" ::: "memory");
            const int row = row0 + ai * HALF + m * 16; const size_t off = (size_t)row * DM + cl;
            float ss = 0.f;
            u32x4 wv[2];
#pragma unroll
            for (int bj = 0; bj < 2; ++bj) {
                f32x4 o0, o1;
                if (F32IN) { o0 = hv[cb][2 * bj]; o1 = hv[cb][2 * bj + 1]; }
                else { const u32x4 q = __builtin_bit_cast(u32x4, hv[cb][bj]); o0 = (f32x4){bf_lo(q.x), bf_hi(q.x), bf_lo(q.y), bf_hi(q.y)}; o1 = (f32x4){bf_lo(q.z), bf_hi(q.z), bf_lo(q.w), bf_hi(q.w)}; }
                const f32x4 h0 = o0 + acc[ai][bj][m][0] * alpha, h1 = o1 + acc[ai][bj][m][1] * alpha;
                ss += (h0[0] * h0[0] + h0[1] * h0[1]) + (h0[2] * h0[2] + h0[3] * h0[3]) + (h1[0] * h1[0] + h1[1] * h1[1]) + (h1[2] * h1[2] + h1[3] * h1[3]);
                wv[bj].x = cvt_pk_bf16(h0[0], h0[1]); wv[bj].y = cvt_pk_bf16(h0[2], h0[3]); wv[bj].z = cvt_pk_bf16(h1[0], h1[1]); wv[bj].w = cvt_pk_bf16(h1[2], h1[3]);
            }
            if (gi + DEPTH < 8) ld(hv[cb], (size_t)(row0 + ((gi + DEPTH) >> 2) * HALF + ((gi + DEPTH) & 3) * 16) * DM + cl);
            *(u32x4*)(hb + off) = wv[0]; *(u32x4*)(hb + off + HALF) = wv[1];
            ss += __shfl_xor(ss, 16); ss += __shfl_xor(ss, 32);
            if (rowss_out && fq == 0) __hip_atomic_fetch_add(rowss_out + row, ss, __ATOMIC_RELAXED, __HIP_MEMORY_SCOPE_AGENT);
        }
    }
};

struct EpiResFinal {
    bf16_t* hb; float* rowss_out; float alpha; float* out; const float* gain; unsigned* cnt;
    __device__ __forceinline__ void operator()(f32x4 (&acc)[2][2][4][2], const Unit& u, int wr, int wc, int fr, int fq) const {
        const int row0 = u.pm * BM + wr * 64 + fr, cl = u.pn * BM + wc * 32 + 8 * fq;
        u32x4 hv[4][2];
#pragma unroll
        for (int gi = 0; gi < 4; ++gi) { const size_t off = (size_t)(row0 + (gi >> 2) * HALF + (gi & 3) * 16) * DM + cl; hv[gi][0] = *(const u32x4*)(hb + off); hv[gi][1] = *(const u32x4*)(hb + off + HALF); }
#pragma unroll
        for (int gi = 0; gi < 8; ++gi) {
            const int ai = gi >> 2, m = gi & 3, cb = gi & 3;
            asm volatile("" ::: "memory");
            const int row = row0 + ai * HALF + m * 16;
            float ss = 0.f;
#pragma unroll
            for (int bj = 0; bj < 2; ++bj) {
                const u32x4 q = hv[cb][bj];
                const f32x4 h0 = (f32x4){bf_lo(q.x), bf_hi(q.x), bf_lo(q.y), bf_hi(q.y)} + acc[ai][bj][m][0] * alpha, h1 = (f32x4){bf_lo(q.z), bf_hi(q.z), bf_lo(q.w), bf_hi(q.w)} + acc[ai][bj][m][1] * alpha;
                ss += (h0[0] * h0[0] + h0[1] * h0[1]) + (h0[2] * h0[2] + h0[3] * h0[3]) + (h1[0] * h1[0] + h1[1] * h1[1]) + (h1[2] * h1[2] + h1[3] * h1[3]);
                acc[ai][bj][m][0] = h0; acc[ai][bj][m][1] = h1;
            }
            if (gi + 4 < 8) { const size_t offn = (size_t)(row0 + ((gi + 4) >> 2) * HALF + ((gi + 4) & 3) * 16) * DM + cl; hv[cb][0] = *(const u32x4*)(hb + offn); hv[cb][1] = *(const u32x4*)(hb + offn + HALF); }
            ss += __shfl_xor(ss, 16); ss += __shfl_xor(ss, 32);
            if (fq == 0) __hip_atomic_fetch_add(rowss_out + row, ss, __ATOMIC_RELAXED, __HIP_MEMORY_SCOPE_AGENT);
        }
        asm volatile("s_waitcnt vmcnt(0)" ::: "memory");
        __builtin_amdgcn_s_barrier(); asm volatile("" ::: "memory");
        if (threadIdx.x == 0) {
            unsigned* c = cnt + 64 * u.pm;
            __hip_atomic_fetch_add(c, 1u, __ATOMIC_RELAXED, __HIP_MEMORY_SCOPE_AGENT);
            unsigned sp = 0;
            while (__hip_atomic_load(c, __ATOMIC_RELAXED, __HIP_MEMORY_SCOPE_AGENT) < 8u) { __builtin_amdgcn_s_sleep(1); if (++sp > (1u << 22)) break; }
            __builtin_amdgcn_fence(__ATOMIC_ACQUIRE, "agent");
            asm volatile("s_waitcnt vmcnt(0)" ::: "memory");
        }
        __builtin_amdgcn_s_barrier(); asm volatile("" ::: "memory");
        float rsv[8];
#pragma unroll
        for (int i = 0; i < 8; ++i) rsv[i] = __hip_atomic_load(rowss_out + row0 + (i >> 2) * HALF + (i & 3) * 16, __ATOMIC_RELAXED, __HIP_MEMORY_SCOPE_AGENT);
        f32x4 gv[2][2];
#pragma unroll
        for (int bj = 0; bj < 2; ++bj) { gv[bj][0] = *(const f32x4*)(gain + cl + bj * HALF); gv[bj][1] = *(const f32x4*)(gain + cl + bj * HALF + 4); }
#pragma unroll
        for (int gi = 0; gi < 8; ++gi) {
            const int ai = gi >> 2, m = gi & 3; const size_t off = (size_t)(row0 + ai * HALF + m * 16) * DM + cl;
            const float rs = __builtin_amdgcn_rsqf(rsv[gi] * (1.0f / DM) + EPS);
#pragma unroll
            for (int bj = 0; bj < 2; ++bj) { *(f32x4*)(out + off + bj * HALF) = acc[ai][bj][m][0] * rs * gv[bj][0]; *(f32x4*)(out + off + bj * HALF + 4) = acc[ai][bj][m][1] * rs * gv[bj][1]; }
        }
    }
};
struct EpiNull {
    __device__ __forceinline__ void operator()(const f32x4 (&acc)[2][2][4][2], const Unit& u, int wr, int wc, int fr, int fq) const {
#pragma unroll
        for (int ai = 0; ai < 2; ++ai)
#pragma unroll
            for (int bj = 0; bj < 2; ++bj)
#pragma unroll
                for (int m = 0; m < 4; ++m) asm volatile("" :: "v"(acc[ai][bj][m][0]), "v"(acc[ai][bj][m][1]));
    }
};

template <class Epi, bool ALIGN_EPI = true, int AUX_A = 0>
__device__ __forceinline__ void gemm_phase(LAS unsigned char* lds, const Gemm g, const StaticOrder& S, const Epi& E) {
    int tid_l = threadIdx.x; asm volatile("" : "+v"(tid_l));
    const int tid = tid_l, wid = __builtin_amdgcn_readfirstlane(tid >> 6), lane = tid & 63, wr = wid >> 2, wc = wid & 3, fr = lane & 15, fq = lane >> 4;
    const int K = g.K, nt = K / BK;
    unsigned voffA[2], voffB[2];
#pragma unroll
    for (int i = 0; i < 2; ++i) { int R, C; stage_rc(tid * 16 + i * 8192, R, C); const int Rb = (R & ~31) + perm32(R & 31);
        voffA[i] = (unsigned)(R * g.lda + C) * 2u; voffB[i] = (unsigned)(Rb * g.ldb + C) * 2u; }
    const size_t kstep = (size_t)(BK * 2);
    const size_t hstepA = (size_t)HALF * g.lda * 2, hstepB = (size_t)HALF * g.ldb * 2;
    const size_t tstepA = 2 * hstepA, tstepB = 2 * hstepB;
    const unsigned ldsw = (unsigned)wid * 1024u;
    const int aoff = lds_byte(wr * 64 + fr, fq * 8), boff = lds_byte(wc * 32 + fr, fq * 8);
#define PG8_SA(b, h) (((b) * 2 + (h)) * HTB)
#define PG8_SB(b, h) ((4 + (b) * 2 + (h)) * HTB)
#define PG8_STAGE_X(bufoff, gbase, voff, aux) do { _Pragma("unroll") for (int _i = 0; _i < 2; ++_i) \
        __builtin_amdgcn_global_load_lds((const unsigned*)((const char*)(gbase) + (voff)[_i]), (LAS unsigned*)(lds + (bufoff) + ldsw + _i * 8192), 16, 0, aux); } while (0)
#define PG8_STAGE(bufoff, gbase, voff) PG8_STAGE_X(bufoff, gbase, voff, 0)
#define PG8_LDA(dst, b, h) do { _Pragma("unroll") for (int m = 0; m < 4; ++m) _Pragma("unroll") for (int k = 0; k < 2; ++k) dst[m][k] = *(const LAS bf16x8*)(lds + PG8_SA(b, h) + aoff + m * 2048 + k * 1024); } while (0)
#define PG8_LDB(dst, b, h) do { _Pragma("unroll") for (int n = 0; n < 2; ++n) _Pragma("unroll") for (int k = 0; k < 2; ++k) dst[n][k] = *(const LAS bf16x8*)(lds + PG8_SB(b, h) + boff + n * 2048 + k * 1024); } while (0)
#define PG8_MMA(ai, bj, At, Bt) do { __builtin_amdgcn_s_setprio(1); _Pragma("unroll") for (int m = 0; m < 4; ++m) _Pragma("unroll") for (int n = 0; n < 2; ++n) _Pragma("unroll") for (int k = 0; k < 2; ++k) \
        acc[ai][bj][m][n] = __builtin_amdgcn_mfma_f32_16x16x32_bf16(Bt[n][k], At[m][k], acc[ai][bj][m][n], 0, 0, 0); __builtin_amdgcn_s_setprio(0); } while (0)
#define PG8_WAIT_V(n) asm volatile("s_waitcnt vmcnt(" #n ")" ::: "memory")
#define PG8_WAIT_L(n) asm volatile("s_waitcnt lgkmcnt(" #n ")" ::: "memory")
#define PG8_BAR __builtin_amdgcn_s_barrier()
#define PG8_SCHED __builtin_amdgcn_sched_barrier(0)
    Unit cur, nxt; int ui = 0;
    if (!S.next(0, cur)) return;
    f32x4 acc[2][2][4][2];
#pragma unroll
    for (int a = 0; a < 2; ++a)
#pragma unroll
        for (int b = 0; b < 2; ++b)
#pragma unroll
            for (int m = 0; m < 4; ++m)
#pragma unroll
                for (int n = 0; n < 2; ++n) acc[a][b][m][n] = (f32x4){0.f, 0.f, 0.f, 0.f};
    bf16x8 At[4][2], B0[2][2], B1[2][2];
    const char* cA = (const char*)g.A + (size_t)cur.pm * tstepA + (size_t)cur.pn * g.a_pn_step; const char* cB = (const char*)g.Bt + (size_t)cur.pn * tstepB;
    PG8_STAGE(PG8_SB(0, 0), cB, voffB); PG8_STAGE(PG8_SB(0, 1), cB + hstepB, voffB); PG8_STAGE_X(PG8_SA(0, 0), cA, voffA, AUX_A); PG8_STAGE_X(PG8_SA(0, 1), cA + hstepA, voffA, AUX_A);
    if (wr == 1) PG8_BAR;
    PG8_WAIT_V(2); PG8_BAR;
    PG8_STAGE(PG8_SB(1, 0), cB + kstep, voffB); PG8_STAGE_X(PG8_SA(1, 0), cA + kstep, voffA, AUX_A); PG8_STAGE(PG8_SB(1, 1), cB + hstepB + kstep, voffB);
    PG8_WAIT_V(6); PG8_BAR;
    for (;;) {
        const bool has_next = S.next(ui + 1, nxt);
        const char* nA = has_next ? (const char*)g.A + (size_t)nxt.pm * tstepA + (size_t)nxt.pn * g.a_pn_step : cA; const char* nB = has_next ? (const char*)g.Bt + (size_t)nxt.pn * tstepB : cB;
        for (int t = 0; t < nt; t += 2) {
            const bool last = (t == nt - 2);
            const size_t kbi = (size_t)(t >> 1);
            const char* a1 = cA + kbi * g.kblkA + kstep;
            const char* a2 = last ? nA : cA + (kbi + 1) * g.kblkA; const char* b2 = last ? nB : cB + (kbi + 1) * g.kblkB;
            const char* a3 = a2 + kstep; const char* b3 = b2 + kstep;
            PG8_LDB(B0, 0, 0); PG8_LDB(B1, 0, 1); PG8_SCHED; PG8_LDA(At, 0, 0); PG8_STAGE_X(PG8_SA(1, 1), a1 + hstepA, voffA, AUX_A);
            PG8_WAIT_V(8); PG8_WAIT_L(0); PG8_BAR; PG8_MMA(0, 0, At, B0); PG8_MMA(0, 1, At, B1); PG8_BAR; PG8_SCHED;
            PG8_LDA(At, 0, 1); PG8_STAGE(PG8_SB(0, 0), b2, voffB); PG8_STAGE(PG8_SB(0, 1), b2 + hstepB, voffB); PG8_STAGE_X(PG8_SA(0, 0), a2, voffA, AUX_A);
            PG8_WAIT_V(8); PG8_WAIT_L(0); PG8_BAR; PG8_MMA(1, 0, At, B0); PG8_MMA(1, 1, At, B1); PG8_BAR; PG8_SCHED;
            PG8_LDB(B0, 1, 0); PG8_LDB(B1, 1, 1); PG8_SCHED; PG8_LDA(At, 1, 0); PG8_STAGE_X(PG8_SA(0, 1), a2 + hstepA, voffA, AUX_A);
            PG8_WAIT_V(8); PG8_WAIT_L(0); PG8_BAR; PG8_MMA(0, 0, At, B0); PG8_MMA(0, 1, At, B1); PG8_BAR; PG8_SCHED;
            PG8_LDA(At, 1, 1); PG8_STAGE(PG8_SB(1, 0), b3, voffB); PG8_STAGE(PG8_SB(1, 1), b3 + hstepB, voffB); PG8_STAGE_X(PG8_SA(1, 0), a3, voffA, AUX_A);
            PG8_WAIT_V(8); PG8_WAIT_L(0); PG8_BAR; PG8_MMA(1, 0, At, B0); PG8_MMA(1, 1, At, B1); PG8_BAR; PG8_SCHED;
        }
        if constexpr (ALIGN_EPI) { if (wr == 0) PG8_BAR; }
        E(acc, cur, wr, wc, fr, fq);
        if (!has_next) break;
#pragma unroll
        for (int a = 0; a < 2; ++a)
#pragma unroll
            for (int b = 0; b < 2; ++b)
#pragma unroll
                for (int m = 0; m < 4; ++m)
#pragma unroll
                    for (int n = 0; n < 2; ++n) acc[a][b][m][n] = (f32x4){0.f, 0.f, 0.f, 0.f};
        cur = nxt; cA = nA; cB = nB; ++ui;
        if constexpr (ALIGN_EPI) { if (wr == 1) PG8_BAR; }
    }
    PG8_WAIT_V(0);
    if constexpr (!ALIGN_EPI) { if (wr == 0) PG8_BAR; }
    PG8_BAR;
#undef PG8_SA
#undef PG8_SB
#undef PG8_STAGE
#undef PG8_STAGE_X
#undef PG8_LDA
#undef PG8_LDB
#undef PG8_MMA
#undef PG8_WAIT_V
#undef PG8_WAIT_L
#undef PG8_BAR
#undef PG8_SCHED
}
}

template <int DH, bool BIAS, int NT, bool PF, bool COAL = false, bool VDB = true>
__device__ __forceinline__ void attn_wave32(const bf16_t* __restrict__ Qp, int ldq, const bf16_t* __restrict__ Kp, int ldk, const bf16_t* __restrict__ Vp, int ldv,
                                            bf16_t* __restrict__ Op, int ldo, int ntiles, float sc, const LAS float* tab, int rel_base, int lane) {
    constexpr int KS = DH / 32, DT = DH / 16;
    asm volatile("" : "+v"(lane));
    const int fr = lane & 15, fq = lane >> 4;
    bf16x8 qf[NT][KS];
#pragma unroll
    for (int nt = 0; nt < NT; ++nt)
#pragma unroll
        for (int ks = 0; ks < KS; ++ks) qf[nt][ks] = *(const bf16x8*)(Qp + (size_t)(nt * 16 + fr) * ldq + ks * 32 + fq * 8);
    f32x4 o[DT][NT];
#pragma unroll
    for (int dt = 0; dt < DT; ++dt)
#pragma unroll
        for (int nt = 0; nt < NT; ++nt) o[dt][nt] = (f32x4){0.f, 0.f, 0.f, 0.f};
    float mrun[NT], lrun[NT];
#pragma unroll
    for (int nt = 0; nt < NT; ++nt) { mrun[nt] = -1e30f; lrun[nt] = 0.f; }
    const bf16_t* kbase = Kp + (size_t)(8 * (fr >> 2) + (fr & 3)) * ldk + fq * 8;
    const bf16_t* vbase = Vp + (size_t)fr * ldv + fq * 8;
    bf16x8 kf[4][KS], vfA[DT][2], vfB[DT][2];
#define ATT_LOADK(tt) do { _Pragma("unroll") for (int mt = 0; mt < 4; ++mt) _Pragma("unroll") for (int ks = 0; ks < KS; ++ks) \
        kf[mt][ks] = COAL ? *(const bf16x8*)(Kp + (size_t)(tt) * (64 * DH) + (mt * KS + ks) * 512 + lane * 8) \
                          : *(const bf16x8*)(kbase + (size_t)((tt) * 64 + (mt >> 1) * 32 + 4 * (mt & 1)) * ldk + ks * 32); } while (0)
#define ATT_LOADV(dst, tt) do { _Pragma("unroll") for (int dt = 0; dt < DT; ++dt) _Pragma("unroll") for (int kb = 0; kb < 2; ++kb) \
        dst[dt][kb] = COAL ? *(const bf16x8*)(Vp + (size_t)(tt) * (64 * DH) + (dt * 2 + kb) * 512 + lane * 8) \
                           : *(const bf16x8*)(vbase + (size_t)(dt * 16) * ldv + (tt) * 64 + kb * 32); } while (0)
#define ATT_BODY(t, vcur, vnext) do { \
        const int tn_ = ((t) + 1 < ntiles) ? (t) + 1 : (t); \
        if (PF && VDB) ATT_LOADV(vnext, tn_); else if (PF) ATT_LOADV(vcur, t); else ATT_LOADK(t); \
        f32x4 s[4][NT]; \
        _Pragma("unroll") for (int mt = 0; mt < 4; ++mt) _Pragma("unroll") for (int nt = 0; nt < NT; ++nt) { s[mt][nt] = (f32x4){0.f, 0.f, 0.f, 0.f}; \
            _Pragma("unroll") for (int ks = 0; ks < KS; ++ks) s[mt][nt] = __builtin_amdgcn_mfma_f32_16x16x32_bf16(kf[mt][ks], qf[nt][ks], s[mt][nt], 0, 0, 0); } \
        if (PF) ATT_LOADK(tn_); \
        bf16x8 pf[NT][2]; \
          \
        const LAS float* tb_ = tab + (rel_base - 64 * (t) + fr - 8 * fq + 63 - 39); \
        _Pragma("unroll") for (int nt = 0; nt < NT; ++nt) { \
            float mloc = -1e30f; \
            _Pragma("unroll") for (int mt = 0; mt < 4; ++mt) _Pragma("unroll") for (int j = 0; j < 4; ++j) { \
                float v = s[mt][nt][j] * sc; \
                if (BIAS) v += tb_[39 + nt * 16 - ((mt >> 1) * 32 + 4 * (mt & 1) + j)]; \
                s[mt][nt][j] = v; mloc = fmaxf(mloc, v); } \
            mloc = fmaxf(mloc, __shfl_xor(mloc, 16)); mloc = fmaxf(mloc, __shfl_xor(mloc, 32)); \
            const float mnew = fmaxf(mrun[nt], mloc), alpha = __builtin_amdgcn_exp2f(mrun[nt] - mnew); \
            mrun[nt] = mnew; \
            float ls = 0.f; \
            _Pragma("unroll") for (int mt = 0; mt < 4; ++mt) _Pragma("unroll") for (int j = 0; j < 4; ++j) { const float p = __builtin_amdgcn_exp2f(s[mt][nt][j] - mnew); s[mt][nt][j] = p; ls += p; } \
            lrun[nt] = lrun[nt] * alpha + ls; \
            _Pragma("unroll") for (int dt = 0; dt < DT; ++dt) o[dt][nt] = o[dt][nt] * alpha; \
            _Pragma("unroll") for (int kb = 0; kb < 2; ++kb) { \
                u32x4 w; w.x = cvt_pk_bf16(s[2 * kb][nt][0], s[2 * kb][nt][1]); w.y = cvt_pk_bf16(s[2 * kb][nt][2], s[2 * kb][nt][3]); \
                w.z = cvt_pk_bf16(s[2 * kb + 1][nt][0], s[2 * kb + 1][nt][1]); w.w = cvt_pk_bf16(s[2 * kb + 1][nt][2], s[2 * kb + 1][nt][3]); \
                pf[nt][kb] = __builtin_bit_cast(bf16x8, w); } } \
        if (!PF) { asm volatile("" ::: "memory"); ATT_LOADV(vcur, t); } \
        _Pragma("unroll") for (int dt = 0; dt < DT; ++dt) _Pragma("unroll") for (int nt = 0; nt < NT; ++nt) _Pragma("unroll") for (int kb = 0; kb < 2; ++kb) \
            o[dt][nt] = __builtin_amdgcn_mfma_f32_16x16x32_bf16(vcur[dt][kb], pf[nt][kb], o[dt][nt], 0, 0, 0); \
    } while (0)
    if (PF && VDB) { ATT_LOADK(0); ATT_LOADV(vfA, 0);
#pragma nounroll
        for (int t = 0; t < ntiles; t += 2) {
            ATT_BODY(t, vfA, vfB);
            if (t + 1 < ntiles) ATT_BODY(t + 1, vfB, vfA);
        }
    } else if (PF) { ATT_LOADK(0);
#pragma nounroll
        for (int t = 0; t < ntiles; ++t) ATT_BODY(t, vfA, vfB);
    } else {
#pragma nounroll
        for (int t = 0; t < ntiles; ++t) ATT_BODY(t, vfA, vfB);
    }
#undef ATT_BODY
#undef ATT_LOADK
#undef ATT_LOADV
#pragma unroll
    for (int nt = 0; nt < NT; ++nt) {
        float l = lrun[nt]; l += __shfl_xor(l, 16); l += __shfl_xor(l, 32);
        const float inv = 1.0f / l;
#pragma unroll
        for (int dt = 0; dt < DT; ++dt) {
            const f32x4 v = o[dt][nt] * inv; u32x2 w; w.x = cvt_pk_bf16(v[0], v[1]); w.y = cvt_pk_bf16(v[2], v[3]);
            *(u32x2*)(Op + (size_t)(nt * 16 + fr) * ldo + dt * 16 + 4 * fq) = w;
        }
    }
}

#define XB_TMO      128
#define XB_XCNT(j)  (256  + 64 * (j))
#define XB_XSUB(j)  (1280 + 64 * (j))
#define XB_XGEN(j)  (2304 + 64 * (j))
#define XB_TOP      3328
#define XB_TOPGEN   3392
#define XCD_BAR_WORDS 3456
#define XB_SPIN_CAP (1u << 22)
__device__ __forceinline__ unsigned xb_ld(unsigned* p)              { return __hip_atomic_load(p, __ATOMIC_RELAXED, __HIP_MEMORY_SCOPE_AGENT); }
__device__ __forceinline__ unsigned xb_add(unsigned* p, unsigned v) { return __hip_atomic_fetch_add(p, v, __ATOMIC_RELAXED, __HIP_MEMORY_SCOPE_AGENT); }
__device__ __forceinline__ unsigned xb_xcc_id() { return (unsigned)__builtin_amdgcn_s_getreg((3 << 11) | 20) & 0xFu; }
#define XB_SPIN(cond, bar) do { unsigned _sp = 0; while (cond) { __builtin_amdgcn_s_sleep(1); \
    if ((++_sp & 255u) == 0u) { if (xb_ld(&(bar)[XB_TMO])) break; if (_sp > XB_SPIN_CAP) { atomicAdd(&(bar)[XB_TMO], 1u); break; } } } } while (0)
struct XcdBarrier { unsigned* bar; unsigned x; volatile LAS unsigned* st; };
__device__ __forceinline__ XcdBarrier xcd_barrier_post(unsigned* bar, volatile LAS unsigned* st) {
    XcdBarrier b; b.bar = bar; b.x = xb_xcc_id(); b.st = st;
    if (threadIdx.x == 0) (void)xb_add(&bar[XB_XCNT(b.x)], 1u);
    return b;
}
__device__ __forceinline__ void xcd_barrier_complete(unsigned* bar, unsigned x, unsigned& nloc, unsigned& nx) {
    const unsigned G = gridDim.x * gridDim.y * gridDim.z;
    unsigned sum, cnt, mine, sp = 0u;
    for (;;) {
        sum = 0u; cnt = 0u; mine = 0u;
#pragma unroll
        for (unsigned j = 0; j < 16; ++j) { const unsigned c = xb_ld(&bar[XB_XCNT(j)]); sum += c; cnt += (c > 0u) ? 1u : 0u; mine = (j == x) ? c : mine; }
        if (sum == G) break;
        __builtin_amdgcn_s_sleep(1);
        if ((++sp & 255u) == 0u) { if (xb_ld(&bar[XB_TMO])) break; if (sp > XB_SPIN_CAP) { atomicAdd(&bar[XB_TMO], 1u); break; } }
    }
    nloc = mine > 0u ? mine : 1u; nx = cnt > 0u ? cnt : 1u;
}
__device__ __forceinline__ void xcd_barrier(const XcdBarrier& b) {
    asm volatile("s_waitcnt vmcnt(0)" ::: "memory");
    __syncthreads();
    if (threadIdx.x == 0) {
        unsigned* bar = b.bar;
        __builtin_amdgcn_s_waitcnt(0);
        unsigned nloc = b.st[0], nx = b.st[1];
        if (nloc == 0u) { xcd_barrier_complete(bar, b.x, nloc, nx); b.st[0] = nloc; b.st[1] = nx; }
        const unsigned old = xb_add(&bar[XB_XSUB(b.x)], 1u);
        const unsigned gen = old / nloc;
        if (old + 1u == (gen + 1u) * nloc) {
            __builtin_amdgcn_fence(__ATOMIC_RELEASE, "agent");
            asm volatile("s_waitcnt vmcnt(0)" ::: "memory");
            const unsigned og = xb_add(&bar[XB_TOP], 1u);
            const unsigned tg = og / nx;
            if (og + 1u == (tg + 1u) * nx) xb_add(&bar[XB_TOPGEN], 1u);
            else XB_SPIN(xb_ld(&bar[XB_TOPGEN]) == tg, bar);
            __builtin_amdgcn_fence(__ATOMIC_ACQUIRE, "agent");
            xb_add(&bar[XB_XGEN(b.x)], 1u);
            asm volatile("s_waitcnt vmcnt(0)" ::: "memory");
        } else {
            XB_SPIN(xb_ld(&bar[XB_XGEN(b.x)]) == gen, bar);
            __builtin_amdgcn_fence(__ATOMIC_ACQUIRE, "agent");
            asm volatile("s_waitcnt vmcnt(0)" ::: "memory");
        }
    }
    __syncthreads();
}

struct Params {
    const float* x; const float* mem;
    const float* ffn1_norm; const float* ffn1_wg; const float* ffn1_wu; const float* ffn1_wd;
    const float* mix_norm; const float* w_in; const float* rel_bias; const float* w_pool; const float* pool_scale; const float* w_out;
    const float* cross_norm; const float* mem_norm; const float* w_cq; const float* w_ckv; const float* w_co;
    const float* ffn2_norm; const float* ffn2_wg; const float* ffn2_wu; const float* ffn2_wd; const float* final_norm;
    float* out; unsigned char* ws;
};

__device__ __forceinline__ void p0_transpose_item(const float* __restrict__ W, int K, int N, bf16_t* __restrict__ WT, int mode, int row_off, const float* __restrict__ gain, LAS float* scr, int item, int lane) {
    const int nblk = N / 32, kb = item / nblk, nb = item - kb * nblk, k0 = 64 * kb, n0 = 32 * nb;
    {
        const int kr = lane >> 3, n4 = (lane & 7) * 4;
        f32x4 v[8]; float gk[8];
#pragma unroll
        for (int i = 0; i < 8; ++i) { v[i] = *(const f32x4*)(W + (size_t)(k0 + 8 * i + kr) * N + n0 + n4); gk[i] = gain ? gain[k0 + 8 * i + kr] : 1.0f; }
#pragma unroll
        for (int i = 0; i < 8; ++i) { LAS float* d = scr + (8 * i + kr) * 33 + n4; d[0] = v[i][0] * gk[i]; d[1] = v[i][1] * gk[i]; d[2] = v[i][2] * gk[i]; d[3] = v[i][3] * gk[i]; }
    }
    asm volatile("s_waitcnt lgkmcnt(0)" ::: "memory");
    const int c = lane & 7;
    const int d0 = (mode == 0 || mode == 3) ? (row_off + n0) : ((n0 >> 7) * 256 + (n0 & 127) + (mode == 2 ? 128 : 0));
#pragma unroll
    for (int j = 0; j < 4; ++j) { const int n = (lane >> 3) + 8 * j; const LAS float* s = scr + (8 * c) * 33 + n;
        u32x4 o; o.x = cvt_pk_bf16(s[0 * 33], s[1 * 33]); o.y = cvt_pk_bf16(s[2 * 33], s[3 * 33]); o.z = cvt_pk_bf16(s[4 * 33], s[5 * 33]); o.w = cvt_pk_bf16(s[6 * 33], s[7 * 33]);
        if (mode == 3) *(u32x4*)(WT + ((size_t)(k0 >> 7) * N + (row_off + n0 + n)) * 128 + (k0 & 127) + 8 * c) = o;
        else *(u32x4*)(WT + (size_t)(d0 + n) * K + k0 + 8 * c) = o; }
    asm volatile("s_waitcnt lgkmcnt(0)" ::: "memory");
}

#define rowss ((float*)(P.ws + WS_ROWSS))
#define Wgu1 ((bf16_t*)(P.ws + WS_WGU1))
#define Wd1 ((bf16_t*)(P.ws + WS_WD1))
#define Win ((bf16_t*)(P.ws + WS_WIN))
#define Wp ((bf16_t*)(P.ws + WS_WP))
#define Wout ((bf16_t*)(P.ws + WS_WOUT))
#define Wcq ((bf16_t*)(P.ws + WS_WCQ))
#define Wckv ((bf16_t*)(P.ws + WS_WCKV))
#define Wco ((bf16_t*)(P.ws + WS_WCO))
#define Wgu2 ((bf16_t*)(P.ws + WS_WGU2))
#define Wd2 ((bf16_t*)(P.ws + WS_WD2))
#define HB ((bf16_t*)(P.ws + WS_HB))
#define ACT ((bf16_t*)(P.ws + WS_ACT))
#define Z ((bf16_t*)(P.ws + WS_Z))
#define VT ((bf16_t*)(P.ws + WS_VT))
#define Y ((bf16_t*)(P.ws + WS_Y))
#define CQ ((bf16_t*)(P.ws + WS_CQ))
#define CO ((bf16_t*)(P.ws + WS_CO))
#define DP ((bf16_t*)(P.ws + WS_DP))
#define MEMN ((bf16_t*)(P.ws + WS_MEMN))
#define KC ((bf16_t*)(P.ws + WS_KC))
#define VCT ((bf16_t*)(P.ws + WS_VCT))
#define KF ((bf16_t*)(P.ws + WS_KF))
constexpr int I_G = (DM / 64) * (DFF / 32), I_D = (DFF / 64) * (DM / 32), I_IN = (DM / 64) * (DIN / 32), I_P = (256 / 64) * (256 / 32), I_O = (DM / 64) * (DM / 32),
              I_CQ = (DM / 64) * (DCROSS / 32), I_CKV = (DM / 64) * (2 * DCROSS / 32), I_CO = (DCROSS / 64) * (DM / 32);
constexpr int N_EARLY = 2 * I_G + I_D + I_IN + 4 * I_P + I_CKV, NITEMS = N_EARLY + 2 * I_G + I_D + I_O + I_CQ + I_CO;
#define CONVERT_ITEM(it_, lane) do { int r = (it_); \
        if (r < I_G) { p0_transpose_item(P.ffn1_wg, DM, DFF, Wgu1, 1, 0, P.ffn1_norm, scr, r, lane); break; } r -= I_G; \
        if (r < I_G) { p0_transpose_item(P.ffn1_wu, DM, DFF, Wgu1, 2, 0, P.ffn1_norm, scr, r, lane); break; } r -= I_G; \
        if (r < I_D) { p0_transpose_item(P.ffn1_wd, DFF, DM, Wd1, 3, 0, nullptr, scr, r, lane); break; } r -= I_D; \
        if (r < I_IN) { p0_transpose_item(P.w_in, DM, DIN, Win, 0, 0, P.mix_norm, scr, r, lane); break; } r -= I_IN; \
        if (r < 4 * I_P) { const int gi = r / I_P; p0_transpose_item(P.w_pool + (size_t)gi * 65536, 256, 256, Wp, 0, gi * 256, nullptr, scr, r - gi * I_P, lane); break; } r -= 4 * I_P; \
        if (r < I_CKV) { p0_transpose_item(P.w_ckv, DM, 2 * DCROSS, Wckv, 0, 0, nullptr, scr, r, lane); break; } r -= I_CKV; \
        if (r < I_G) { p0_transpose_item(P.ffn2_wg, DM, DFF, Wgu2, 1, 0, P.ffn2_norm, scr, r, lane); break; } r -= I_G; \
        if (r < I_G) { p0_transpose_item(P.ffn2_wu, DM, DFF, Wgu2, 2, 0, P.ffn2_norm, scr, r, lane); break; } r -= I_G; \
        if (r < I_D) { p0_transpose_item(P.ffn2_wd, DFF, DM, Wd2, 3, 0, nullptr, scr, r, lane); break; } r -= I_D; \
        if (r < I_O) { p0_transpose_item(P.w_out, DM, DM, Wout, 0, 0, nullptr, scr, r, lane); break; } r -= I_O; \
        if (r < I_CQ) { p0_transpose_item(P.w_cq, DM, DCROSS, Wcq, 0, 0, P.cross_norm, scr, r, lane); break; } r -= I_CQ; \
        p0_transpose_item(P.w_co, DCROSS, DM, Wco, 0, 0, nullptr, scr, r, lane); } while (0)
__global__ void __launch_bounds__(512, 2) fwd_megakernel(Params P) {
    extern __shared__ __attribute__((aligned(16))) unsigned char lds_raw[];
    cg::grid_group grid = cg::this_grid();
    LAS unsigned char* lds = (LAS unsigned char*)lds_raw;
    const int tid = threadIdx.x, lane = tid & 63, wave = __builtin_amdgcn_readfirstlane(tid >> 6);
    const int G = gridDim.x, bx = blockIdx.x;
    const int gw = bx * 8 + wave, NGW = G * 8;
    volatile LAS unsigned* bst = (volatile LAS unsigned*)(lds + 131072 + 64);
    if (tid < 2) bst[tid] = 0u;
    __syncthreads();
    const XcdBarrier xbar = xcd_barrier_post((unsigned*)(P.ws + WS_BAR), bst);
#ifndef WGM_RES
#define WGM_RES 8
#endif
#ifndef REV_DOWN
#define REV_DOWN 1
#endif
#define RUN_GEMM_ON(EPI, gM, gN, gdesc, edesc, G_, c_) do { pg8::StaticOrder S_; S_.init((gM), (gN), (G_), (c_), ((gN) == DM) ? WGM_RES : 8); pg8::gemm_phase<EPI>(lds, (gdesc), S_, (edesc)); } while (0)
#define RUN_GEMM(EPI, gM, gN, gdesc, edesc) RUN_GEMM_ON(EPI, gM, gN, gdesc, edesc, G, bx)
#ifndef AUX_DOWN
#define AUX_DOWN 0
#endif
#define RUN_GEMM_NT(EPI, gM, gN, gdesc, edesc) do { pg8::StaticOrder S_; S_.init((gM), (gN), G, bx, ((gN) == DM) ? WGM_RES : 8, REV_DOWN); pg8::gemm_phase<EPI, true, AUX_DOWN>(lds, (gdesc), S_, (edesc)); } while (0)

    for (int rep_ = 0; rep_ < REP_P0; ++rep_) {
        LAS float* scr = (LAS float*)(lds + wave * 16384);
        for (int it = gw; it < N_EARLY; it += NGW) CONVERT_ITEM(it, lane);
        for (int i = bx * 512 + tid; i < 4 * MTOK; i += G * 512) rowss[MTOK + i] = 0.f;
        for (int m = gw; m < MTOK; m += NGW) {
            const f32x4* xr = (const f32x4*)(P.x + (size_t)m * DM) + lane; u32x2* o8 = (u32x2*)(HB + (size_t)m * DM) + lane; float s = 0.f;
#pragma unroll
            for (int j = 0; j < 8; ++j) { const f32x4 v = xr[64 * j]; s += (v[0] * v[0] + v[1] * v[1]) + (v[2] * v[2] + v[3] * v[3]); u32x2 w; w.x = cvt_pk_bf16(v[0], v[1]); w.y = cvt_pk_bf16(v[2], v[3]); o8[64 * j] = w; }
            s = wave_sum(s); if (lane == 0) rowss[m] = s;
        }
        for (int m = gw; m < BATCH * NMEM; m += NGW) {
            const f32x4* xr = (const f32x4*)(P.mem + (size_t)m * DM) + lane; const f32x4* gr = (const f32x4*)P.mem_norm + lane; u32x2* o8 = (u32x2*)(MEMN + (size_t)m * DM) + lane;
            f32x4 v[8]; float s = 0.f;
#pragma unroll
            for (int j = 0; j < 8; ++j) { v[j] = xr[64 * j]; s += (v[j][0] * v[j][0] + v[j][1] * v[j][1]) + (v[j][2] * v[j][2] + v[j][3] * v[j][3]); }
            const float rs = __builtin_amdgcn_rsqf(wave_sum(s) * (1.0f / DM) + EPS);
#pragma unroll
            for (int j = 0; j < 8; ++j) { const f32x4 gg = gr[64 * j]; const f32x4 y = v[j] * rs * gg; u32x2 w; w.x = cvt_pk_bf16(y[0], y[1]); w.y = cvt_pk_bf16(y[2], y[3]); o8[64 * j] = w; }
        }
    }
    grid.sync();
    for (int rep_ = 0; rep_ < REP_G1; ++rep_)
    RUN_GEMM(pg8::EpiSwiglu, MTOK, 2 * DFF, (pg8::Gemm{HB, Wgu1, DM, DM, DM, 0}), (pg8::EpiSwiglu{ACT, DFF, rowss}));
    for (int rep_ = 0; rep_ < REP_G1NULL; ++rep_)
    RUN_GEMM(pg8::EpiNull, MTOK, 2 * DFF, (pg8::Gemm{HB, Wgu1, DM, DM, DM, 0}), (pg8::EpiNull{}));
    for (int rep_ = 0; rep_ < REP_SYNC; ++rep_) grid.sync();
    xcd_barrier(xbar);
    for (int rep_ = 0; rep_ < REP_G2NULL; ++rep_)
    RUN_GEMM(pg8::EpiNull, MTOK, DM, (pg8::Gemm{ACT, Wd1, 128, 128, DFF, 0, (size_t)0, (size_t)DM * 256}), (pg8::EpiNull{}));
    for (int rep_ = 0; rep_ < REP_G2; ++rep_)
    RUN_GEMM(pg8::EpiRes<true>, MTOK, DM, (pg8::Gemm{ACT, Wd1, 128, 128, DFF, 0, (size_t)MTOK * 256, (size_t)DM * 256}), (pg8::EpiRes<true>{P.x, HB, nullptr, 0.5f}));
    RUN_GEMM_NT(pg8::EpiRes<false>, MTOK, DM, (pg8::Gemm{ACT, Wd1, 128, 128, DFF, 0, (size_t)MTOK * 256, (size_t)DM * 256}), (pg8::EpiRes<false>{nullptr, HB, rowss + 1 * MTOK, 0.5f}));
    xcd_barrier(xbar);
    for (int rep_ = 0; rep_ < REP_G3; ++rep_)
    RUN_GEMM(pg8::EpiBf<64>, MTOK, DIN, (pg8::Gemm{HB, Win, DM, DM, DM, 0}), (pg8::EpiBf<64>{Z, DIN, 0, rowss + 1 * MTOK, nullptr, 8, 12, SEQ, DATT, VT, 4, 8, KF}));
    xcd_barrier(xbar);
    for (int rep_ = 0; rep_ < REP_ATT; ++rep_) {
        for (int task = gw; task < (MTOK / 64) * 4; task += NGW) {
            const int gi = task & 3, rt = task >> 2, sub = lane >> 5, cgi = lane & 31, w = 2 << gi;
            const int t0 = rt * 64 + sub * 32, tpos = t0 & (SEQ - 1);
            const bf16_t* up = Z + (size_t)t0 * DIN + 3 * DATT + gi * 256 + cgi * 8;
            bf16_t* dp = DP + (size_t)t0 * DPOOL + gi * 256 + cgi * 8;
            float sum[8];
#pragma unroll
            for (int e = 0; e < 8; ++e) sum[e] = 0.f;
            for (int i = 1; i < w; ++i) if (tpos - i >= 0) { const u32x4 v = *(const u32x4*)(up - (size_t)i * DIN);
                sum[0] += bf_lo(v.x); sum[1] += bf_hi(v.x); sum[2] += bf_lo(v.y); sum[3] += bf_hi(v.y); sum[4] += bf_lo(v.z); sum[5] += bf_hi(v.z); sum[6] += bf_lo(v.w); sum[7] += bf_hi(v.w); }
#pragma nounroll
            for (int r0 = 0; r0 < 32; r0 += 8) {
                u32x4 cv[8], ov[8];
#pragma unroll
                for (int j = 0; j < 8; ++j) cv[j] = *(const u32x4*)(up + (size_t)(r0 + j) * DIN);
#pragma unroll
                for (int j = 0; j < 8; ++j) { const int rr = r0 + j - w + 1; ov[j] = (tpos + rr >= 0) ? *(const u32x4*)(up + (ptrdiff_t)rr * DIN) : (u32x4){0u, 0u, 0u, 0u}; }
#pragma unroll
                for (int j = 0; j < 8; ++j) {
                    const u32x4 v = cv[j], q = ov[j];
                    const float cur[8] = {bf_lo(v.x), bf_hi(v.x), bf_lo(v.y), bf_hi(v.y), bf_lo(v.z), bf_hi(v.z), bf_lo(v.w), bf_hi(v.w)};
                    const float old[8] = {bf_lo(q.x), bf_hi(q.x), bf_lo(q.y), bf_hi(q.y), bf_lo(q.z), bf_hi(q.z), bf_lo(q.w), bf_hi(q.w)};
                    const int have = tpos + r0 + j + 1; const float inv = 1.0f / (float)(have < w ? have : w);
                    float d[8];
#pragma unroll
                    for (int e = 0; e < 8; ++e) { sum[e] += cur[e]; d[e] = sum[e] * inv - cur[e]; sum[e] -= old[e]; }
                    u32x4 o; o.x = cvt_pk_bf16(d[0], d[1]); o.y = cvt_pk_bf16(d[2], d[3]); o.z = cvt_pk_bf16(d[4], d[5]); o.w = cvt_pk_bf16(d[6], d[7]);
                    *(u32x4*)(dp + (size_t)(r0 + j) * DPOOL) = o;
                }
            }
        }
        LAS float* tab = (LAS float*)lds;
        for (int bh = bx; bh < BATCH * 16; bh += G) {
            const int b = bh >> 4, h = bh & 15;
            __syncthreads();
            for (int i = tid; i < 704; i += 512) { int rel = i - 63; rel = rel < -128 ? -128 : (rel > 128 ? 128 : rel); tab[i] = P.rel_bias[h * NREL + rel + 128] * LOG2E; }
            __syncthreads();
            const bool first = (bh == bx);
#pragma nounroll
            for (int stage = 0; stage < 2; ++stage) {
                const bool do_att = first ? ((((wave >> 2) & 1) == stage)) : (stage == 0);
                if (do_att) {
#pragma nounroll
                    for (int i = 0; i < 8; ++i) {
                        const int c = i * 4 + (wave >> 1), half = wave & 1, j0 = c < 8 ? 8 - c : 0, kstart = (c - 8 + j0) * 64;
                        const size_t qrow = (size_t)b * SEQ + c * 64 + half * 32;
                        attn_wave32<64, true, 2, true, true>(Z + qrow * DIN + h * 64, DIN, KF + ((size_t)(b * 16 + h) * SEQ + kstart) * 64, 0,
                                              VT + ((size_t)(b * 16 + h) * SEQ + kstart) * 64, 0, Y + qrow * DM + h * 64, DM, 9 - j0, 0.125f * LOG2E, tab, half * 32 + (8 - j0) * 64, lane);
                    }
                } else if (first) {
                    int ln = threadIdx.x & 63; asm volatile("" : "+v"(ln));
                    LAS float* scr2 = (LAS float*)(lds + 4096 + wave * 8448);
#define scr scr2
#pragma nounroll
                    for (int it = N_EARLY + gw; it < NITEMS; it += NGW) CONVERT_ITEM(it, ln);
#undef scr
                }
            }
        }
        __syncthreads();
    }
    xcd_barrier(xbar);
    if (G >= 128 && bx < 64) {
        RUN_GEMM_ON(pg8::EpiBf<128>, BATCH * NMEM, 2 * DCROSS, (pg8::Gemm{MEMN, Wckv, DM, DM, DM, 0}), (pg8::EpiBf<128>{KC, DCROSS, 0, nullptr, nullptr, 2, 4, NMEM, DCROSS, VCT, 0, 2, KC}), 64, bx);
    } else if (G >= 128) {
        RUN_GEMM_ON(pg8::EpiBf<0>, MTOK, DPOOL, (pg8::Gemm{DP, Wp, DPOOL, 256, 256, 512}), (pg8::EpiBf<0>{Y, DM, DATT, nullptr, P.pool_scale, 0, 0, 1, 1, nullptr, 0, 0, nullptr}), G - 64, bx - 64);
    } else {
        RUN_GEMM(pg8::EpiBf<128>, BATCH * NMEM, 2 * DCROSS, (pg8::Gemm{MEMN, Wckv, DM, DM, DM, 0}), (pg8::EpiBf<128>{KC, DCROSS, 0, nullptr, nullptr, 2, 4, NMEM, DCROSS, VCT, 0, 2, KC}));
        RUN_GEMM(pg8::EpiBf<0>, MTOK, DPOOL, (pg8::Gemm{DP, Wp, DPOOL, 256, 256, 512}), (pg8::EpiBf<0>{Y, DM, DATT, nullptr, P.pool_scale, 0, 0, 1, 1, nullptr, 0, 0, nullptr}));
    }
    xcd_barrier(xbar);
    RUN_GEMM(pg8::EpiRes<false>, MTOK, DM, (pg8::Gemm{Y, Wout, DM, DM, DM, 0}), (pg8::EpiRes<false>{nullptr, HB, rowss + 2 * MTOK, 1.0f}));
    xcd_barrier(xbar);
    RUN_GEMM(pg8::EpiBf<0>, MTOK, DCROSS, (pg8::Gemm{HB, Wcq, DM, DM, DM, 0}), (pg8::EpiBf<0>{CQ, DCROSS, 0, rowss + 2 * MTOK, nullptr, 0, 0, 1, 1, nullptr, 0, 0, nullptr}));
    xcd_barrier(xbar);
    for (int rep_ = 0; rep_ < REP_XATT; ++rep_) {
        for (int it = bx; it < BATCH * 16; it += G) {
            const int b = it >> 4, sub = it & 15;
#pragma nounroll
            for (int r = 0; r < 4; ++r) {
                const int wu = r * 8 + wave, head = wu & 3, qblk = wu >> 2;
                const size_t qrow = (size_t)b * SEQ + sub * 128 + qblk * 16;
#ifndef NO_ATT9
                attn_wave32<128, false, 1, true, true, false>(CQ + qrow * DCROSS + head * 128, DCROSS, KC + (size_t)(b * 4 + head) * NMEM * 128, 0,
                                        VCT + (size_t)(b * 4 + head) * NMEM * 128, 0, CO + qrow * DCROSS + head * 128, DCROSS, 4, 0.08838834764831845f * LOG2E, nullptr, 0, lane);
#endif
            }
        }
    }
    xcd_barrier(xbar);
    RUN_GEMM(pg8::EpiRes<false>, MTOK, DM, (pg8::Gemm{CO, Wco, DCROSS, DCROSS, DCROSS, 0}), (pg8::EpiRes<false>{nullptr, HB, rowss + 3 * MTOK, 1.0f}));
    xcd_barrier(xbar);
    RUN_GEMM(pg8::EpiSwiglu, MTOK, 2 * DFF, (pg8::Gemm{HB, Wgu2, DM, DM, DM, 0}), (pg8::EpiSwiglu{ACT, DFF, rowss + 3 * MTOK}));
    xcd_barrier(xbar);
    if (G == 256) {
        pg8::StaticOrder S_; S_.init(MTOK, DM, G, bx, 4, 0);
        pg8::gemm_phase<pg8::EpiResFinal, true, AUX_DOWN>(lds, (pg8::Gemm{ACT, Wd2, 128, 128, DFF, 0, (size_t)MTOK * 256, (size_t)DM * 256}), S_,
                                                          (pg8::EpiResFinal{HB, rowss + 4 * MTOK, 0.5f, P.out, P.final_norm, (unsigned*)(P.ws + WS_PCNT)}));
    } else {
        RUN_GEMM_NT(pg8::EpiRes<false>, MTOK, DM, (pg8::Gemm{ACT, Wd2, 128, 128, DFF, 0, (size_t)MTOK * 256, (size_t)DM * 256}), (pg8::EpiRes<false>{nullptr, HB, rowss + 4 * MTOK, 0.5f}));
        xcd_barrier(xbar);
        {
            const float* rs4 = rowss + 4 * MTOK;
            for (int m = gw; m < MTOK; m += NGW) {
                const u32x2* hr = (const u32x2*)(HB + (size_t)m * DM) + lane; f32x4* xr = (f32x4*)(P.out + (size_t)m * DM) + lane; const f32x4* gr = (const f32x4*)P.final_norm + lane;
                const float rs = __builtin_amdgcn_rsqf(rs4[m] * (1.0f / DM) + EPS);
    #pragma unroll
                for (int j = 0; j < 8; ++j) { const u32x2 q = hr[64 * j]; const f32x4 v = (f32x4){bf_lo(q.x), bf_hi(q.x), bf_lo(q.y), bf_hi(q.y)}; xr[64 * j] = v * rs * gr[64 * j]; }
            }
        }
    }
#undef RUN_GEMM
#undef RUN_GEMM_ON
#undef RUN_GEMM_NT
}

extern "C" void kernel_launch(void* const* d_in, const int* in_sizes, int n_in, void* d_out, int out_size, void* d_ws, size_t ws_size, hipStream_t stream) {
    static int grid_blocks = 0;
    if (grid_blocks == 0) {
        if (n_in != 22 || in_sizes[0] != MTOK * DM || out_size != MTOK * DM || ws_size < WS_END) {
            fprintf(stderr, "kernel_launch: unexpected shapes (n_in %d, in0 %d, out %d, ws %zu)\n", n_in, n_in > 0 ? in_sizes[0] : -1, out_size, ws_size); grid_blocks = -1; return; }
        int dev = 0, cus = 0, per_cu = 0;
        hipGetDevice(&dev);
        hipDeviceGetAttribute(&cus, hipDeviceAttributeMultiprocessorCount, dev);
        if (hipFuncSetAttribute((const void*)fwd_megakernel, hipFuncAttributeMaxDynamicSharedMemorySize, LDS_BYTES) != hipSuccess) { fprintf(stderr, "kernel_launch: hipFuncSetAttribute failed\n"); grid_blocks = -1; return; }
        if (hipOccupancyMaxActiveBlocksPerMultiprocessor(&per_cu, (const void*)fwd_megakernel, 512, LDS_BYTES) != hipSuccess || per_cu < 1) { fprintf(stderr, "kernel_launch: occupancy query gave %d\n", per_cu); per_cu = 1; }
        (void)hipGetLastError();
        grid_blocks = cus * per_cu;
    }
    if (grid_blocks < 0) return;
    Params p{};
    const float* const* in = (const float* const*)d_in;
    p.x = in[0]; p.mem = in[1]; p.ffn1_norm = in[2]; p.ffn1_wg = in[3]; p.ffn1_wu = in[4]; p.ffn1_wd = in[5]; p.mix_norm = in[6]; p.w_in = in[7]; p.rel_bias = in[8];
    p.w_pool = in[9]; p.pool_scale = in[10]; p.w_out = in[11]; p.cross_norm = in[12]; p.mem_norm = in[13]; p.w_cq = in[14]; p.w_ckv = in[15]; p.w_co = in[16];
    p.ffn2_norm = in[17]; p.ffn2_wg = in[18]; p.ffn2_wu = in[19]; p.ffn2_wd = in[20]; p.final_norm = in[21];
    p.out = (float*)d_out; p.ws = (unsigned char*)d_ws;
    if (hipMemsetAsync((char*)d_ws + WS_BAR, 0, WS_BAR_BYTES, stream) != hipSuccess) { fprintf(stderr, "kernel_launch: memset of the barrier words failed\n"); return; }
    void* args[] = {&p};
    hipError_t e = hipLaunchCooperativeKernel((const void*)fwd_megakernel, dim3(grid_blocks), dim3(512), args, LDS_BYTES, stream);
    if (e != hipSuccess) fprintf(stderr, "cooperative launch failed: %s (grid %d)\n", hipGetErrorString(e), grid_blocks);
}
```

```cpp
#include <hip/hip_runtime.h>
#include <hip/hip_cooperative_groups.h>
#include <cstdio>
#include <cstdint>
namespace cg = cooperative_groups;

#define LAS __attribute__((address_space(3)))
typedef unsigned short bf16_t;
typedef short bf16x8 __attribute__((ext_vector_type(8)));
typedef float f32x4 __attribute__((ext_vector_type(4)));
typedef float f32x2 __attribute__((ext_vector_type(2)));
typedef unsigned u32x4 __attribute__((ext_vector_type(4)));
typedef unsigned u32x2 __attribute__((ext_vector_type(2)));

constexpr int BATCH = 16, SEQ = 2048, DM = 2048, MTOK = BATCH * SEQ;
constexpr int DFF = 5632, DIN = 4096, DATT = 1024, DPOOL = 1024, NMEM = 256, DCROSS = 512;
constexpr int NREL = 257;
constexpr float EPS = 1e-6f;
constexpr float LOG2E = 1.4426950408889634f;

constexpr size_t MiB = 1u << 20;
constexpr size_t WS_ROWSS = 0;
constexpr size_t WS_BAR = 896 * 1024, WS_BAR_BYTES = 49152, WS_PCNT = WS_BAR + 16384;
constexpr size_t WS_WGU1 = 1 * MiB, WS_WD1 = 45 * MiB, WS_WIN = 67 * MiB, WS_WP = 83 * MiB, WS_WOUT = 84 * MiB, WS_WCQ = 92 * MiB,
                 WS_WCKV = 94 * MiB, WS_WCO = 98 * MiB, WS_WGU2 = 100 * MiB, WS_WD2 = 144 * MiB;
constexpr size_t WS_HB = 166 * MiB;
constexpr size_t WS_ACT = 294 * MiB;
constexpr size_t WS_Z = 294 * MiB;
constexpr size_t WS_VT = 550 * MiB;
constexpr size_t WS_Y = 646 * MiB;
constexpr size_t WS_CQ = 646 * MiB, WS_CO = 678 * MiB;
constexpr size_t WS_DP = 774 * MiB;
constexpr size_t WS_MEMN = 838 * MiB;
constexpr size_t WS_KC = 854 * MiB;
constexpr size_t WS_VCT = 858 * MiB;
constexpr size_t WS_KF = 862 * MiB;
constexpr size_t WS_END = 926 * MiB;

#ifndef REP_G1NULL
#define REP_G1NULL 0
#endif
#ifndef REP_SYNC
#define REP_SYNC 0
#endif
#ifndef REP_G2
#define REP_G2 0
#endif
#ifndef REP_G2NULL
#define REP_G2NULL 0
#endif
#ifndef REP_ATTC
#define REP_ATTC 0
#endif
#ifndef REP_XATT
#define REP_XATT 1
#endif
#ifndef REP_P0
#define REP_P0 1
#endif
#ifndef REP_G1
#define REP_G1 1
#endif
#ifndef REP_ATT
#define REP_ATT 1
#endif
#ifndef REP_G3
#define REP_G3 1
#endif
constexpr int LDS_BYTES = 147456;

__device__ __forceinline__ unsigned cvt_pk_bf16(float lo, float hi) { unsigned r; asm volatile("v_cvt_pk_bf16_f32 %0, %1, %2" : "=v"(r) : "v"(lo), "v"(hi)); return r; }
__device__ __forceinline__ float bf_lo(unsigned w) { return __uint_as_float(w << 16); }
__device__ __forceinline__ float bf_hi(unsigned w) { return __uint_as_float(w & 0xffff0000u); }
__device__ __forceinline__ float wave_sum(float v) {
#pragma unroll
    for (int o = 1; o < 64; o <<= 1) v += __shfl_xor(v, o);
    return v;
}

namespace pg8 {
constexpr int BM = 256, BK = 64, HALF = 128, HTB = HALF * BK * 2, STAGE_BYTES = 8 * HTB, NXCD = 8;
__host__ __device__ __forceinline__ int lds_byte(int r, int c) { const int st = (r >> 4) * 2 + (c >> 5), rr = r & 15, cc = c & 31, ob = rr * 64 + cc * 2; return st * 1024 + (ob ^ (((ob >> 9) & 1) << 5)); }
__host__ __device__ __forceinline__ void stage_rc(int b, int& R, int& C) { const int st = b / 1024, sb = b % 1024, swz = sb ^ (((sb >> 9) & 1) << 5); R = (st >> 1) * 16 + swz / 64; C = (st & 1) * 32 + (swz % 64) / 2; }
__host__ __device__ __forceinline__ int perm32(int rho) { const int n = rho >> 4, i = rho & 15; return 8 * (i >> 2) + 4 * n + (i & 3); }

struct Unit { int pm, pn; };
struct Gemm { const bf16_t* A; const bf16_t* Bt; int lda, ldb, K, a_pn_step; size_t kblkA = 256, kblkB = 256; };

struct StaticOrder {
    int nM, nN, nwg, G, c, WGM, rev;
    __device__ void init(int M, int N, int G_, int c_, int wgm = 8, int rev_ = 0) { nM = M / BM; nN = N / BM; nwg = nM * nN; G = G_; c = c_; WGM = wgm; rev = rev_; }
    __device__ bool next(int i, Unit& u) const {
        const int nr = (nwg + G - 1) / G; if (i >= nr) return false;
        long L = (long)(rev ? nr - 1 - i : i) * G + c;
        if (L >= nwg) { if (!rev) return false; L = (long)(nr - 2 - i) * G + c; if (i + 1 >= nr) return false; }
        int wgid = (int)L; { const int q = nwg / NXCD, r = nwg % NXCD, xcd = wgid % NXCD, off = wgid / NXCD; wgid = (xcd < r ? xcd * (q + 1) : r * (q + 1) + (xcd - r) * q) + off; }
        const int nig = WGM * nN, gid = wgid / nig, fm = gid * WGM, gsz = (nM - fm) < WGM ? (nM - fm) : WGM;
        u.pm = fm + ((wgid % nig) % gsz); u.pn = (wgid % nig) / gsz; return true;
    }
};

template <int FMD> struct EpiBf {
    bf16_t* O; int ldc; int col_off; const float* rowss; const float* colscale; int t_lo, t_hi, t_rows, t_cols; bf16_t* VT; int k_lo, k_hi; bf16_t* KF;
    __device__ __forceinline__ void operator()(const f32x4 (&acc)[2][2][4][2], const Unit& u, int wr, int wc, int fr, int fq) const {
        const int row0 = u.pm * BM + wr * 64 + fr, cl = wc * 32 + 8 * fq;
        const bool tr = (u.pn >= t_lo) && (u.pn < t_hi);
        constexpr bool FM = FMD != 0;
        constexpr int FDH = FM ? FMD : 64, FKS = FDH / 32, FROWS = (FMD == 128) ? NMEM : SEQ, FNH = (FMD == 128) ? 4 : 16, FTPB = FROWS / 64;
        const bool kfm = FM && (u.pn >= k_lo) && (u.pn < k_hi);
        f32x4 cs[2][2]; float rsv[8];
#pragma unroll
        for (int bj = 0; bj < 2; ++bj)
#pragma unroll
            for (int n = 0; n < 2; ++n) cs[bj][n] = colscale ? *(const f32x4*)(colscale + u.pn * BM + bj * HALF + cl + 4 * n) : (f32x4){1.f, 1.f, 1.f, 1.f};
#pragma unroll
        for (int i = 0; i < 8; ++i) rsv[i] = rowss ? rowss[row0 + (i >> 2) * HALF + (i & 3) * 16] : 0.f;
        asm volatile("" ::: "memory");
#pragma unroll
        for (int ai = 0; ai < 2; ++ai)
#pragma unroll
            for (int m = 0; m < 4; ++m) {
                const int row = row0 + ai * HALF + m * 16;
                const float rsc = rowss ? __builtin_amdgcn_rsqf(rsv[ai * 4 + m] * (1.0f / DM) + EPS) : 1.0f;
#pragma unroll
                for (int bj = 0; bj < 2; ++bj) {
                    const f32x4 v0 = acc[ai][bj][m][0] * rsc * cs[bj][0], v1 = acc[ai][bj][m][1] * rsc * cs[bj][1];
                    u32x4 w; w.x = cvt_pk_bf16(v0[0], v0[1]); w.y = cvt_pk_bf16(v0[2], v0[3]); w.z = cvt_pk_bf16(v1[0], v1[1]); w.w = cvt_pk_bf16(v1[2], v1[3]);
                    if (FM && (kfm || tr)) {
                        const int c = (u.pn - (kfm ? k_lo : t_lo)) * BM + bj * HALF + cl, hh = c / FDH, d = c % FDH;
                        const int bb = row / FROWS, s = row % FROWS, tile = s >> 6, k = s & 63;
                        const size_t tbase = ((size_t)((bb * FNH + hh) * FTPB + tile)) * (64 * FDH);
                        if (kfm) {
                            const int kb = k >> 5, r = k & 31, mt = kb * 2 + ((r >> 2) & 1), fra = (r >> 3) * 4 + (r & 3), ks = d >> 5, fqa = (d >> 3) & 3;
                            *(u32x4*)(KF + tbase + ((mt * FKS + ks) * 64 + fqa * 16 + fra) * 8) = w;
                        } else {
                            const int dt = d >> 4, fra0 = d & 15, kb = k >> 5, fqa = (k & 31) >> 3, e8 = k & 7;
                            bf16_t* p = VT + tbase + ((dt * 2 + kb) * 64 + fqa * 16 + fra0) * 8 + e8;
                            p[0] = (bf16_t)(w.x & 0xffffu); p[8] = (bf16_t)(w.x >> 16); p[16] = (bf16_t)(w.y & 0xffffu); p[24] = (bf16_t)(w.y >> 16);
                            p[32] = (bf16_t)(w.z & 0xffffu); p[40] = (bf16_t)(w.z >> 16); p[48] = (bf16_t)(w.w & 0xffffu); p[56] = (bf16_t)(w.w >> 16);
                        }
                    } else if (!tr) { *(u32x4*)(O + (size_t)row * ldc + col_off + u.pn * BM + bj * HALF + cl) = w; }
                    else {
                        const int cv = (u.pn - t_lo) * BM + bj * HALF + cl, b = row / t_rows, s = row - b * t_rows;
                        bf16_t* p = VT + ((size_t)b * t_cols + cv) * t_rows + s;
                        p[0] = (bf16_t)(w.x & 0xffffu); p[(size_t)t_rows] = (bf16_t)(w.x >> 16); p[(size_t)2 * t_rows] = (bf16_t)(w.y & 0xffffu); p[(size_t)3 * t_rows] = (bf16_t)(w.y >> 16);
                        p[(size_t)4 * t_rows] = (bf16_t)(w.z & 0xffffu); p[(size_t)5 * t_rows] = (bf16_t)(w.z >> 16); p[(size_t)6 * t_rows] = (bf16_t)(w.w & 0xffffu); p[(size_t)7 * t_rows] = (bf16_t)(w.w >> 16);
                    }
                }
            }
    }
};
__device__ __forceinline__ float silu_mul(float g, float u) { return g * __builtin_amdgcn_rcpf(1.0f + __expf(-g)) * u; }
struct EpiSwiglu {
    bf16_t* O; int ldc; const float* rowss;
    __device__ __forceinline__ void operator()(const f32x4 (&acc)[2][2][4][2], const Unit& u, int wr, int wc, int fr, int fq) const {
        const int row0 = u.pm * BM + wr * 64 + fr, cl = wc * 32 + 8 * fq;
        float rsv[8];
#pragma unroll
        for (int i = 0; i < 8; ++i) rsv[i] = rowss[row0 + (i >> 2) * HALF + (i & 3) * 16];
        asm volatile("" ::: "memory");
#pragma unroll
        for (int ai = 0; ai < 2; ++ai)
#pragma unroll
            for (int m = 0; m < 4; ++m) {
                const int row = row0 + ai * HALF + m * 16;
                const float rsc = __builtin_amdgcn_rsqf(rsv[ai * 4 + m] * (1.0f / DM) + EPS);
                const f32x4 g0 = acc[ai][0][m][0] * rsc, g1 = acc[ai][0][m][1] * rsc, u0 = acc[ai][1][m][0] * rsc, u1 = acc[ai][1][m][1] * rsc;
                u32x4 w;
                w.x = cvt_pk_bf16(silu_mul(g0[0], u0[0]), silu_mul(g0[1], u0[1])); w.y = cvt_pk_bf16(silu_mul(g0[2], u0[2]), silu_mul(g0[3], u0[3]));
                w.z = cvt_pk_bf16(silu_mul(g1[0], u1[0]), silu_mul(g1[1], u1[1])); w.w = cvt_pk_bf16(silu_mul(g1[2], u1[2]), silu_mul(g1[3], u1[3]));
                *(u32x4*)(O + ((size_t)u.pn * MTOK + row) * HALF + cl) = w;
            }
    }
};
template <bool F32IN> struct EpiRes {
    const float* hin_f; bf16_t* hb; float* rowss_out; float alpha;
    static constexpr int DEPTH = F32IN ? 2 : 4, NV = F32IN ? 4 : 2;
    __device__ __forceinline__ void ld(f32x4 (&hv)[4], size_t off) const {
        if (F32IN) { hv[0] = *(const f32x4*)(hin_f + off); hv[1] = *(const f32x4*)(hin_f + off + 4); hv[2] = *(const f32x4*)(hin_f + off + HALF); hv[3] = *(const f32x4*)(hin_f + off + HALF + 4); }
        else { hv[0] = __builtin_bit_cast(f32x4, *(const u32x4*)(hb + off)); hv[1] = __builtin_bit_cast(f32x4, *(const u32x4*)(hb + off + HALF)); }
    }
    __device__ __forceinline__ void operator()(const f32x4 (&acc)[2][2][4][2], const Unit& u, int wr, int wc, int fr, int fq) const {
        const int row0 = u.pm * BM + wr * 64 + fr, cl = u.pn * BM + wc * 32 + 8 * fq;
        f32x4 hv[DEPTH][4];
#pragma unroll
        for (int gi = 0; gi < DEPTH; ++gi) ld(hv[gi], (size_t)(row0 + (gi >> 2) * HALF + (gi & 3) * 16) * DM + cl);
#pragma unroll
        for (int gi = 0; gi < 8; ++gi) {
            const int ai = gi >> 2, m = gi & 3, cb = gi % DEPTH;
            asm volatile("" ::: "memory");
            const int row = row0 + ai * HALF + m * 16; const size_t off = (size_t)row * DM + cl;
            float ss = 0.f;
            u32x4 wv[2];
#pragma unroll
            for (int bj = 0; bj < 2; ++bj) {
                f32x4 o0, o1;
                if (F32IN) { o0 = hv[cb][2 * bj]; o1 = hv[cb][2 * bj + 1]; }
                else { const u32x4 q = __builtin_bit_cast(u32x4, hv[cb][bj]); o0 = (f32x4){bf_lo(q.x), bf_hi(q.x), bf_lo(q.y), bf_hi(q.y)}; o1 = (f32x4){bf_lo(q.z), bf_hi(q.z), bf_lo(q.w), bf_hi(q.w)}; }
                const f32x4 h0 = o0 + acc[ai][bj][m][0] * alpha, h1 = o1 + acc[ai][bj][m][1] * alpha;
                ss += (h0[0] * h0[0] + h0[1] * h0[1]) + (h0[2] * h0[2] + h0[3] * h0[3]) + (h1[0] * h1[0] + h1[1] * h1[1]) + (h1[2] * h1[2] + h1[3] * h1[3]);
                wv[bj].x = cvt_pk_bf16(h0[0], h0[1]); wv[bj].y = cvt_pk_bf16(h0[2], h0[3]); wv[bj].z = cvt_pk_bf16(h1[0], h1[1]); wv[bj].w = cvt_pk_bf16(h1[2], h1[3]);
            }
            if (gi + DEPTH < 8) ld(hv[cb], (size_t)(row0 + ((gi + DEPTH) >> 2) * HALF + ((gi + DEPTH) & 3) * 16) * DM + cl);
            *(u32x4*)(hb + off) = wv[0]; *(u32x4*)(hb + off + HALF) = wv[1];
            ss += __shfl_xor(ss, 16); ss += __shfl_xor(ss, 32);
            if (rowss_out && fq == 0) __hip_atomic_fetch_add(rowss_out + row, ss, __ATOMIC_RELAXED, __HIP_MEMORY_SCOPE_AGENT);
        }
    }
};

struct EpiResFinal {
    bf16_t* hb; float* rowss_out; float alpha; float* out; const float* gain; unsigned* cnt;
    __device__ __forceinline__ void operator()(f32x4 (&acc)[2][2][4][2], const Unit& u, int wr, int wc, int fr, int fq) const {
        const int row0 = u.pm * BM + wr * 64 + fr, cl = u.pn * BM + wc * 32 + 8 * fq;
        u32x4 hv[4][2];
#pragma unroll
        for (int gi = 0; gi < 4; ++gi) { const size_t off = (size_t)(row0 + (gi >> 2) * HALF + (gi & 3) * 16) * DM + cl; hv[gi][0] = *(const u32x4*)(hb + off); hv[gi][1] = *(const u32x4*)(hb + off + HALF); }
#pragma unroll
        for (int gi = 0; gi < 8; ++gi) {
            const int ai = gi >> 2, m = gi & 3, cb = gi & 3;
            asm volatile("" ::: "memory");
            const int row = row0 + ai * HALF + m * 16;
            float ss = 0.f;
#pragma unroll
            for (int bj = 0; bj < 2; ++bj) {
                const u32x4 q = hv[cb][bj];
                const f32x4 h0 = (f32x4){bf_lo(q.x), bf_hi(q.x), bf_lo(q.y), bf_hi(q.y)} + acc[ai][bj][m][0] * alpha, h1 = (f32x4){bf_lo(q.z), bf_hi(q.z), bf_lo(q.w), bf_hi(q.w)} + acc[ai][bj][m][1] * alpha;
                ss += (h0[0] * h0[0] + h0[1] * h0[1]) + (h0[2] * h0[2] + h0[3] * h0[3]) + (h1[0] * h1[0] + h1[1] * h1[1]) + (h1[2] * h1[2] + h1[3] * h1[3]);
                acc[ai][bj][m][0] = h0; acc[ai][bj][m][1] = h1;
            }
            if (gi + 4 < 8) { const size_t offn = (size_t)(row0 + ((gi + 4) >> 2) * HALF + ((gi + 4) & 3) * 16) * DM + cl; hv[cb][0] = *(const u32x4*)(hb + offn); hv[cb][1] = *(const u32x4*)(hb + offn + HALF); }
            ss += __shfl_xor(ss, 16); ss += __shfl_xor(ss, 32);
            if (fq == 0) __hip_atomic_fetch_add(rowss_out + row, ss, __ATOMIC_RELAXED, __HIP_MEMORY_SCOPE_AGENT);
        }
        asm volatile("s_waitcnt vmcnt(0)" ::: "memory");
        __builtin_amdgcn_s_barrier(); asm volatile("" ::: "memory");
        if (threadIdx.x == 0) {
            unsigned* c = cnt + 64 * u.pm;
            __hip_atomic_fetch_add(c, 1u, __ATOMIC_RELAXED, __HIP_MEMORY_SCOPE_AGENT);
            unsigned sp = 0;
            while (__hip_atomic_load(c, __ATOMIC_RELAXED, __HIP_MEMORY_SCOPE_AGENT) < 8u) { __builtin_amdgcn_s_sleep(1); if (++sp > (1u << 22)) break; }
            __builtin_amdgcn_fence(__ATOMIC_ACQUIRE, "agent");
            asm volatile("s_waitcnt vmcnt(0)" ::: "memory");
        }
        __builtin_amdgcn_s_barrier(); asm volatile("" ::: "memory");
        float rsv[8];
#pragma unroll
        for (int i = 0; i < 8; ++i) rsv[i] = __hip_atomic_load(rowss_out + row0 + (i >> 2) * HALF + (i & 3) * 16, __ATOMIC_RELAXED, __HIP_MEMORY_SCOPE_AGENT);
        f32x4 gv[2][2];
#pragma unroll
        for (int bj = 0; bj < 2; ++bj) { gv[bj][0] = *(const f32x4*)(gain + cl + bj * HALF); gv[bj][1] = *(const f32x4*)(gain + cl + bj * HALF + 4); }
#pragma unroll
        for (int gi = 0; gi < 8; ++gi) {
            const int ai = gi >> 2, m = gi & 3; const size_t off = (size_t)(row0 + ai * HALF + m * 16) * DM + cl;
            const float rs = __builtin_amdgcn_rsqf(rsv[gi] * (1.0f / DM) + EPS);
#pragma unroll
            for (int bj = 0; bj < 2; ++bj) { *(f32x4*)(out + off + bj * HALF) = acc[ai][bj][m][0] * rs * gv[bj][0]; *(f32x4*)(out + off + bj * HALF + 4) = acc[ai][bj][m][1] * rs * gv[bj][1]; }
        }
    }
};
struct EpiNull {
    __device__ __forceinline__ void operator()(const f32x4 (&acc)[2][2][4][2], const Unit& u, int wr, int wc, int fr, int fq) const {
#pragma unroll
        for (int ai = 0; ai < 2; ++ai)
#pragma unroll
            for (int bj = 0; bj < 2; ++bj)
#pragma unroll
                for (int m = 0; m < 4; ++m) asm volatile("" :: "v"(acc[ai][bj][m][0]), "v"(acc[ai][bj][m][1]));
    }
};

template <class Epi, bool ALIGN_EPI = true, int AUX_A = 0>
__device__ __forceinline__ void gemm_phase(LAS unsigned char* lds, const Gemm g, const StaticOrder& S, const Epi& E) {
    int tid_l = threadIdx.x; asm volatile("" : "+v"(tid_l));
    const int tid = tid_l, wid = __builtin_amdgcn_readfirstlane(tid >> 6), lane = tid & 63, wr = wid >> 2, wc = wid & 3, fr = lane & 15, fq = lane >> 4;
    const int K = g.K, nt = K / BK;
    unsigned voffA[2], voffB[2];
#pragma unroll
    for (int i = 0; i < 2; ++i) { int R, C; stage_rc(tid * 16 + i * 8192, R, C); const int Rb = (R & ~31) + perm32(R & 31);
        voffA[i] = (unsigned)(R * g.lda + C) * 2u; voffB[i] = (unsigned)(Rb * g.ldb + C) * 2u; }
    const size_t kstep = (size_t)(BK * 2);
    const size_t hstepA = (size_t)HALF * g.lda * 2, hstepB = (size_t)HALF * g.ldb * 2;
    const size_t tstepA = 2 * hstepA, tstepB = 2 * hstepB;
    const unsigned ldsw = (unsigned)wid * 1024u;
    const int aoff = lds_byte(wr * 64 + fr, fq * 8), boff = lds_byte(wc * 32 + fr, fq * 8);
#define PG8_SA(b, h) (((b) * 2 + (h)) * HTB)
#define PG8_SB(b, h) ((4 + (b) * 2 + (h)) * HTB)
#define PG8_STAGE_X(bufoff, gbase, voff, aux) do { _Pragma("unroll") for (int _i = 0; _i < 2; ++_i) \
        __builtin_amdgcn_global_load_lds((const unsigned*)((const char*)(gbase) + (voff)[_i]), (LAS unsigned*)(lds + (bufoff) + ldsw + _i * 8192), 16, 0, aux); } while (0)
#define PG8_STAGE(bufoff, gbase, voff) PG8_STAGE_X(bufoff, gbase, voff, 0)
#define PG8_LDA(dst, b, h) do { _Pragma("unroll") for (int m = 0; m < 4; ++m) _Pragma("unroll") for (int k = 0; k < 2; ++k) dst[m][k] = *(const LAS bf16x8*)(lds + PG8_SA(b, h) + aoff + m * 2048 + k * 1024); } while (0)
#define PG8_LDB(dst, b, h) do { _Pragma("unroll") for (int n = 0; n < 2; ++n) _Pragma("unroll") for (int k = 0; k < 2; ++k) dst[n][k] = *(const LAS bf16x8*)(lds + PG8_SB(b, h) + boff + n * 2048 + k * 1024); } while (0)
#define PG8_MMA(ai, bj, At, Bt) do { __builtin_amdgcn_s_setprio(1); _Pragma("unroll") for (int m = 0; m < 4; ++m) _Pragma("unroll") for (int n = 0; n < 2; ++n) _Pragma("unroll") for (int k = 0; k < 2; ++k) \
        acc[ai][bj][m][n] = __builtin_amdgcn_mfma_f32_16x16x32_bf16(Bt[n][k], At[m][k], acc[ai][bj][m][n], 0, 0, 0); __builtin_amdgcn_s_setprio(0); } while (0)
#define PG8_WAIT_V(n) asm volatile("s_waitcnt vmcnt(" #n ")" ::: "memory")
#define PG8_WAIT_L(n) asm volatile("s_waitcnt lgkmcnt(" #n ")" ::: "memory")
#define PG8_BAR __builtin_amdgcn_s_barrier()
#define PG8_SCHED __builtin_amdgcn_sched_barrier(0)
    Unit cur, nxt; int ui = 0;
    if (!S.next(0, cur)) return;
    f32x4 acc[2][2][4][2];
#pragma unroll
    for (int a = 0; a < 2; ++a)
#pragma unroll
        for (int b = 0; b < 2; ++b)
#pragma unroll
            for (int m = 0; m < 4; ++m)
#pragma unroll
                for (int n = 0; n < 2; ++n) acc[a][b][m][n] = (f32x4){0.f, 0.f, 0.f, 0.f};
    bf16x8 At[4][2], B0[2][2], B1[2][2];
    const char* cA = (const char*)g.A + (size_t)cur.pm * tstepA + (size_t)cur.pn * g.a_pn_step; const char* cB = (const char*)g.Bt + (size_t)cur.pn * tstepB;
    PG8_STAGE(PG8_SB(0, 0), cB, voffB); PG8_STAGE(PG8_SB(0, 1), cB + hstepB, voffB); PG8_STAGE_X(PG8_SA(0, 0), cA, voffA, AUX_A); PG8_STAGE_X(PG8_SA(0, 1), cA + hstepA, voffA, AUX_A);
    if (wr == 1) PG8_BAR;
    PG8_WAIT_V(2); PG8_BAR;
    PG8_STAGE(PG8_SB(1, 0), cB + kstep, voffB); PG8_STAGE_X(PG8_SA(1, 0), cA + kstep, voffA, AUX_A); PG8_STAGE(PG8_SB(1, 1), cB + hstepB + kstep, voffB);
    PG8_WAIT_V(6); PG8_BAR;
    for (;;) {
        const bool has_next = S.next(ui + 1, nxt);
        const char* nA = has_next ? (const char*)g.A + (size_t)nxt.pm * tstepA + (size_t)nxt.pn * g.a_pn_step : cA; const char* nB = has_next ? (const char*)g.Bt + (size_t)nxt.pn * tstepB : cB;
        for (int t = 0; t < nt; t += 2) {
            const bool last = (t == nt - 2);
            const size_t kbi = (size_t)(t >> 1);
            const char* a1 = cA + kbi * g.kblkA + kstep;
            const char* a2 = last ? nA : cA + (kbi + 1) * g.kblkA; const char* b2 = last ? nB : cB + (kbi + 1) * g.kblkB;
            const char* a3 = a2 + kstep; const char* b3 = b2 + kstep;
            PG8_LDB(B0, 0, 0); PG8_LDB(B1, 0, 1); PG8_SCHED; PG8_LDA(At, 0, 0); PG8_STAGE_X(PG8_SA(1, 1), a1 + hstepA, voffA, AUX_A);
            PG8_WAIT_V(8); PG8_WAIT_L(0); PG8_BAR; PG8_MMA(0, 0, At, B0); PG8_MMA(0, 1, At, B1); PG8_BAR; PG8_SCHED;
            PG8_LDA(At, 0, 1); PG8_STAGE(PG8_SB(0, 0), b2, voffB); PG8_STAGE(PG8_SB(0, 1), b2 + hstepB, voffB); PG8_STAGE_X(PG8_SA(0, 0), a2, voffA, AUX_A);
            PG8_WAIT_V(8); PG8_WAIT_L(0); PG8_BAR; PG8_MMA(1, 0, At, B0); PG8_MMA(1, 1, At, B1); PG8_BAR; PG8_SCHED;
            PG8_LDB(B0, 1, 0); PG8_LDB(B1, 1, 1); PG8_SCHED; PG8_LDA(At, 1, 0); PG8_STAGE_X(PG8_SA(0, 1), a2 + hstepA, voffA, AUX_A);
            PG8_WAIT_V(8); PG8_WAIT_L(0); PG8_BAR; PG8_MMA(0, 0, At, B0); PG8_MMA(0, 1, At, B1); PG8_BAR; PG8_SCHED;
            PG8_LDA(At, 1, 1); PG8_STAGE(PG8_SB(1, 0), b3, voffB); PG8_STAGE(PG8_SB(1, 1), b3 + hstepB, voffB); PG8_STAGE_X(PG8_SA(1, 0), a3, voffA, AUX_A);
            PG8_WAIT_V(8); PG8_WAIT_L(0); PG8_BAR; PG8_MMA(1, 0, At, B0); PG8_MMA(1, 1, At, B1); PG8_BAR; PG8_SCHED;
        }
        if constexpr (ALIGN_EPI) { if (wr == 0) PG8_BAR; }
        E(acc, cur, wr, wc, fr, fq);
        if (!has_next) break;
#pragma unroll
        for (int a = 0; a < 2; ++a)
#pragma unroll
            for (int b = 0; b < 2; ++b)
#pragma unroll
                for (int m = 0; m < 4; ++m)
#pragma unroll
                    for (int n = 0; n < 2; ++n) acc[a][b][m][n] = (f32x4){0.f, 0.f, 0.f, 0.f};
        cur = nxt; cA = nA; cB = nB; ++ui;
        if constexpr (ALIGN_EPI) { if (wr == 1) PG8_BAR; }
    }
    PG8_WAIT_V(0);
    if constexpr (!ALIGN_EPI) { if (wr == 0) PG8_BAR; }
    PG8_BAR;
#undef PG8_SA
#undef PG8_SB
#undef PG8_STAGE
#undef PG8_STAGE_X
#undef PG8_LDA
#undef PG8_LDB
#undef PG8_MMA
#undef PG8_WAIT_V
#undef PG8_WAIT_L
#undef PG8_BAR
#undef PG8_SCHED
}
}

template <int DH, bool BIAS, int NT, bool PF, bool COAL = false, bool VDB = true>
__device__ __forceinline__ void attn_wave32(const bf16_t* __restrict__ Qp, int ldq, const bf16_t* __restrict__ Kp, int ldk, const bf16_t* __restrict__ Vp, int ldv,
                                            bf16_t* __restrict__ Op, int ldo, int ntiles, float sc, const LAS float* tab, int rel_base, int lane) {
    constexpr int KS = DH / 32, DT = DH / 16;
    asm volatile("" : "+v"(lane));
    const int fr = lane & 15, fq = lane >> 4;
    bf16x8 qf[NT][KS];
#pragma unroll
    for (int nt = 0; nt < NT; ++nt)
#pragma unroll
        for (int ks = 0; ks < KS; ++ks) qf[nt][ks] = *(const bf16x8*)(Qp + (size_t)(nt * 16 + fr) * ldq + ks * 32 + fq * 8);
    f32x4 o[DT][NT];
#pragma unroll
    for (int dt = 0; dt < DT; ++dt)
#pragma unroll
        for (int nt = 0; nt < NT; ++nt) o[dt][nt] = (f32x4){0.f, 0.f, 0.f, 0.f};
    float mrun[NT], lrun[NT];
#pragma unroll
    for (int nt = 0; nt < NT; ++nt) { mrun[nt] = -1e30f; lrun[nt] = 0.f; }
    const bf16_t* kbase = Kp + (size_t)(8 * (fr >> 2) + (fr & 3)) * ldk + fq * 8;
    const bf16_t* vbase = Vp + (size_t)fr * ldv + fq * 8;
    bf16x8 kf[4][KS], vfA[DT][2], vfB[DT][2];
#define ATT_LOADK(tt) do { _Pragma("unroll") for (int mt = 0; mt < 4; ++mt) _Pragma("unroll") for (int ks = 0; ks < KS; ++ks) \
        kf[mt][ks] = COAL ? *(const bf16x8*)(Kp + (size_t)(tt) * (64 * DH) + (mt * KS + ks) * 512 + lane * 8) \
                          : *(const bf16x8*)(kbase + (size_t)((tt) * 64 + (mt >> 1) * 32 + 4 * (mt & 1)) * ldk + ks * 32); } while (0)
#define ATT_LOADV(dst, tt) do { _Pragma("unroll") for (int dt = 0; dt < DT; ++dt) _Pragma("unroll") for (int kb = 0; kb < 2; ++kb) \
        dst[dt][kb] = COAL ? *(const bf16x8*)(Vp + (size_t)(tt) * (64 * DH) + (dt * 2 + kb) * 512 + lane * 8) \
                           : *(const bf16x8*)(vbase + (size_t)(dt * 16) * ldv + (tt) * 64 + kb * 32); } while (0)
#define ATT_BODY(t, vcur, vnext) do { \
        const int tn_ = ((t) + 1 < ntiles) ? (t) + 1 : (t); \
        if (PF && VDB) ATT_LOADV(vnext, tn_); else if (PF) ATT_LOADV(vcur, t); else ATT_LOADK(t); \
        f32x4 s[4][NT]; \
        _Pragma("unroll") for (int mt = 0; mt < 4; ++mt) _Pragma("unroll") for (int nt = 0; nt < NT; ++nt) { s[mt][nt] = (f32x4){0.f, 0.f, 0.f, 0.f}; \
            _Pragma("unroll") for (int ks = 0; ks < KS; ++ks) s[mt][nt] = __builtin_amdgcn_mfma_f32_16x16x32_bf16(kf[mt][ks], qf[nt][ks], s[mt][nt], 0, 0, 0); } \
        if (PF) ATT_LOADK(tn_); \
        bf16x8 pf[NT][2]; \
          \
        const LAS float* tb_ = tab + (rel_base - 64 * (t) + fr - 8 * fq + 63 - 39); \
        _Pragma("unroll") for (int nt = 0; nt < NT; ++nt) { \
            float mloc = -1e30f; \
            _Pragma("unroll") for (int mt = 0; mt < 4; ++mt) _Pragma("unroll") for (int j = 0; j < 4; ++j) { \
                float v = s[mt][nt][j] * sc; \
                if (BIAS) v += tb_[39 + nt * 16 - ((mt >> 1) * 32 + 4 * (mt & 1) + j)]; \
                s[mt][nt][j] = v; mloc = fmaxf(mloc, v); } \
            mloc = fmaxf(mloc, __shfl_xor(mloc, 16)); mloc = fmaxf(mloc, __shfl_xor(mloc, 32)); \
            const float mnew = fmaxf(mrun[nt], mloc), alpha = __builtin_amdgcn_exp2f(mrun[nt] - mnew); \
            mrun[nt] = mnew; \
            float ls = 0.f; \
            _Pragma("unroll") for (int mt = 0; mt < 4; ++mt) _Pragma("unroll") for (int j = 0; j < 4; ++j) { const float p = __builtin_amdgcn_exp2f(s[mt][nt][j] - mnew); s[mt][nt][j] = p; ls += p; } \
            lrun[nt] = lrun[nt] * alpha + ls; \
            _Pragma("unroll") for (int dt = 0; dt < DT; ++dt) o[dt][nt] = o[dt][nt] * alpha; \
            _Pragma("unroll") for (int kb = 0; kb < 2; ++kb) { \
                u32x4 w; w.x = cvt_pk_bf16(s[2 * kb][nt][0], s[2 * kb][nt][1]); w.y = cvt_pk_bf16(s[2 * kb][nt][2], s[2 * kb][nt][3]); \
                w.z = cvt_pk_bf16(s[2 * kb + 1][nt][0], s[2 * kb + 1][nt][1]); w.w = cvt_pk_bf16(s[2 * kb + 1][nt][2], s[2 * kb + 1][nt][3]); \
                pf[nt][kb] = __builtin_bit_cast(bf16x8, w); } } \
        if (!PF) { asm volatile("" ::: "memory"); ATT_LOADV(vcur, t); } \
        _Pragma("unroll") for (int dt = 0; dt < DT; ++dt) _Pragma("unroll") for (int nt = 0; nt < NT; ++nt) _Pragma("unroll") for (int kb = 0; kb < 2; ++kb) \
            o[dt][nt] = __builtin_amdgcn_mfma_f32_16x16x32_bf16(vcur[dt][kb], pf[nt][kb], o[dt][nt], 0, 0, 0); \
    } while (0)
    if (PF && VDB) { ATT_LOADK(0); ATT_LOADV(vfA, 0);
#pragma nounroll
        for (int t = 0; t < ntiles; t += 2) {
            ATT_BODY(t, vfA, vfB);
            if (t + 1 < ntiles) ATT_BODY(t + 1, vfB, vfA);
        }
    } else if (PF) { ATT_LOADK(0);
#pragma nounroll
        for (int t = 0; t < ntiles; ++t) ATT_BODY(t, vfA, vfB);
    } else {
#pragma nounroll
        for (int t = 0; t < ntiles; ++t) ATT_BODY(t, vfA, vfB);
    }
#undef ATT_BODY
#undef ATT_LOADK
#undef ATT_LOADV
#pragma unroll
    for (int nt = 0; nt < NT; ++nt) {
        float l = lrun[nt]; l += __shfl_xor(l, 16); l += __shfl_xor(l, 32);
        const float inv = 1.0f / l;
#pragma unroll
        for (int dt = 0; dt < DT; ++dt) {
            const f32x4 v = o[dt][nt] * inv; u32x2 w; w.x = cvt_pk_bf16(v[0], v[1]); w.y = cvt_pk_bf16(v[2], v[3]);
            *(u32x2*)(Op + (size_t)(nt * 16 + fr) * ldo + dt * 16 + 4 * fq) = w;
        }
    }
}

#define XB_TMO      128
#define XB_XCNT(j)  (256  + 64 * (j))
#define XB_XSUB(j)  (1280 + 64 * (j))
#define XB_XGEN(j)  (2304 + 64 * (j))
#define XB_TOP      3328
#define XB_TOPGEN   3392
#define XCD_BAR_WORDS 3456
#define XB_SPIN_CAP (1u << 22)
__device__ __forceinline__ unsigned xb_ld(unsigned* p)              { return __hip_atomic_load(p, __ATOMIC_RELAXED, __HIP_MEMORY_SCOPE_AGENT); }
__device__ __forceinline__ unsigned xb_add(unsigned* p, unsigned v) { return __hip_atomic_fetch_add(p, v, __ATOMIC_RELAXED, __HIP_MEMORY_SCOPE_AGENT); }
__device__ __forceinline__ unsigned xb_xcc_id() { return (unsigned)__builtin_amdgcn_s_getreg((3 << 11) | 20) & 0xFu; }
#define XB_SPIN(cond, bar) do { unsigned _sp = 0; while (cond) { __builtin_amdgcn_s_sleep(1); \
    if ((++_sp & 255u) == 0u) { if (xb_ld(&(bar)[XB_TMO])) break; if (_sp > XB_SPIN_CAP) { atomicAdd(&(bar)[XB_TMO], 1u); break; } } } } while (0)
struct XcdBarrier { unsigned* bar; unsigned x; volatile LAS unsigned* st; };
__device__ __forceinline__ XcdBarrier xcd_barrier_post(unsigned* bar, volatile LAS unsigned* st) {
    XcdBarrier b; b.bar = bar; b.x = xb_xcc_id(); b.st = st;
    if (threadIdx.x == 0) (void)xb_add(&bar[XB_XCNT(b.x)], 1u);
    return b;
}
__device__ __forceinline__ void xcd_barrier_complete(unsigned* bar, unsigned x, unsigned& nloc, unsigned& nx) {
    const unsigned G = gridDim.x * gridDim.y * gridDim.z;
    unsigned sum, cnt, mine, sp = 0u;
    for (;;) {
        sum = 0u; cnt = 0u; mine = 0u;
#pragma unroll
        for (unsigned j = 0; j < 16; ++j) { const unsigned c = xb_ld(&bar[XB_XCNT(j)]); sum += c; cnt += (c > 0u) ? 1u : 0u; mine = (j == x) ? c : mine; }
        if (sum == G) break;
        __builtin_amdgcn_s_sleep(1);
        if ((++sp & 255u) == 0u) { if (xb_ld(&bar[XB_TMO])) break; if (sp > XB_SPIN_CAP) { atomicAdd(&bar[XB_TMO], 1u); break; } }
    }
    nloc = mine > 0u ? mine : 1u; nx = cnt > 0u ? cnt : 1u;
}
__device__ __forceinline__ void xcd_barrier(const XcdBarrier& b) {
    asm volatile("s_waitcnt vmcnt(0)" ::: "memory");
    __syncthreads();
    if (threadIdx.x == 0) {
        unsigned* bar = b.bar;
        __builtin_amdgcn_s_waitcnt(0);
        unsigned nloc = b.st[0], nx = b.st[1];
        if (nloc == 0u) { xcd_barrier_complete(bar, b.x, nloc, nx); b.st[0] = nloc; b.st[1] = nx; }
        const unsigned old = xb_add(&bar[XB_XSUB(b.x)], 1u);
        const unsigned gen = old / nloc;
        if (old + 1u == (gen + 1u) * nloc) {
            __builtin_amdgcn_fence(__ATOMIC_RELEASE, "agent");
            asm volatile("s_waitcnt vmcnt(0)" ::: "memory");
            const unsigned og = xb_add(&bar[XB_TOP], 1u);
            const unsigned tg = og / nx;
            if (og + 1u == (tg + 1u) * nx) xb_add(&bar[XB_TOPGEN], 1u);
            else XB_SPIN(xb_ld(&bar[XB_TOPGEN]) == tg, bar);
            __builtin_amdgcn_fence(__ATOMIC_ACQUIRE, "agent");
            xb_add(&bar[XB_XGEN(b.x)], 1u);
            asm volatile("s_waitcnt vmcnt(0)" ::: "memory");
        } else {
            XB_SPIN(xb_ld(&bar[XB_XGEN(b.x)]) == gen, bar);
            __builtin_amdgcn_fence(__ATOMIC_ACQUIRE, "agent");
            asm volatile("s_waitcnt vmcnt(0)" ::: "memory");
        }
    }
    __syncthreads();
}

struct Params {
    const float* x; const float* mem;
    const float* ffn1_norm; const float* ffn1_wg; const float* ffn1_wu; const float* ffn1_wd;
    const float* mix_norm; const float* w_in; const float* rel_bias; const float* w_pool; const float* pool_scale; const float* w_out;
    const float* cross_norm; const float* mem_norm; const float* w_cq; const float* w_ckv; const float* w_co;
    const float* ffn2_norm; const float* ffn2_wg; const float* ffn2_wu; const float* ffn2_wd; const float* final_norm;
    float* out; unsigned char* ws;
};

__device__ __forceinline__ void p0_transpose_item(const float* __restrict__ W, int K, int N, bf16_t* __restrict__ WT, int mode, int row_off, const float* __restrict__ gain, LAS float* scr, int item, int lane) {
    const int nblk = N / 32, kb = item / nblk, nb = item - kb * nblk, k0 = 64 * kb, n0 = 32 * nb;
    {
        const int kr = lane >> 3, n4 = (lane & 7) * 4;
        f32x4 v[8]; float gk[8];
#pragma unroll
        for (int i = 0; i < 8; ++i) { v[i] = *(const f32x4*)(W + (size_t)(k0 + 8 * i + kr) * N + n0 + n4); gk[i] = gain ? gain[k0 + 8 * i + kr] : 1.0f; }
#pragma unroll
        for (int i = 0; i < 8; ++i) { LAS float* d = scr + (8 * i + kr) * 33 + n4; d[0] = v[i][0] * gk[i]; d[1] = v[i][1] * gk[i]; d[2] = v[i][2] * gk[i]; d[3] = v[i][3] * gk[i]; }
    }
    asm volatile("s_waitcnt lgkmcnt(0)" ::: "memory");
    const int c = lane & 7;
    const int d0 = (mode == 0 || mode == 3) ? (row_off + n0) : ((n0 >> 7) * 256 + (n0 & 127) + (mode == 2 ? 128 : 0));
#pragma unroll
    for (int j = 0; j < 4; ++j) { const int n = (lane >> 3) + 8 * j; const LAS float* s = scr + (8 * c) * 33 + n;
        u32x4 o; o.x = cvt_pk_bf16(s[0 * 33], s[1 * 33]); o.y = cvt_pk_bf16(s[2 * 33], s[3 * 33]); o.z = cvt_pk_bf16(s[4 * 33], s[5 * 33]); o.w = cvt_pk_bf16(s[6 * 33], s[7 * 33]);
        if (mode == 3) *(u32x4*)(WT + ((size_t)(k0 >> 7) * N + (row_off + n0 + n)) * 128 + (k0 & 127) + 8 * c) = o;
        else *(u32x4*)(WT + (size_t)(d0 + n) * K + k0 + 8 * c) = o; }
    asm volatile("s_waitcnt lgkmcnt(0)" ::: "memory");
}

#define rowss ((float*)(P.ws + WS_ROWSS))
#define Wgu1 ((bf16_t*)(P.ws + WS_WGU1))
#define Wd1 ((bf16_t*)(P.ws + WS_WD1))
#define Win ((bf16_t*)(P.ws + WS_WIN))
#define Wp ((bf16_t*)(P.ws + WS_WP))
#define Wout ((bf16_t*)(P.ws + WS_WOUT))
#define Wcq ((bf16_t*)(P.ws + WS_WCQ))
#define Wckv ((bf16_t*)(P.ws + WS_WCKV))
#define Wco ((bf16_t*)(P.ws + WS_WCO))
#define Wgu2 ((bf16_t*)(P.ws + WS_WGU2))
#define Wd2 ((bf16_t*)(P.ws + WS_WD2))
#define HB ((bf16_t*)(P.ws + WS_HB))
#define ACT ((bf16_t*)(P.ws + WS_ACT))
#define Z ((bf16_t*)(P.ws + WS_Z))
#define VT ((bf16_t*)(P.ws + WS_VT))
#define Y ((bf16_t*)(P.ws + WS_Y))
#define CQ ((bf16_t*)(P.ws + WS_CQ))
#define CO ((bf16_t*)(P.ws + WS_CO))
#define DP ((bf16_t*)(P.ws + WS_DP))
#define MEMN ((bf16_t*)(P.ws + WS_MEMN))
#define KC ((bf16_t*)(P.ws + WS_KC))
#define VCT ((bf16_t*)(P.ws + WS_VCT))
#define KF ((bf16_t*)(P.ws + WS_KF))
constexpr int I_G = (DM / 64) * (DFF / 32), I_D = (DFF / 64) * (DM / 32), I_IN = (DM / 64) * (DIN / 32), I_P = (256 / 64) * (256 / 32), I_O = (DM / 64) * (DM / 32),
              I_CQ = (DM / 64) * (DCROSS / 32), I_CKV = (DM / 64) * (2 * DCROSS / 32), I_CO = (DCROSS / 64) * (DM / 32);
constexpr int N_EARLY = 2 * I_G + I_D + I_IN + 4 * I_P + I_CKV, NITEMS = N_EARLY + 2 * I_G + I_D + I_O + I_CQ + I_CO;
#define CONVERT_ITEM(it_, lane) do { int r = (it_); \
        if (r < I_G) { p0_transpose_item(P.ffn1_wg, DM, DFF, Wgu1, 1, 0, P.ffn1_norm, scr, r, lane); break; } r -= I_G; \
        if (r < I_G) { p0_transpose_item(P.ffn1_wu, DM, DFF, Wgu1, 2, 0, P.ffn1_norm, scr, r, lane); break; } r -= I_G; \
        if (r < I_D) { p0_transpose_item(P.ffn1_wd, DFF, DM, Wd1, 3, 0, nullptr, scr, r, lane); break; } r -= I_D; \
        if (r < I_IN) { p0_transpose_item(P.w_in, DM, DIN, Win, 0, 0, P.mix_norm, scr, r, lane); break; } r -= I_IN; \
        if (r < 4 * I_P) { const int gi = r / I_P; p0_transpose_item(P.w_pool + (size_t)gi * 65536, 256, 256, Wp, 0, gi * 256, nullptr, scr, r - gi * I_P, lane); break; } r -= 4 * I_P; \
        if (r < I_CKV) { p0_transpose_item(P.w_ckv, DM, 2 * DCROSS, Wckv, 0, 0, nullptr, scr, r, lane); break; } r -= I_CKV; \
        if (r < I_G) { p0_transpose_item(P.ffn2_wg, DM, DFF, Wgu2, 1, 0, P.ffn2_norm, scr, r, lane); break; } r -= I_G; \
        if (r < I_G) { p0_transpose_item(P.ffn2_wu, DM, DFF, Wgu2, 2, 0, P.ffn2_norm, scr, r, lane); break; } r -= I_G; \
        if (r < I_D) { p0_transpose_item(P.ffn2_wd, DFF, DM, Wd2, 3, 0, nullptr, scr, r, lane); break; } r -= I_D; \
        if (r < I_O) { p0_transpose_item(P.w_out, DM, DM, Wout, 0, 0, nullptr, scr, r, lane); break; } r -= I_O; \
        if (r < I_CQ) { p0_transpose_item(P.w_cq, DM, DCROSS, Wcq, 0, 0, P.cross_norm, scr, r, lane); break; } r -= I_CQ; \
        p0_transpose_item(P.w_co, DCROSS, DM, Wco, 0, 0, nullptr, scr, r, lane); } while (0)
__global__ void __launch_bounds__(512, 2) fwd_megakernel(Params P) {
    extern __shared__ __attribute__((aligned(16))) unsigned char lds_raw[];
    cg::grid_group grid = cg::this_grid();
    LAS unsigned char* lds = (LAS unsigned char*)lds_raw;
    const int tid = threadIdx.x, lane = tid & 63, wave = __builtin_amdgcn_readfirstlane(tid >> 6);
    const int G = gridDim.x, bx = blockIdx.x;
    const int gw = bx * 8 + wave, NGW = G * 8;
    volatile LAS unsigned* bst = (volatile LAS unsigned*)(lds + 131072 + 64);
    if (tid < 2) bst[tid] = 0u;
    __syncthreads();
    const XcdBarrier xbar = xcd_barrier_post((unsigned*)(P.ws + WS_BAR), bst);
#ifndef WGM_RES
#define WGM_RES 8
#endif
#ifndef REV_DOWN
#define REV_DOWN 1
#endif
#define RUN_GEMM_ON(EPI, gM, gN, gdesc, edesc, G_, c_) do { pg8::StaticOrder S_; S_.init((gM), (gN), (G_), (c_), ((gN) == DM) ? WGM_RES : 8); pg8::gemm_phase<EPI>(lds, (gdesc), S_, (edesc)); } while (0)
#define RUN_GEMM(EPI, gM, gN, gdesc, edesc) RUN_GEMM_ON(EPI, gM, gN, gdesc, edesc, G, bx)
#ifndef AUX_DOWN
#define AUX_DOWN 0
#endif
#define RUN_GEMM_NT(EPI, gM, gN, gdesc, edesc) do { pg8::StaticOrder S_; S_.init((gM), (gN), G, bx, ((gN) == DM) ? WGM_RES : 8, REV_DOWN); pg8::gemm_phase<EPI, true, AUX_DOWN>(lds, (gdesc), S_, (edesc)); } while (0)

    for (int rep_ = 0; rep_ < REP_P0; ++rep_) {
        LAS float* scr = (LAS float*)(lds + wave * 16384);
        for (int i = bx * 512 + tid; i < 4 * MTOK; i += G * 512) rowss[MTOK + i] = 0.f;
        for (int m = gw; m < MTOK; m += NGW) {
            const f32x4* xr = (const f32x4*)(P.x + (size_t)m * DM) + lane; u32x2* o8 = (u32x2*)(HB + (size_t)m * DM) + lane; float s = 0.f;
#pragma unroll
            for (int j = 0; j < 8; ++j) { const f32x4 v = xr[64 * j]; s += (v[0] * v[0] + v[1] * v[1]) + (v[2] * v[2] + v[3] * v[3]); u32x2 w; w.x = cvt_pk_bf16(v[0], v[1]); w.y = cvt_pk_bf16(v[2], v[3]); o8[64 * j] = w; }
            s = wave_sum(s); if (lane == 0) rowss[m] = s;
        }
        for (int m = gw; m < BATCH * NMEM; m += NGW) {
            const f32x4* xr = (const f32x4*)(P.mem + (size_t)m * DM) + lane; const f32x4* gr = (const f32x4*)P.mem_norm + lane; u32x2* o8 = (u32x2*)(MEMN + (size_t)m * DM) + lane;
            f32x4 v[8]; float s = 0.f;
#pragma unroll
            for (int j = 0; j < 8; ++j) { v[j] = xr[64 * j]; s += (v[j][0] * v[j][0] + v[j][1] * v[j][1]) + (v[j][2] * v[j][2] + v[j][3] * v[j][3]); }
            const float rs = __builtin_amdgcn_rsqf(wave_sum(s) * (1.0f / DM) + EPS);
#pragma unroll
            for (int j = 0; j < 8; ++j) { const f32x4 gg = gr[64 * j]; const f32x4 y = v[j] * rs * gg; u32x2 w; w.x = cvt_pk_bf16(y[0], y[1]); w.y = cvt_pk_bf16(y[2], y[3]); o8[64 * j] = w; }
        }
        for (int it = N_EARLY - 1 - gw; it >= 0; it -= NGW) CONVERT_ITEM(it, lane);
    }
    grid.sync();
    for (int rep_ = 0; rep_ < REP_G1; ++rep_)
    RUN_GEMM(pg8::EpiSwiglu, MTOK, 2 * DFF, (pg8::Gemm{HB, Wgu1, DM, DM, DM, 0}), (pg8::EpiSwiglu{ACT, DFF, rowss}));
    for (int rep_ = 0; rep_ < REP_G1NULL; ++rep_)
    RUN_GEMM(pg8::EpiNull, MTOK, 2 * DFF, (pg8::Gemm{HB, Wgu1, DM, DM, DM, 0}), (pg8::EpiNull{}));
    for (int rep_ = 0; rep_ < REP_SYNC; ++rep_) grid.sync();
    xcd_barrier(xbar);
    for (int rep_ = 0; rep_ < REP_G2NULL; ++rep_)
    RUN_GEMM(pg8::EpiNull, MTOK, DM, (pg8::Gemm{ACT, Wd1, 128, 128, DFF, 0, (size_t)0, (size_t)DM * 256}), (pg8::EpiNull{}));
    for (int rep_ = 0; rep_ < REP_G2; ++rep_)
    RUN_GEMM(pg8::EpiRes<true>, MTOK, DM, (pg8::Gemm{ACT, Wd1, 128, 128, DFF, 0, (size_t)MTOK * 256, (size_t)DM * 256}), (pg8::EpiRes<true>{P.x, HB, nullptr, 0.5f}));
    RUN_GEMM_NT(pg8::EpiRes<false>, MTOK, DM, (pg8::Gemm{ACT, Wd1, 128, 128, DFF, 0, (size_t)MTOK * 256, (size_t)DM * 256}), (pg8::EpiRes<false>{nullptr, HB, rowss + 1 * MTOK, 0.5f}));
    xcd_barrier(xbar);
    for (int rep_ = 0; rep_ < REP_G3; ++rep_)
    RUN_GEMM(pg8::EpiBf<64>, MTOK, DIN, (pg8::Gemm{HB, Win, DM, DM, DM, 0}), (pg8::EpiBf<64>{Z, DIN, 0, rowss + 1 * MTOK, nullptr, 8, 12, SEQ, DATT, VT, 4, 8, KF}));
    xcd_barrier(xbar);
    for (int rep_ = 0; rep_ < REP_ATT; ++rep_) {
        for (int task = gw; task < (MTOK / 64) * 4; task += NGW) {
            const int gi = task & 3, rt = task >> 2, sub = lane >> 5, cgi = lane & 31, w = 2 << gi;
            const int t0 = rt * 64 + sub * 32, tpos = t0 & (SEQ - 1);
            const bf16_t* up = Z + (size_t)t0 * DIN + 3 * DATT + gi * 256 + cgi * 8;
            bf16_t* dp = DP + (size_t)t0 * DPOOL + gi * 256 + cgi * 8;
            float sum[8];
#pragma unroll
            for (int e = 0; e < 8; ++e) sum[e] = 0.f;
            for (int i = 1; i < w; ++i) if (tpos - i >= 0) { const u32x4 v = *(const u32x4*)(up - (size_t)i * DIN);
                sum[0] += bf_lo(v.x); sum[1] += bf_hi(v.x); sum[2] += bf_lo(v.y); sum[3] += bf_hi(v.y); sum[4] += bf_lo(v.z); sum[5] += bf_hi(v.z); sum[6] += bf_lo(v.w); sum[7] += bf_hi(v.w); }
#pragma nounroll
            for (int r0 = 0; r0 < 32; r0 += 8) {
                u32x4 cv[8], ov[8];
#pragma unroll
                for (int j = 0; j < 8; ++j) cv[j] = *(const u32x4*)(up + (size_t)(r0 + j) * DIN);
#pragma unroll
                for (int j = 0; j < 8; ++j) { const int rr = r0 + j - w + 1; ov[j] = (tpos + rr >= 0) ? *(const u32x4*)(up + (ptrdiff_t)rr * DIN) : (u32x4){0u, 0u, 0u, 0u}; }
#pragma unroll
                for (int j = 0; j < 8; ++j) {
                    const u32x4 v = cv[j], q = ov[j];
                    const float cur[8] = {bf_lo(v.x), bf_hi(v.x), bf_lo(v.y), bf_hi(v.y), bf_lo(v.z), bf_hi(v.z), bf_lo(v.w), bf_hi(v.w)};
                    const float old[8] = {bf_lo(q.x), bf_hi(q.x), bf_lo(q.y), bf_hi(q.y), bf_lo(q.z), bf_hi(q.z), bf_lo(q.w), bf_hi(q.w)};
                    const int have = tpos + r0 + j + 1; const float inv = 1.0f / (float)(have < w ? have : w);
                    float d[8];
#pragma unroll
                    for (int e = 0; e < 8; ++e) { sum[e] += cur[e]; d[e] = sum[e] * inv - cur[e]; sum[e] -= old[e]; }
                    u32x4 o; o.x = cvt_pk_bf16(d[0], d[1]); o.y = cvt_pk_bf16(d[2], d[3]); o.z = cvt_pk_bf16(d[4], d[5]); o.w = cvt_pk_bf16(d[6], d[7]);
                    *(u32x4*)(dp + (size_t)(r0 + j) * DPOOL) = o;
                }
            }
        }
        LAS float* tab = (LAS float*)lds;
        for (int bh = bx; bh < BATCH * 16; bh += G) {
            const int b = bh >> 4, h = bh & 15;
            __syncthreads();
            for (int i = tid; i < 704; i += 512) { int rel = i - 63; rel = rel < -128 ? -128 : (rel > 128 ? 128 : rel); tab[i] = P.rel_bias[h * NREL + rel + 128] * LOG2E; }
            __syncthreads();
            const bool first = (bh == bx);
#pragma nounroll
            for (int stage = 0; stage < 2; ++stage) {
                const bool do_att = first ? ((((wave >> 2) & 1) == stage)) : (stage == 0);
                if (do_att) {
#pragma nounroll
                    for (int i = 0; i < 8; ++i) {
                        const int c = i * 4 + (wave >> 1), half = wave & 1, j0 = c < 8 ? 8 - c : 0, kstart = (c - 8 + j0) * 64;
                        const size_t qrow = (size_t)b * SEQ + c * 64 + half * 32;
                        attn_wave32<64, true, 2, true, true>(Z + qrow * DIN + h * 64, DIN, KF + ((size_t)(b * 16 + h) * SEQ + kstart) * 64, 0,
                                              VT + ((size_t)(b * 16 + h) * SEQ + kstart) * 64, 0, Y + qrow * DM + h * 64, DM, 9 - j0, 0.125f * LOG2E, tab, half * 32 + (8 - j0) * 64, lane);
                    }
                } else if (first) {
                    int ln = threadIdx.x & 63; asm volatile("" : "+v"(ln));
                    LAS float* scr2 = (LAS float*)(lds + 4096 + wave * 8448);
#define scr scr2
#pragma nounroll
                    for (int it = N_EARLY + gw; it < NITEMS; it += NGW) CONVERT_ITEM(it, ln);
#undef scr
                }
            }
        }
        __syncthreads();
    }
    xcd_barrier(xbar);
    if (G >= 128 && bx < 64) {
        RUN_GEMM_ON(pg8::EpiBf<128>, BATCH * NMEM, 2 * DCROSS, (pg8::Gemm{MEMN, Wckv, DM, DM, DM, 0}), (pg8::EpiBf<128>{KC, DCROSS, 0, nullptr, nullptr, 2, 4, NMEM, DCROSS, VCT, 0, 2, KC}), 64, bx);
    } else if (G >= 128) {
        RUN_GEMM_ON(pg8::EpiBf<0>, MTOK, DPOOL, (pg8::Gemm{DP, Wp, DPOOL, 256, 256, 512}), (pg8::EpiBf<0>{Y, DM, DATT, nullptr, P.pool_scale, 0, 0, 1, 1, nullptr, 0, 0, nullptr}), G - 64, bx - 64);
    } else {
        RUN_GEMM(pg8::EpiBf<128>, BATCH * NMEM, 2 * DCROSS, (pg8::Gemm{MEMN, Wckv, DM, DM, DM, 0}), (pg8::EpiBf<128>{KC, DCROSS, 0, nullptr, nullptr, 2, 4, NMEM, DCROSS, VCT, 0, 2, KC}));
        RUN_GEMM(pg8::EpiBf<0>, MTOK, DPOOL, (pg8::Gemm{DP, Wp, DPOOL, 256, 256, 512}), (pg8::EpiBf<0>{Y, DM, DATT, nullptr, P.pool_scale, 0, 0, 1, 1, nullptr, 0, 0, nullptr}));
    }
    xcd_barrier(xbar);
    RUN_GEMM(pg8::EpiRes<false>, MTOK, DM, (pg8::Gemm{Y, Wout, DM, DM, DM, 0}), (pg8::EpiRes<false>{nullptr, HB, rowss + 2 * MTOK, 1.0f}));
    xcd_barrier(xbar);
    RUN_GEMM(pg8::EpiBf<0>, MTOK, DCROSS, (pg8::Gemm{HB, Wcq, DM, DM, DM, 0}), (pg8::EpiBf<0>{CQ, DCROSS, 0, rowss + 2 * MTOK, nullptr, 0, 0, 1, 1, nullptr, 0, 0, nullptr}));
    xcd_barrier(xbar);
    for (int rep_ = 0; rep_ < REP_XATT; ++rep_) {
        for (int it = bx; it < BATCH * 16; it += G) {
            const int b = it >> 4, sub = it & 15;
#pragma nounroll
            for (int r = 0; r < 4; ++r) {
                const int wu = r * 8 + wave, head = wu & 3, qblk = wu >> 2;
                const size_t qrow = (size_t)b * SEQ + sub * 128 + qblk * 16;
#ifndef NO_ATT9
                attn_wave32<128, false, 1, true, true, false>(CQ + qrow * DCROSS + head * 128, DCROSS, KC + (size_t)(b * 4 + head) * NMEM * 128, 0,
                                        VCT + (size_t)(b * 4 + head) * NMEM * 128, 0, CO + qrow * DCROSS + head * 128, DCROSS, 4, 0.08838834764831845f * LOG2E, nullptr, 0, lane);
#endif
            }
        }
    }
    xcd_barrier(xbar);
    RUN_GEMM(pg8::EpiRes<false>, MTOK, DM, (pg8::Gemm{CO, Wco, DCROSS, DCROSS, DCROSS, 0}), (pg8::EpiRes<false>{nullptr, HB, rowss + 3 * MTOK, 1.0f}));
    xcd_barrier(xbar);
    RUN_GEMM(pg8::EpiSwiglu, MTOK, 2 * DFF, (pg8::Gemm{HB, Wgu2, DM, DM, DM, 0}), (pg8::EpiSwiglu{ACT, DFF, rowss + 3 * MTOK}));
    xcd_barrier(xbar);
    if (G == 256) {
        pg8::StaticOrder S_; S_.init(MTOK, DM, G, bx, 4, 0);
        pg8::gemm_phase<pg8::EpiResFinal, true, AUX_DOWN>(lds, (pg8::Gemm{ACT, Wd2, 128, 128, DFF, 0, (size_t)MTOK * 256, (size_t)DM * 256}), S_,
                                                          (pg8::EpiResFinal{HB, rowss + 4 * MTOK, 0.5f, P.out, P.final_norm, (unsigned*)(P.ws + WS_PCNT)}));
    } else {
        RUN_GEMM_NT(pg8::EpiRes<false>, MTOK, DM, (pg8::Gemm{ACT, Wd2, 128, 128, DFF, 0, (size_t)MTOK * 256, (size_t)DM * 256}), (pg8::EpiRes<false>{nullptr, HB, rowss + 4 * MTOK, 0.5f}));
        xcd_barrier(xbar);
        {
            const float* rs4 = rowss + 4 * MTOK;
            for (int m = gw; m < MTOK; m += NGW) {
                const u32x2* hr = (const u32x2*)(HB + (size_t)m * DM) + lane; f32x4* xr = (f32x4*)(P.out + (size_t)m * DM) + lane; const f32x4* gr = (const f32x4*)P.final_norm + lane;
                const float rs = __builtin_amdgcn_rsqf(rs4[m] * (1.0f / DM) + EPS);
    #pragma unroll
                for (int j = 0; j < 8; ++j) { const u32x2 q = hr[64 * j]; const f32x4 v = (f32x4){bf_lo(q.x), bf_hi(q.x), bf_lo(q.y), bf_hi(q.y)}; xr[64 * j] = v * rs * gr[64 * j]; }
            }
        }
    }
#undef RUN_GEMM
#undef RUN_GEMM_ON
#undef RUN_GEMM_NT
}

extern "C" void kernel_launch(void* const* d_in, const int* in_sizes, int n_in, void* d_out, int out_size, void* d_ws, size_t ws_size, hipStream_t stream) {
    static int grid_blocks = 0;
    if (grid_blocks == 0) {
        if (n_in != 22 || in_sizes[0] != MTOK * DM || out_size != MTOK * DM || ws_size < WS_END) {
            fprintf(stderr, "kernel_launch: unexpected shapes (n_in %d, in0 %d, out %d, ws %zu)\n", n_in, n_in > 0 ? in_sizes[0] : -1, out_size, ws_size); grid_blocks = -1; return; }
        int dev = 0, cus = 0, per_cu = 0;
        hipGetDevice(&dev);
        hipDeviceGetAttribute(&cus, hipDeviceAttributeMultiprocessorCount, dev);
        if (hipFuncSetAttribute((const void*)fwd_megakernel, hipFuncAttributeMaxDynamicSharedMemorySize, LDS_BYTES) != hipSuccess) { fprintf(stderr, "kernel_launch: hipFuncSetAttribute failed\n"); grid_blocks = -1; return; }
        if (hipOccupancyMaxActiveBlocksPerMultiprocessor(&per_cu, (const void*)fwd_megakernel, 512, LDS_BYTES) != hipSuccess || per_cu < 1) { fprintf(stderr, "kernel_launch: occupancy query gave %d\n", per_cu); per_cu = 1; }
        (void)hipGetLastError();
        grid_blocks = cus * per_cu;
    }
    if (grid_blocks < 0) return;
    Params p{};
    const float* const* in = (const float* const*)d_in;
    p.x = in[0]; p.mem = in[1]; p.ffn1_norm = in[2]; p.ffn1_wg = in[3]; p.ffn1_wu = in[4]; p.ffn1_wd = in[5]; p.mix_norm = in[6]; p.w_in = in[7]; p.rel_bias = in[8];
    p.w_pool = in[9]; p.pool_scale = in[10]; p.w_out = in[11]; p.cross_norm = in[12]; p.mem_norm = in[13]; p.w_cq = in[14]; p.w_ckv = in[15]; p.w_co = in[16];
    p.ffn2_norm = in[17]; p.ffn2_wg = in[18]; p.ffn2_wu = in[19]; p.ffn2_wd = in[20]; p.final_norm = in[21];
    p.out = (float*)d_out; p.ws = (unsigned char*)d_ws;
    if (hipMemsetAsync((char*)d_ws + WS_BAR, 0, WS_BAR_BYTES, stream) != hipSuccess) { fprintf(stderr, "kernel_launch: memset of the barrier words failed\n"); return; }
    void* args[] = {&p};
    hipError_t e = hipLaunchCooperativeKernel((const void*)fwd_megakernel, dim3(grid_blocks), dim3(512), args, LDS_BYTES, stream);
    if (e != hipSuccess) fprintf(stderr, "cooperative launch failed: %s (grid %d)\n", hipGetErrorString(e), grid_blocks);
}
```
